# Optimizing an MI355X kernel written in HIP

```python
import math
import jax, jax.numpy as jnp
from jax import lax
import numpy as np

D_MODEL = 1024
BATCH = 32
SEQ = 2048
DEPTH = 1

GRID_W = 64
CTX_LEN = 256
N_MOD = 6
S5_WIDTH = 1024
S5_GROUP_CH = 16
S5_GROUPS = S5_WIDTH // S5_GROUP_CH
S5_STATE = 64
S5_DT_MIN = 1e-3
S5_DT_MAX = 1e-1
S5_MAX_RE = -1e-4
HEAD_DIM = 64
N_Q_HEADS = 16
N_KV_HEADS = 4
GQ = N_Q_HEADS // N_KV_HEADS
ATTN_WIDTH = N_Q_HEADS * HEAD_DIM
KV_WIDTH = N_KV_HEADS * HEAD_DIM
ROPE_AXIS_DIM = HEAD_DIM // 2
ROPE_THETA = 10000.0
Q_BLOCK = 128
IN_SPLITS = (S5_WIDTH, S5_WIDTH + ATTN_WIDTH, S5_WIDTH + ATTN_WIDTH + KV_WIDTH,
             S5_WIDTH + ATTN_WIDTH + 2 * KV_WIDTH, S5_WIDTH + ATTN_WIDTH + 2 * KV_WIDTH + D_MODEL)
IN_WIDTH = S5_WIDTH + ATTN_WIDTH + 2 * KV_WIDTH + 2 * D_MODEL
N_EXPERTS = 256
EXPERT_HIDDEN = 256
TOP_K = 8
N_EXPERT_GROUPS = 8
EXPERTS_PER_GROUP = N_EXPERTS // N_EXPERT_GROUPS
TOPK_GROUPS = 4
ROUTED_SCALE = 2.5
SHARED_HIDDEN = 256
MOE_BLOCK = 128
LN_EPS = 1e-5
MOD_EPS = 1e-6
RMS_EPS = 1e-6

kernel_name = 'hybrid_s5_gqa_moe_prefix_dit_block'


def _layer_norm(x, g, b):
    x32 = x.astype(jnp.float32)
    mu = jnp.mean(x32, -1, keepdims=True)
    var = jnp.mean(jnp.square(x32 - mu), -1, keepdims=True)
    y = (x32 - mu) * lax.rsqrt(var + LN_EPS) * g.astype(jnp.float32) + b.astype(jnp.float32)
    return y.astype(x.dtype)


def _modulate(x, shift, scale):
    x32 = x.astype(jnp.float32)
    mu = jnp.mean(x32, -1, keepdims=True)
    var = jnp.mean(jnp.square(x32 - mu), -1, keepdims=True)
    xn = ((x32 - mu) * lax.rsqrt(var + MOD_EPS)).astype(x.dtype)
    return xn * (1.0 + scale) + shift


def _rms_norm(t, g):
    t32 = t.astype(jnp.float32)
    y = t32 * lax.rsqrt(jnp.mean(t32 * t32, -1, keepdims=True) + RMS_EPS) * g.astype(jnp.float32)
    return y.astype(t.dtype)


def _axial_rope_tables(rows):
    inv_freq = ROPE_THETA ** (-jnp.arange(0, ROPE_AXIS_DIM, 2, dtype=jnp.float32) / ROPE_AXIS_DIM)
    pos_row = jnp.repeat(jnp.arange(rows, dtype=jnp.float32), GRID_W)
    pos_col = jnp.tile(jnp.arange(GRID_W, dtype=jnp.float32), rows)
    ang_r = pos_row[:, None] * inv_freq
    ang_c = pos_col[:, None] * inv_freq
    return (jnp.cos(ang_r), jnp.sin(ang_r), jnp.cos(ang_c), jnp.sin(ang_c))


def _rotate(t, cos, sin):
    t1, t2 = jnp.split(t, 2, axis=-1)
    cos = cos[:, None, :].astype(t.dtype)
    sin = sin[:, None, :].astype(t.dtype)
    return jnp.concatenate([t1 * cos - t2 * sin, t1 * sin + t2 * cos], axis=-1)


def _rope_2d(t, rope):
    cos_r, sin_r, cos_c, sin_c = rope
    t_row, t_col = jnp.split(t, 2, axis=-1)
    return jnp.concatenate([_rotate(t_row, cos_r, sin_r), _rotate(t_col, cos_c, sin_c)], axis=-1)


def _scan_combine(e1, e2):
    a1, b1 = e1
    a2, b2 = e2
    return a2 * a1, a2 * b1 + b2


def _diag_scan(lam_bar, bu, reverse, h0=None):
    if h0 is not None:
        edge = -1 if reverse else 0
        bu = bu.at[:, edge].add(lam_bar * h0)
    a = jnp.broadcast_to(lam_bar, bu.shape)
    _, h = lax.associative_scan(_scan_combine, (a, bu), reverse=reverse, axis=1)
    return h


def _s5_discretise(lam_re, lam_im, log_dt, b_re, b_im):
    lam = lax.complex(jnp.minimum(lam_re.astype(jnp.float32), S5_MAX_RE), lam_im.astype(jnp.float32))
    dt = jnp.exp(log_dt.astype(jnp.float32))[:, None]
    lam_bar = jnp.exp(lam * dt)
    b = lax.complex(b_re.astype(jnp.float32), b_im.astype(jnp.float32))
    b_bar = ((lam_bar - 1.0) / lam)[:, :, None] * b
    return lam_bar, b_bar


def _s5_readout(h, c_mat):
    y = jnp.real(jnp.einsum('blgp,gcp->blgc', h, c_mat))
    return y.reshape(h.shape[0], h.shape[1], S5_WIDTH)


def _half_glu(y, w_glu):
    z = jax.nn.gelu(y)
    return z * jax.nn.sigmoid(z @ w_glu.astype(jnp.float32))


def _s5_branch(s_lat, s_ctx, lam_re, lam_im, log_dt, b_re, b_im, c_re, c_im, d_skip, w_glu, keep_ctx):
    def groups(s):
        return s.astype(jnp.float32).reshape(s.shape[0], s.shape[1], S5_GROUPS, S5_GROUP_CH).astype(jnp.complex64)
    ul, uc = groups(s_lat), groups(s_ctx)
    d32 = d_skip.astype(jnp.float32)
    y_lat = s_lat.astype(jnp.float32) * d32
    y_ctx = s_ctx.astype(jnp.float32) * d32 if keep_ctx else None
    for direction, reverse in enumerate((False, True)):
        lam_bar, b_bar = _s5_discretise(lam_re[direction], lam_im[direction], log_dt[direction],
                                        b_re[direction], b_im[direction])
        c_mat = lax.complex(c_re[direction].astype(jnp.float32), c_im[direction].astype(jnp.float32))
        h_ctx = _diag_scan(lam_bar, jnp.einsum('blgc,gpc->blgp', uc, b_bar), reverse)
        h_ctx_final = h_ctx[:, 0] if reverse else h_ctx[:, -1]
        h_lat = _diag_scan(lam_bar, jnp.einsum('blgc,gpc->blgp', ul, b_bar), reverse, h_ctx_final)
        y_lat = y_lat + _s5_readout(h_lat, c_mat)
        if keep_ctx:
            y_ctx = y_ctx + _s5_readout(h_ctx, c_mat)
    out_lat = _half_glu(y_lat, w_glu).astype(s_lat.dtype)
    out_ctx = _half_glu(y_ctx, w_glu).astype(s_ctx.dtype) if keep_ctx else None
    return out_lat, out_ctx


def _block_attention(q, k, v):
    B, Lq = q.shape[0], q.shape[1]
    nb = Lq // Q_BLOCK
    qb = q.reshape(B, nb, Q_BLOCK, N_KV_HEADS, GQ, HEAD_DIM).swapaxes(0, 1)
    scale = HEAD_DIM ** -0.5

    def one_block(qi):
        s = jnp.einsum('bqhgd,bkhd->bhgqk', qi, k).astype(jnp.float32) * scale
        p = jax.nn.softmax(s, axis=-1).astype(v.dtype)
        return jnp.einsum('bhgqk,bkhd->bqhgd', p, v)

    o = lax.map(one_block, qb)
    return o.swapaxes(0, 1).reshape(B, Lq, ATTN_WIDTH)


def _gqa_branch(q_lat, k_lat, v_lat, q_ctx, k_ctx, v_ctx, q_norm_g, k_norm_g, rope, keep_ctx):
    def heads(t, n):
        return t.reshape(t.shape[0], t.shape[1], n, HEAD_DIM)
    ql = _rope_2d(_rms_norm(heads(q_lat, N_Q_HEADS), q_norm_g), rope)
    kl = _rope_2d(_rms_norm(heads(k_lat, N_KV_HEADS), k_norm_g), rope)
    kc = _rms_norm(heads(k_ctx, N_KV_HEADS), k_norm_g)
    vl, vc = heads(v_lat, N_KV_HEADS), heads(v_ctx, N_KV_HEADS)
    k_all = jnp.concatenate([kc, kl], axis=1)
    v_all = jnp.concatenate([vc, vl], axis=1)
    out_lat = _block_attention(ql, k_all, v_all)
    out_ctx = None
    if keep_ctx:
        qc = _rms_norm(heads(q_ctx, N_Q_HEADS), q_norm_g)
        out_ctx = _block_attention(qc, kc, vc)
    return out_lat, out_ctx


def _mixer(u_lat, u_ctx, w_in, s5_params, q_norm_g, k_norm_g, w_branch_ssm, w_branch_attn, w_out, rope, keep_ctx):
    s_lat, q_lat, k_lat, v_lat, gs_lat, ga_lat = jnp.split(u_lat @ w_in, IN_SPLITS, axis=-1)
    s_ctx, q_ctx, k_ctx, v_ctx, gs_ctx, ga_ctx = jnp.split(u_ctx @ w_in, IN_SPLITS, axis=-1)
    ssm_lat, ssm_ctx = _s5_branch(s_lat, s_ctx, *s5_params, keep_ctx)
    attn_lat, attn_ctx = _gqa_branch(q_lat, k_lat, v_lat, q_ctx, k_ctx, v_ctx, q_norm_g, k_norm_g, rope, keep_ctx)

    def merge(ssm, attn, gs, ga):
        merged = jax.nn.sigmoid(gs) * (ssm @ w_branch_ssm) + jax.nn.sigmoid(ga) * (attn @ w_branch_attn)
        return merged @ w_out

    y_lat = merge(ssm_lat, attn_lat, gs_lat, ga_lat)
    y_ctx = merge(ssm_ctx, attn_ctx, gs_ctx, ga_ctx) if keep_ctx else None
    return y_lat, y_ctx


def _routed_experts(ht, idx, gates, w_gate, w_up, w_down):
    T, D = ht.shape
    M = T * TOP_K
    flat_e = idx.reshape(M)
    order = jnp.argsort(flat_e)
    sorted_e = flat_e[order]
    counts = jnp.bincount(flat_e, length=N_EXPERTS)
    padded = (counts + MOE_BLOCK - 1) // MOE_BLOCK * MOE_BLOCK
    pad_end = jnp.cumsum(padded)
    pad_start = pad_end - padded
    grp_start = jnp.cumsum(counts) - counts
    dest = pad_start[sorted_e] + jnp.arange(M, dtype=pad_start.dtype) - grp_start[sorted_e]
    n_blocks = (M + N_EXPERTS * (MOE_BLOCK - 1) + MOE_BLOCK - 1) // MOE_BLOCK
    n_slots = n_blocks * MOE_BLOCK
    slot_token = jnp.full((n_slots,), T, jnp.int32).at[dest].set((order // TOP_K).astype(jnp.int32))
    slot_gate = jnp.zeros((n_slots,), jnp.float32).at[dest].set(gates.reshape(M)[order])
    block_start = jnp.arange(n_blocks, dtype=pad_end.dtype) * MOE_BLOCK
    block_expert = jnp.minimum(jnp.searchsorted(pad_end, block_start, side='right'), N_EXPERTS - 1)
    h_pad = jnp.concatenate([ht, jnp.zeros((1, D), ht.dtype)], axis=0)

    def expert_block(args):
        tok, gate, e = args
        xb = h_pad[tok]
        hid = jax.nn.silu(xb @ w_gate[e]) * (xb @ w_up[e])
        return (hid @ w_down[e]) * gate[:, None].astype(ht.dtype)

    out = lax.map(expert_block, (slot_token.reshape(n_blocks, MOE_BLOCK),
                                 slot_gate.reshape(n_blocks, MOE_BLOCK), block_expert))
    return jax.ops.segment_sum(out.reshape(n_slots, D), slot_token, num_segments=T + 1)[:T]


def _moe_ffn(h, w_router, router_bias, w_exp_gate, w_exp_up, w_exp_down, w_sh_gate, w_sh_up, w_sh_down):
    shape = h.shape
    ht = h.reshape(-1, shape[-1])
    T = ht.shape[0]
    scores = jax.nn.sigmoid((ht @ w_router).astype(jnp.float32))
    biased = scores + router_bias.astype(jnp.float32)
    grouped = biased.reshape(T, N_EXPERT_GROUPS, EXPERTS_PER_GROUP)
    group_score = jnp.sum(lax.top_k(grouped, 2)[0], axis=-1)
    _, top_groups = lax.top_k(group_score, TOPK_GROUPS)
    group_keep = jnp.sum(jax.nn.one_hot(top_groups, N_EXPERT_GROUPS, dtype=jnp.float32), axis=1) > 0
    expert_keep = jnp.repeat(group_keep, EXPERTS_PER_GROUP, axis=1)
    _, idx = lax.top_k(jnp.where(expert_keep, biased, -jnp.inf), TOP_K)
    sel = jnp.take_along_axis(scores, idx, axis=-1)
    gates = sel / jnp.sum(sel, axis=-1, keepdims=True) * ROUTED_SCALE
    routed = _routed_experts(ht, idx, gates, w_exp_gate, w_exp_up, w_exp_down)
    shared = (jax.nn.silu(ht @ w_sh_gate) * (ht @ w_sh_up)) @ w_sh_down
    return (routed + shared).reshape(shape)


def setup_inputs(seed: int = 0) -> dict:
    key = jax.random.key(seed)
    ks = jax.random.split(key, 40)
    f32 = jnp.float32

    def nrm(k, shape, scale):
        return jax.random.normal(k, shape, f32) * scale

    beta = (8.0 * DEPTH) ** -0.25
    n_idx = jnp.arange(S5_STATE, dtype=f32)
    return {
        'x': nrm(ks[0], (BATCH, SEQ, D_MODEL), 1.0),
        'c': nrm(ks[1], (BATCH, D_MODEL), 1.0),
        'ctx': nrm(ks[2], (BATCH, CTX_LEN, D_MODEL), 1.0),
        'c_ctx': nrm(ks[3], (D_MODEL,), 1.0),
        'w_mod': nrm(ks[4], (DEPTH, D_MODEL, N_MOD * D_MODEL), 0.5 * D_MODEL ** -0.5),
        'b_mod': nrm(ks[5], (DEPTH, N_MOD * D_MODEL), 0.02),
        'w_in': nrm(ks[6], (DEPTH, D_MODEL, IN_WIDTH), D_MODEL ** -0.5),
        's5_lam_re': -0.5 + nrm(ks[7], (DEPTH, 2, S5_GROUPS, S5_STATE), 0.01),
        's5_lam_im': jnp.pi * n_idx + nrm(ks[8], (DEPTH, 2, S5_GROUPS, S5_STATE), 0.01),
        's5_log_dt': jax.random.uniform(ks[9], (DEPTH, 2, S5_GROUPS), f32,
                                        minval=math.log(S5_DT_MIN), maxval=math.log(S5_DT_MAX)),
        's5_b_re': nrm(ks[10], (DEPTH, 2, S5_GROUPS, S5_STATE, S5_GROUP_CH), (2.0 * S5_GROUP_CH) ** -0.5),
        's5_b_im': nrm(ks[11], (DEPTH, 2, S5_GROUPS, S5_STATE, S5_GROUP_CH), (2.0 * S5_GROUP_CH) ** -0.5),
        's5_c_re': nrm(ks[12], (DEPTH, 2, S5_GROUPS, S5_GROUP_CH, S5_STATE), (2.0 * S5_STATE) ** -0.5),
        's5_c_im': nrm(ks[13], (DEPTH, 2, S5_GROUPS, S5_GROUP_CH, S5_STATE), (2.0 * S5_STATE) ** -0.5),
        's5_d': nrm(ks[14], (DEPTH, S5_WIDTH), 0.5),
        'w_glu': nrm(ks[15], (DEPTH, S5_WIDTH, S5_WIDTH), S5_WIDTH ** -0.5),
        'q_norm_g': 1.0 + nrm(ks[16], (DEPTH, HEAD_DIM), 0.02),
        'k_norm_g': 1.0 + nrm(ks[17], (DEPTH, HEAD_DIM), 0.02),
        'w_branch_ssm': nrm(ks[18], (DEPTH, S5_WIDTH, D_MODEL), S5_WIDTH ** -0.5),
        'w_branch_attn': nrm(ks[19], (DEPTH, ATTN_WIDTH, D_MODEL), ATTN_WIDTH ** -0.5),
        'w_out': nrm(ks[20], (DEPTH, D_MODEL, D_MODEL), beta * D_MODEL ** -0.5),
        'ln1_g': 1.0 + nrm(ks[21], (DEPTH, D_MODEL), 0.02),
        'ln1_b': nrm(ks[22], (DEPTH, D_MODEL), 0.02),
        'w_router': nrm(ks[23], (DEPTH, D_MODEL, N_EXPERTS), D_MODEL ** -0.5),
        'router_bias': nrm(ks[24], (DEPTH, N_EXPERTS), 0.01),
        'w_exp_gate': nrm(ks[25], (DEPTH, N_EXPERTS, D_MODEL, EXPERT_HIDDEN), D_MODEL ** -0.5),
        'w_exp_up': nrm(ks[26], (DEPTH, N_EXPERTS, D_MODEL, EXPERT_HIDDEN), D_MODEL ** -0.5),
        'w_exp_down': nrm(ks[27], (DEPTH, N_EXPERTS, EXPERT_HIDDEN, D_MODEL), beta * EXPERT_HIDDEN ** -0.5),
        'w_sh_gate': nrm(ks[28], (DEPTH, D_MODEL, SHARED_HIDDEN), D_MODEL ** -0.5),
        'w_sh_up': nrm(ks[29], (DEPTH, D_MODEL, SHARED_HIDDEN), D_MODEL ** -0.5),
        'w_sh_down': nrm(ks[30], (DEPTH, SHARED_HIDDEN, D_MODEL), beta * SHARED_HIDDEN ** -0.5),
        'ln2_g': 1.0 + nrm(ks[31], (DEPTH, D_MODEL), 0.02),
        'ln2_b': nrm(ks[32], (DEPTH, D_MODEL), 0.02),
    }


def reference(x, c, ctx, c_ctx, w_mod, b_mod, w_in, s5_lam_re, s5_lam_im, s5_log_dt, s5_b_re, s5_b_im,
              s5_c_re, s5_c_im, s5_d, w_glu, q_norm_g, k_norm_g, w_branch_ssm, w_branch_attn, w_out,
              ln1_g, ln1_b, w_router, router_bias, w_exp_gate, w_exp_up, w_exp_down,
              w_sh_gate, w_sh_up, w_sh_down, ln2_g, ln2_b):
    alpha = (2.0 * DEPTH) ** 0.25
    rows = x.shape[1] // GRID_W
    rope = _axial_rope_tables(rows)
    x_lat, x_ctx = x, ctx
    for layer in range(DEPTH):
        keep_ctx = layer < DEPTH - 1
        mod = jax.nn.silu(c) @ w_mod[layer] + b_mod[layer]
        mod_c = jax.nn.silu(c_ctx) @ w_mod[layer] + b_mod[layer]
        sh1, sc1, g1, sh2, sc2, g2 = jnp.split(mod[:, None, :], N_MOD, axis=-1)
        csh1, csc1, cg1, csh2, csc2, cg2 = jnp.split(mod_c, N_MOD, axis=-1)
        s5_params = (s5_lam_re[layer], s5_lam_im[layer], s5_log_dt[layer], s5_b_re[layer], s5_b_im[layer],
                     s5_c_re[layer], s5_c_im[layer], s5_d[layer], w_glu[layer])
        moe_params = (w_router[layer], router_bias[layer], w_exp_gate[layer], w_exp_up[layer], w_exp_down[layer],
                      w_sh_gate[layer], w_sh_up[layer], w_sh_down[layer])
        y_lat, y_ctx = _mixer(_modulate(x_lat, sh1, sc1), _modulate(x_ctx, csh1, csc1), w_in[layer], s5_params,
                              q_norm_g[layer], k_norm_g[layer], w_branch_ssm[layer], w_branch_attn[layer],
                              w_out[layer], rope, keep_ctx)
        x_lat = _layer_norm(alpha * x_lat + g1 * y_lat, ln1_g[layer], ln1_b[layer])
        f_lat = _moe_ffn(_modulate(x_lat, sh2, sc2), *moe_params)
        x_lat = _layer_norm(alpha * x_lat + g2 * f_lat, ln2_g[layer], ln2_b[layer])
        if keep_ctx:
            x_ctx = _layer_norm(alpha * x_ctx + cg1 * y_ctx, ln1_g[layer], ln1_b[layer])
            f_ctx = _moe_ffn(_modulate(x_ctx, csh2, csc2), *moe_params)
            x_ctx = _layer_norm(alpha * x_ctx + cg2 * f_ctx, ln2_g[layer], ln2_b[layer])
    return x_lat
```

```cpp
#include <hip/hip_runtime.h>
#include <cstdio>
#include <cstdint>


#ifndef MK_DIAG
#define MK_DIAG 0
#endif

#define LAS __attribute__((address_space(3)))
#define GAS __attribute__((address_space(1)))
typedef unsigned short bf16_t;
typedef short bf16x8 __attribute__((ext_vector_type(8)));
typedef float f32x4 __attribute__((ext_vector_type(4)));
typedef float f32x2 __attribute__((ext_vector_type(2)));
typedef unsigned u32x4 __attribute__((ext_vector_type(4)));
typedef unsigned u32x2 __attribute__((ext_vector_type(2)));

constexpr int NB = 32, SEQ = 2048, CTX = 256, DM = 1024, T = NB * SEQ, TC = NB * CTX;
constexpr int NIN = 4608;
constexpr int SKV = CTX + SEQ;
constexpr int LC5 = 32;
constexpr int NCHL = SEQ / LC5, NCHC = CTX / LC5;
constexpr int ROWS_G = NB * (NCHL + NCHC);
constexpr int NS5 = LC5 * 16;
constexpr int KAUG = NS5 + 256;
constexpr int NEXP = 256, NEXPS = 257, EH = 256, TOPK = 8;
constexpr int NCHUNK = 4, TCH = T / NCHUNK;
constexpr int SLOTS_CH = TCH * (TOPK + 1);
constexpr float ALPHA = 1.189207115002721f;
constexpr float C2Q = 0.125f * 1.4426950408889634f;

constexpr size_t MiB = 1u << 20;
constexpr size_t WS_CTL = 0, CTL_ZERO_BYTES = 1 * MiB;
constexpr size_t WS_MOD = 1 * MiB;
constexpr size_t WS_ROPE = 2 * MiB;
constexpr size_t WS_LAML = 2 * MiB + 65536;
constexpr size_t WS_TILES = 2 * MiB + 262144;
constexpr size_t WS_EIDX = 3 * MiB;
constexpr size_t WS_GATE = 5 * MiB;
constexpr size_t WS_SLOT = 7 * MiB;
constexpr size_t WS_STOK = 9 * MiB;
constexpr size_t WS_WIN = 16 * MiB;
constexpr size_t WS_WGLU = 25 * MiB, WS_WBS = 27 * MiB, WS_WBA = 29 * MiB, WS_WOUT = 31 * MiB, WS_WR = 33 * MiB;
constexpr size_t WS_WGU = 34 * MiB;
constexpr size_t WS_WD = 291 * MiB;
constexpr size_t WS_X1 = 420 * MiB;
constexpr size_t WS_U2 = 548 * MiB;
constexpr size_t WS_H = 676 * MiB;
constexpr size_t WS_Y = 748 * MiB;
constexpr size_t WS_LOGIT = 748 * MiB;
constexpr size_t WS_END_MOE = 1036 * MiB;
constexpr size_t WS_TMAT = 34 * MiB;
constexpr size_t WS_WH = 82 * MiB;
constexpr size_t WS_HFIN = 98 * MiB;
constexpr size_t WS_A = 242 * MiB;
constexpr size_t WS_UC = 370 * MiB;
constexpr size_t WS_SAUG = 386 * MiB;
constexpr size_t WS_Q = 602 * MiB;
constexpr size_t WS_K = 730 * MiB;
constexpr size_t WS_V = 766 * MiB;
constexpr size_t WS_GS = 802 * MiB;
constexpr size_t WS_GA = 930 * MiB;
constexpr size_t WS_END = 1058 * MiB;
static_assert(WS_SAUG + (size_t)64 * ROWS_G * KAUG * 2 <= WS_Q && WS_HFIN + (size_t)64 * ROWS_G * 256 * 4 <= WS_A && WS_TMAT + (size_t)64 * NS5 * KAUG * 2 <= WS_WH, "ws map");
static_assert(WS_WGU + (size_t)NEXPS * 512 * 1024 * 2 <= WS_WD && WS_WD + (size_t)NEXPS * 1024 * 256 * 2 <= WS_X1 && WS_H + (size_t)SLOTS_CH * 256 * 2 <= WS_Y && WS_Y + (size_t)SLOTS_CH * 1024 * 2 <= WS_END_MOE, "ws map moe");
constexpr int CW_TMO = 0, CW_CODE = 1;
constexpr int CW_CHK = 64;
constexpr int CW_BAR = 4096;
constexpr int CW_CNT = 65536;

constexpr int RING_BYTES = 131072;
constexpr int LDSCTL_OFF = 143360;
constexpr int IDX_OFF = LDSCTL_OFF + 512;
constexpr int LDS_BYTES = 147456;
constexpr int NWAVES = 8, NTHR = 512;

#define RLX_AGENT __ATOMIC_RELAXED, __HIP_MEMORY_SCOPE_AGENT
#define LDS_WAIT() asm volatile("s_waitcnt lgkmcnt(0)" ::: "memory")
#define VM_WAIT() asm volatile("s_waitcnt vmcnt(0)" ::: "memory")
__device__ __forceinline__ unsigned cvt_pk_bf16(float lo, float hi) { unsigned r; asm volatile("v_cvt_pk_bf16_f32 %0, %1, %2" : "=v"(r) : "v"(lo), "v"(hi)); return r; }
__device__ __forceinline__ float bf2f(unsigned short b) { return __uint_as_float((unsigned)b << 16); }
__device__ __forceinline__ float bflo(unsigned w) { return __uint_as_float(w << 16); }
__device__ __forceinline__ float bfhi(unsigned w) { return __uint_as_float(w & 0xffff0000u); }
__device__ __forceinline__ unsigned short f2bf(float f) { return (unsigned short)(cvt_pk_bf16(f, 0.f) & 0xffffu); }
__device__ __forceinline__ float sigmoidf_(float v) { return __builtin_amdgcn_rcpf(1.f + __builtin_amdgcn_exp2f(-1.4426950408889634f * v)); }
__device__ __forceinline__ float wave_sum(float v) {
#pragma unroll
    for (int o = 1; o < 64; o <<= 1) v += __shfl_xor(v, o);
    return v;
}
__device__ __forceinline__ float gelu_tanh(float x) { const float u = 0.7978845608028654f * (x + 0.044715f * x * x * x); return x * __builtin_amdgcn_rcpf(1.f + __builtin_amdgcn_exp2f(-2.885390081777927f * u)); }
__device__ __forceinline__ float silu_(float x) { return x * sigmoidf_(x); }

#define XB_TMO      128
#define XB_XCNT(j)  (256  + 64 * (j))
#define XB_XSUB(j)  (1280 + 64 * (j))
#define XB_XGEN(j)  (2304 + 64 * (j))
#define XB_TOP      3328
#define XB_TOPGEN   3392
#define XCD_BAR_WORDS 3456
#define XB_SPIN_CAP (1u << 18)
__device__ __forceinline__ unsigned xb_ld(unsigned* p)              { return __hip_atomic_load(p, __ATOMIC_RELAXED, __HIP_MEMORY_SCOPE_AGENT); }
__device__ __forceinline__ unsigned xb_add(unsigned* p, unsigned v) { return __hip_atomic_fetch_add(p, v, __ATOMIC_RELAXED, __HIP_MEMORY_SCOPE_AGENT); }
__device__ __forceinline__ unsigned xb_xcc_id() { return (unsigned)__builtin_amdgcn_s_getreg((3 << 11) | 20) & 0xFu; }
#define XB_SPIN(cond, bar) do { unsigned _sp = 0; while (cond) { __builtin_amdgcn_s_sleep(1); \
    if ((++_sp & 255u) == 0u) { if (xb_ld(&(bar)[XB_TMO])) break; if (_sp > XB_SPIN_CAP) { atomicAdd(&(bar)[XB_TMO], 1u); break; } } } } while (0)
struct XcdBarrier { unsigned* bar; unsigned x; volatile LAS unsigned* st; };
__device__ __forceinline__ XcdBarrier xcd_barrier_post(unsigned* bar, volatile LAS unsigned* st) {
    XcdBarrier b; b.bar = bar; b.x = xb_xcc_id(); b.st = st;
    if (threadIdx.x == 0) (void)xb_add(&bar[XB_XCNT(b.x)], 1u);
    return b;
}
__device__ __forceinline__ void xcd_barrier_complete(unsigned* bar, unsigned x, unsigned& nloc, unsigned& nx) {
    const unsigned G = gridDim.x * gridDim.y * gridDim.z;
    unsigned sum, cnt, sp = 0u;
    for (;;) {
        sum = 0u; cnt = 0u;
#pragma unroll 1
        for (unsigned j = 0; j < 16; ++j) { const unsigned c = xb_ld(&bar[XB_XCNT(j)]); sum += c; cnt += (c > 0u) ? 1u : 0u; }
        if (sum == G) break;
        __builtin_amdgcn_s_sleep(1);
        if ((++sp & 255u) == 0u) { if (xb_ld(&bar[XB_TMO])) break; if (sp > XB_SPIN_CAP) { atomicAdd(&bar[XB_TMO], 1u); break; } }
    }
    const unsigned mine = xb_ld(&bar[XB_XCNT(x)]);
    nloc = mine > 0u ? mine : 1u; nx = cnt > 0u ? cnt : 1u;
}
__device__ __forceinline__ void xcd_barrier(const XcdBarrier& b) {
    asm volatile("s_waitcnt vmcnt(0)" ::: "memory");
    __syncthreads();
    if (threadIdx.x == 0) {
        unsigned* bar = b.bar;
        __builtin_amdgcn_s_waitcnt(0);
        unsigned nloc = b.st[0], nx = b.st[1];
        if (nloc == 0u) { xcd_barrier_complete(bar, b.x, nloc, nx); b.st[0] = nloc; b.st[1] = nx; }
        const unsigned old = xb_add(&bar[XB_XSUB(b.x)], 1u);
        const unsigned gen = old / nloc;
        if (old + 1u == (gen + 1u) * nloc) {
            __builtin_amdgcn_fence(__ATOMIC_RELEASE, "agent");
            asm volatile("s_waitcnt vmcnt(0)" ::: "memory");
            const unsigned og = xb_add(&bar[XB_TOP], 1u);
            const unsigned tg = og / nx;
            if (og + 1u == (tg + 1u) * nx) xb_add(&bar[XB_TOPGEN], 1u);
            else XB_SPIN(xb_ld(&bar[XB_TOPGEN]) == tg, bar);
            __builtin_amdgcn_fence(__ATOMIC_ACQUIRE, "agent");
            xb_add(&bar[XB_XGEN(b.x)], 1u);
            asm volatile("s_waitcnt vmcnt(0)" ::: "memory");
        } else {
            XB_SPIN(xb_ld(&bar[XB_XGEN(b.x)]) == gen, bar);
            __builtin_amdgcn_fence(__ATOMIC_ACQUIRE, "agent");
            asm volatile("s_waitcnt vmcnt(0)" ::: "memory");
        }
    }
    __syncthreads();
}
namespace pg8 {
constexpr int BM = 256, BK = 64, HALF = 128, HTB = HALF * BK * 2, STAGE_BYTES = 8 * HTB;
__host__ __device__ __forceinline__ int lds_byte(int r, int c) { const int st = (r >> 4) * 2 + (c >> 5), rr = r & 15, cc = c & 31, ob = rr * 64 + cc * 2; return st * 1024 + (ob ^ (((ob >> 9) & 1) << 5)); }
__host__ __device__ __forceinline__ void stage_rc(int b, int& R, int& C) { const int st = b / 1024, sb = b % 1024, swz = sb ^ (((sb >> 9) & 1) << 5); R = (st >> 1) * 16 + swz / 64; C = (st & 1) * 32 + (swz % 64) / 2; }
__host__ __device__ __forceinline__ int perm32(int rho) { const int n = rho >> 4, i = rho & 15; return 8 * (i >> 2) + 4 * n + (i & 3); }
__host__ __device__ __forceinline__ int invperm32(int l) { return 16 * ((l >> 2) & 1) + 4 * (l >> 3) + (l & 3); }

struct Unit { unsigned A, B; int pm, pn, x0, x1; };
typedef f32x4 Acc[2][2][4][2];

template <class Epi, class Sched>
__device__ __forceinline__ void gemm_phase(LAS unsigned char* lds, const unsigned char* wsb, const Sched& S, const Epi& E) {
    int tid_ = threadIdx.x; asm volatile("" : "+v"(tid_));
    const int tid = tid_, wid = __builtin_amdgcn_readfirstlane(tid >> 6), lane = tid & 63, wr = wid >> 2, wc = wid & 3, fr = lane & 15, fq = lane >> 4;
    int nt_ = S.nt; asm volatile("" : "+s"(nt_)); const int nt = nt_;
    const unsigned kstepA = S.kstepA; constexpr unsigned kstepB = 128u;
    int sR[2], sC[2];
#pragma unroll
    for (int i = 0; i < 2; ++i) stage_rc(tid * 16 + i * 8192, sR[i], sC[i]);
    unsigned voffB[2], voC[2];
#pragma unroll
    for (int i = 0; i < 2; ++i) { voffB[i] = S.boff(sR[i], sC[i]); voC[i] = Sched::GATHER ? 0u : S.aoff(sR[i], sC[i]); }
    const unsigned hstepA = Sched::GATHER ? 0u : S.aoff(HALF, 0) - S.aoff(0, 0), hstepB = S.boff(HALF, 0) - S.boff(0, 0);
    const unsigned ldsw = (unsigned)wid * 1024u;
    const int aoff = lds_byte(wr * 64 + fr, fq * 8), boff = lds_byte(wc * 32 + fr, fq * 8);
#define PG8_SA(b, h) (((b) * 2 + (h)) * HTB)
#define PG8_SB(b, h) ((4 + (b) * 2 + (h)) * HTB)
#define PG8_STG(bufoff, gbase, v0, v1) do { \
        __builtin_amdgcn_global_load_lds((const unsigned*)(wsb + ((gbase) + (v0))), (LAS unsigned*)(lds + (bufoff) + ldsw), 16, 0, 0); \
        __builtin_amdgcn_global_load_lds((const unsigned*)(wsb + ((gbase) + (v1))), (LAS unsigned*)(lds + (bufoff) + ldsw + 8192), 16, 0, 0); } while (0)
#define PG8_STG_A(b, h, gbase, NR, IB) do { if constexpr (Sched::GATHER) { const unsigned v0_ = S.goff(NR, IB, lds, (h) * HALF + sR[0], sC[0]), v1_ = S.goff(NR, IB, lds, (h) * HALF + sR[1], sC[1]); PG8_STG(PG8_SA(b, h), gbase, v0_, v1_); } \
        else PG8_STG(PG8_SA(b, h), (gbase) + (h) * hstepA, voC[0], voC[1]); } while (0)
#define PG8_STG_B(b, h, gbase) PG8_STG(PG8_SB(b, h), (gbase) + (h) * hstepB, voffB[0], voffB[1])
#define PG8_LDA(dst, b, h) do { _Pragma("unroll") for (int m = 0; m < 4; ++m) _Pragma("unroll") for (int k = 0; k < 2; ++k) dst[m][k] = *(const LAS bf16x8*)(lds + PG8_SA(b, h) + aoff + m * 2048 + k * 1024); } while (0)
#define PG8_LDB(dst, b, h) do { _Pragma("unroll") for (int n = 0; n < 2; ++n) _Pragma("unroll") for (int k = 0; k < 2; ++k) dst[n][k] = *(const LAS bf16x8*)(lds + PG8_SB(b, h) + boff + n * 2048 + k * 1024); } while (0)
#define PG8_MMA(ai, bj, At, Bt) do { __builtin_amdgcn_s_setprio(1); _Pragma("unroll") for (int m = 0; m < 4; ++m) _Pragma("unroll") for (int n = 0; n < 2; ++n) _Pragma("unroll") for (int k = 0; k < 2; ++k) \
        acc[ai][bj][m][n] = __builtin_amdgcn_mfma_f32_16x16x32_bf16(Bt[n][k], At[m][k], acc[ai][bj][m][n], 0, 0, 0); __builtin_amdgcn_s_setprio(0); } while (0)
#define PG8_WAIT_V(n) asm volatile("s_waitcnt vmcnt(" #n ")" ::: "memory")
#define PG8_WAIT_L(n) asm volatile("s_waitcnt lgkmcnt(" #n ")" ::: "memory")
#define PG8_BAR __builtin_amdgcn_s_barrier()
#define PG8_SCHED __builtin_amdgcn_sched_barrier(0)
    Unit cur, nxt; int ui = 0;
    if (!S.next(0, cur)) return;
    Acc acc;
#pragma unroll
    for (int a = 0; a < 2; ++a)
#pragma unroll
        for (int b = 0; b < 2; ++b)
#pragma unroll
            for (int m = 0; m < 4; ++m)
#pragma unroll
                for (int n = 0; n < 2; ++n) acc[a][b][m][n] = (f32x4){0.f, 0.f, 0.f, 0.f};
    bf16x8 At[4][2], B0[2][2], B1[2][2];
    unsigned cA = cur.A, cB = cur.B;
    if constexpr (Sched::GATHER) { S.fetch(cur, 0, lds, wid, lane); PG8_WAIT_V(0); PG8_BAR; asm volatile("" ::: "memory"); }
    PG8_STG_B(0, 0, cB); PG8_STG_B(0, 1, cB); PG8_STG_A(0, 0, cA, cur.x1, 0); PG8_STG_A(0, 1, cA, cur.x1, 0);
    if (wr == 1) PG8_BAR;
    PG8_WAIT_V(2); PG8_BAR;
    PG8_STG_B(1, 0, cB + kstepB); PG8_STG_A(1, 0, cA + kstepA, cur.x1, 0); PG8_STG_B(1, 1, cB + kstepB);
    PG8_WAIT_V(6); PG8_BAR;
    for (;;) {
        const bool has_next = S.next(ui + 1, nxt);
        const unsigned nA = has_next ? nxt.A : cA, nB = has_next ? nxt.B : cB;
        if constexpr (Sched::GATHER) { if (has_next) S.fetch(nxt, (ui + 1) & 1, lds, wid, lane); }
#pragma unroll 1
        for (int t = 0; t < nt; t += 2) {
            const bool last = (t == nt - 2);
            const unsigned a1 = cA + (unsigned)(t + 1) * kstepA;
            const unsigned a2 = last ? nA : cA + (unsigned)(t + 2) * kstepA, b2 = last ? nB : cB + (unsigned)(t + 2) * kstepB;
            const unsigned a3 = a2 + kstepA, b3 = b2 + kstepB;
            const bool swn = last && has_next; const int nr1 = cur.x1, ib1 = ui & 1, nr2 = swn ? nxt.x1 : cur.x1, ib2 = swn ? ((ui + 1) & 1) : (ui & 1);
            PG8_LDB(B0, 0, 0); PG8_LDB(B1, 0, 1); PG8_SCHED; PG8_LDA(At, 0, 0); PG8_STG_A(1, 1, a1, nr1, ib1);
            PG8_WAIT_V(8); PG8_WAIT_L(0); PG8_BAR; PG8_MMA(0, 0, At, B0); PG8_MMA(0, 1, At, B1); PG8_BAR; PG8_SCHED;
            PG8_LDA(At, 0, 1); PG8_STG_B(0, 0, b2); PG8_STG_B(0, 1, b2); PG8_STG_A(0, 0, a2, nr2, ib2);
            PG8_WAIT_V(8); PG8_WAIT_L(0); PG8_BAR; PG8_MMA(1, 0, At, B0); PG8_MMA(1, 1, At, B1); PG8_BAR; PG8_SCHED;
            PG8_LDB(B0, 1, 0); PG8_LDB(B1, 1, 1); PG8_SCHED; PG8_LDA(At, 1, 0); PG8_STG_A(0, 1, a2, nr2, ib2);
            PG8_WAIT_V(8); PG8_WAIT_L(0); PG8_BAR; PG8_MMA(0, 0, At, B0); PG8_MMA(0, 1, At, B1); PG8_BAR; PG8_SCHED;
            PG8_LDA(At, 1, 1); PG8_STG_B(1, 0, b3); PG8_STG_B(1, 1, b3); PG8_STG_A(1, 0, a3, nr2, ib2);
            PG8_WAIT_V(8); PG8_WAIT_L(0); PG8_BAR; PG8_MMA(1, 0, At, B0); PG8_MMA(1, 1, At, B1); PG8_BAR; PG8_SCHED;
        }
        if (wr == 0) PG8_BAR;
        E(acc, cur, wr, wc, fr, fq);
        if (!has_next) break;
#pragma unroll
        for (int a = 0; a < 2; ++a)
#pragma unroll
            for (int b = 0; b < 2; ++b)
#pragma unroll
                for (int m = 0; m < 4; ++m)
#pragma unroll
                    for (int n = 0; n < 2; ++n) acc[a][b][m][n] = (f32x4){0.f, 0.f, 0.f, 0.f};
        cur = nxt; cA = nA; cB = nB; ++ui;
        if (wr == 1) PG8_BAR;
    }
    PG8_WAIT_V(0);
    PG8_BAR;
#undef PG8_SA
#undef PG8_SB
#undef PG8_STG
#undef PG8_STG_A
#undef PG8_STG_B
#undef PG8_LDA
#undef PG8_LDB
#undef PG8_MMA
#undef PG8_WAIT_V
#undef PG8_WAIT_L
#undef PG8_BAR
#undef PG8_SCHED
}

__device__ __forceinline__ int xcd_remap(int L, int nwg) { const int q = nwg / 8, r = nwg % 8, xcd = L % 8, off = L / 8; return (xcd < r ? xcd * (q + 1) : r * (q + 1) + (xcd - r) * q) + off; }
__device__ __forceinline__ void tile_of(int wgid, int nM, int nN, int& pm, int& pn) { const int WGM = 8; const int nig = WGM * nN, gid = wgid / nig, fm = gid * WGM, gsz = (nM - fm) < WGM ? (nM - fm) : WGM; pm = fm + ((wgid % nig) % gsz); pn = (wgid % nig) / gsz; }
}
namespace pg8 {
struct SchedDense {
    static constexpr bool GATHER = false;
    unsigned A, B, rsA, gsA, rsB, kstepA, tileA, tileB; int nt, nM, nN, G, c;
    __device__ __forceinline__ unsigned aoff(int row, int C) const { return (unsigned)row * rsA + (unsigned)(C >> 4) * gsA + (unsigned)(C & 15) * 2u; }
    __device__ __forceinline__ unsigned boff(int row, int C) const { return (unsigned)row * rsB + (unsigned)C * 2u; }
    __device__ __forceinline__ bool next(int i, Unit& u) const {
        const int nwg = nM * nN; const long L = (long)i * G + c; if (L >= nwg) return false;
        int pm, pn; tile_of(xcd_remap((int)L, nwg), nM, nN, pm, pn);
        u.A = A + (unsigned)pm * tileA; u.B = B + (unsigned)pn * tileB; u.pm = pm; u.pn = pn; u.x0 = 0; u.x1 = 0; return true;
    }
};
struct SchedInProj {
    static constexpr bool GATHER = false;
    unsigned U, Uc, W; int nt, G, c; static constexpr unsigned kstepA = 128u;
    __device__ __forceinline__ unsigned aoff(int row, int C) const { return (unsigned)row * 2048u + (unsigned)C * 2u; }
    __device__ __forceinline__ unsigned boff(int row, int C) const { return (unsigned)row * 2048u + (unsigned)C * 2u; }
    __device__ __forceinline__ bool next(int i, Unit& u) const {
        const long L = (long)i * G + c; const int NL = 256 * 18;
        if (L < NL) { int pm, pn; tile_of(xcd_remap((int)L, NL), 256, 18, pm, pn); u.A = U + (unsigned)pm * 256u * 2048u; u.B = W + (unsigned)pn * 256u * 2048u; u.pm = pm; u.pn = pn; u.x0 = 0; u.x1 = 0; return true; }
        const int j = (int)(L - NL); if (j >= 32 * 6) return false;
        const int pm = j / 6, q = j % 6, pn = q < 4 ? q : q + 4;
        u.A = Uc + (unsigned)pm * 256u * 2048u; u.B = W + (unsigned)pn * 256u * 2048u; u.pm = pm; u.pn = pn; u.x0 = 1; u.x1 = 0; return true;
    }
};
struct SchedGroup {
    static constexpr bool GATHER = false;
    unsigned A, B, rsA, rsB, grpA, grpB; int nt, mt, ntn, G, c; static constexpr unsigned kstepA = 128u;
    __device__ __forceinline__ unsigned aoff(int row, int C) const { return (unsigned)row * rsA + (unsigned)C * 2u; }
    __device__ __forceinline__ unsigned boff(int row, int C) const { return (unsigned)row * rsB + (unsigned)C * 2u; }
    __device__ __forceinline__ bool next(int i, Unit& u) const {
        const int per = mt * ntn, nwg = 64 * per; const long L = (long)i * G + c; if (L >= nwg) return false;
        const int w = xcd_remap((int)L, nwg), g = w / per, r = w % per, pm = r / ntn, pn = r % ntn;
        u.A = A + (unsigned)g * grpA + (unsigned)pm * 256u * rsA; u.B = B + (unsigned)g * grpB + (unsigned)pn * 256u * rsB; u.pm = pm; u.pn = pn; u.x0 = g; u.x1 = 0; return true;
    }
};
template <bool UP> struct SchedMoe {
    static constexpr bool GATHER = true;
    const int* tiles; int ntiles; unsigned A, B; const int* stok; int G, c; static constexpr unsigned kstepA = 128u; int nt;
    __device__ __forceinline__ unsigned aoff(int, int) const { return 0u; }
    __device__ __forceinline__ unsigned boff(int row, int C) const { return (unsigned)row * (UP ? 2048u : 512u) + (unsigned)C * 2u; }
    __device__ __forceinline__ bool next(int i, Unit& u) const {
        const int nN = UP ? 2 : 4, nwg = ntiles * nN; const long L = (long)i * G + c; if (L >= nwg) return false;
        const int w = xcd_remap((int)L, nwg), tile = w / nN, pn = w % nN;
        const int e = __builtin_amdgcn_readfirstlane(__hip_atomic_load(tiles + tile * 4 + 0, RLX_AGENT));
        const int row0 = __builtin_amdgcn_readfirstlane(__hip_atomic_load(tiles + tile * 4 + 1, RLX_AGENT));
        const int nrows = __builtin_amdgcn_readfirstlane(__hip_atomic_load(tiles + tile * 4 + 2, RLX_AGENT));
        if (UP) { u.A = A; u.B = B + ((unsigned)e * 512u + (unsigned)pn * 256u) * 2048u; }
        else    { u.A = A + (unsigned)row0 * 512u; u.B = B + ((unsigned)e * 1024u + (unsigned)pn * 256u) * 512u; }
        u.pm = row0; u.pn = pn; u.x0 = e; u.x1 = nrows; return true;
    }
    __device__ __forceinline__ void fetch(const Unit& u, int buf, LAS unsigned char* lds, int wid, int lane) const {
        if (UP) { if (wid < 4) __builtin_amdgcn_global_load_lds((const unsigned*)(stok + u.pm + wid * 64 + lane), (LAS unsigned*)(lds + IDX_OFF + buf * 1024 + wid * 256), 4, 0, 0); }
    }
    __device__ __forceinline__ unsigned goff(int nrows, int buf, LAS unsigned char* lds, int row, int C) const {
        const int r = row < nrows ? row : nrows - 1;
        if (UP) { const int tok = *(const LAS int*)(lds + IDX_OFF + buf * 1024 + r * 4); return (unsigned)tok * 2048u + (unsigned)C * 2u; }
        return (unsigned)r * 512u + (unsigned)C * 2u;
    }
};

__device__ __forceinline__ u32x4 pack8(const f32x4& a, const f32x4& b) { u32x4 w; w.x = cvt_pk_bf16(a[0], a[1]); w.y = cvt_pk_bf16(a[2], a[3]); w.z = cvt_pk_bf16(b[0], b[1]); w.w = cvt_pk_bf16(b[2], b[3]); return w; }
__device__ __forceinline__ void unpack8(const u32x4& w, f32x4& a, f32x4& b) { a = (f32x4){bflo(w.x), bfhi(w.x), bflo(w.y), bfhi(w.y)}; b = (f32x4){bflo(w.z), bfhi(w.z), bflo(w.w), bfhi(w.w)}; }

struct EpiInProj {
    bf16_t *saug, *q, *k, *v, *gs, *ga; const float *rope, *qg, *kg;
    __device__ __forceinline__ void operator()(const Acc& acc, const Unit& u, int wr, int wc, int fr, int fq) const {
        const int pn = u.pn; const bool ctx = u.x0 != 0;
        if (pn < 4) {
#pragma unroll
            for (int ai = 0; ai < 2; ++ai)
#pragma unroll
                for (int m = 0; m < 4; ++m) {
                    const int r = u.pm * 256 + ai * 128 + wr * 64 + m * 16 + fr;
                    int b, l; if (!ctx) { b = r >> 11; l = r & 2047; } else { b = r >> 8; l = r & 255; }
                    const int grow = ctx ? 2048 + b * 8 + (l >> 5) : b * 64 + (l >> 5), t = l & 31;
#pragma unroll
                    for (int bj = 0; bj < 2; ++bj) { const int col = pn * 256 + bj * 128 + wc * 32 + fq * 8, g = col >> 4, c0 = col & 15;
                        *(u32x4*)(saug + ((size_t)(g * ROWS_G + grow) * KAUG + t * 16 + c0)) = pack8(acc[ai][bj][m][0], acc[ai][bj][m][1]); }
                }
        } else if (pn < 9) {
            const bool isq = pn < 8; const float* gv = isq ? qg : kg;
            f32x4 g4[2][2];
#pragma unroll
            for (int bj = 0; bj < 2; ++bj)
#pragma unroll
                for (int n = 0; n < 2; ++n) g4[bj][n] = *(const f32x4*)(gv + bj * 32 + n * 16 + fq * 4);
            const float osc = isq ? C2Q : 1.f;
#pragma unroll
            for (int ai = 0; ai < 2; ++ai)
#pragma unroll
                for (int m = 0; m < 4; ++m) {
                    const int r = u.pm * 256 + ai * 128 + wr * 64 + m * 16 + fr;
                    int b, l; if (!ctx) { b = r >> 11; l = r & 2047; } else { b = r >> 8; l = r & 255; }
                    float ss = 0.f;
#pragma unroll
                    for (int bj = 0; bj < 2; ++bj)
#pragma unroll
                        for (int n = 0; n < 2; ++n) { const f32x4 x = acc[ai][bj][m][n]; ss += (x[0] * x[0] + x[1] * x[1]) + (x[2] * x[2] + x[3] * x[3]); }
                    ss += __shfl_xor(ss, 16); ss += __shfl_xor(ss, 32);
                    const float rstd = 1.0f / sqrtf(ss * (1.0f / 64.0f) + 1e-6f) * osc;
                    bf16_t* dst = isq ? q + ((size_t)r * 1024 + (4 * (pn - 4) + wc) * 64 + fq * 16)
                                      : k + ((size_t)(b * SKV + (ctx ? l : CTX + l)) * 256 + wc * 64 + fq * 16);
#pragma unroll
                    for (int bj = 0; bj < 2; ++bj) {
                        f32x4 a = acc[ai][bj][m][0] * g4[bj][0] * rstd, bb = acc[ai][bj][m][1] * g4[bj][1] * rstd;
                        if (!ctx) {
                            const int pos = bj == 0 ? (l >> 6) : (l & 63);
                            const f32x4 c0 = *(const f32x4*)(rope + (pos * 16 + fq * 4) * 2), c1 = *(const f32x4*)(rope + (pos * 16 + fq * 4) * 2 + 4);
                            const f32x4 cs = (f32x4){c0[0], c0[2], c1[0], c1[2]}, sn = (f32x4){c0[1], c0[3], c1[1], c1[3]};
                            const f32x4 o1 = a * cs - bb * sn, o2 = a * sn + bb * cs; a = o1; bb = o2;
                        }
                        *(u32x4*)(dst + bj * 8) = pack8(a, bb);
                    }
                }
        } else if (pn == 9) {
#pragma unroll
            for (int ai = 0; ai < 2; ++ai)
#pragma unroll
                for (int m = 0; m < 4; ++m) {
                    const int r = u.pm * 256 + ai * 128 + wr * 64 + m * 16 + fr;
                    int b, l; if (!ctx) { b = r >> 11; l = r & 2047; } else { b = r >> 8; l = r & 255; }
                    bf16_t* dst = v + ((size_t)(b * SKV + (ctx ? l : CTX + l)) * 256 + wc * 32 + fq * 8);
#pragma unroll
                    for (int bj = 0; bj < 2; ++bj) *(u32x4*)(dst + bj * 128) = pack8(acc[ai][bj][m][0], acc[ai][bj][m][1]);
                }
        } else {
            bf16_t* base = pn < 14 ? gs + (pn - 10) * 256 : ga + (pn - 14) * 256;
#pragma unroll
            for (int ai = 0; ai < 2; ++ai)
#pragma unroll
                for (int m = 0; m < 4; ++m) {
                    const int r = u.pm * 256 + ai * 128 + wr * 64 + m * 16 + fr;
                    bf16_t* dst = base + ((size_t)r * 1024 + wc * 32 + fq * 8);
#pragma unroll
                    for (int bj = 0; bj < 2; ++bj) { f32x4 a = acc[ai][bj][m][0], bb = acc[ai][bj][m][1];
#pragma unroll
                        for (int j = 0; j < 4; ++j) { a[j] = sigmoidf_(a[j]); bb[j] = sigmoidf_(bb[j]); }
                        *(u32x4*)(dst + bj * 128) = pack8(a, bb); }
                }
        }
    }
};
struct EpiF32 {
    float* C; int ldc; size_t grp;
    __device__ __forceinline__ void operator()(const Acc& acc, const Unit& u, int wr, int wc, int fr, int fq) const {
        float* base = C + (size_t)u.x0 * grp + (size_t)(u.pm * 256 + wr * 64 + fr) * ldc + u.pn * 256 + wc * 32 + fq * 8;
#pragma unroll
        for (int ai = 0; ai < 2; ++ai)
#pragma unroll
            for (int m = 0; m < 4; ++m)
#pragma unroll
                for (int bj = 0; bj < 2; ++bj) { float* p = base + (size_t)(ai * 128 + m * 16) * ldc + bj * 128; *(f32x4*)p = acc[ai][bj][m][0]; *(f32x4*)(p + 4) = acc[ai][bj][m][1]; }
    }
};
template <int ACT> struct EpiBf16 {
    bf16_t* O; int ldc; size_t grp;
    __device__ __forceinline__ void operator()(const Acc& acc, const Unit& u, int wr, int wc, int fr, int fq) const {
        bf16_t* base = O + (size_t)u.x0 * grp + (size_t)(u.pm * 256 + wr * 64 + fr) * ldc + u.pn * 256 + wc * 32 + fq * 8;
#pragma unroll
        for (int ai = 0; ai < 2; ++ai)
#pragma unroll
            for (int m = 0; m < 4; ++m)
#pragma unroll
                for (int bj = 0; bj < 2; ++bj) { f32x4 a = acc[ai][bj][m][0], b = acc[ai][bj][m][1];
                    if (ACT == 1) {
#pragma unroll
                        for (int j = 0; j < 4; ++j) { a[j] = gelu_tanh(a[j]); b[j] = gelu_tanh(b[j]); } }
                    *(u32x4*)(base + (size_t)(ai * 128 + m * 16) * ldc + bj * 128) = pack8(a, b); }
    }
};
template <int MODE> struct EpiGate {
    const bf16_t* G; bf16_t* O;
    __device__ __forceinline__ void operator()(const Acc& acc, const Unit& u, int wr, int wc, int fr, int fq) const {
#pragma unroll
        for (int ai = 0; ai < 2; ++ai)
#pragma unroll
            for (int m = 0; m < 4; ++m) {
                const int r = u.pm * 256 + ai * 128 + wr * 64 + m * 16 + fr;
#pragma unroll
                for (int bj = 0; bj < 2; ++bj) {
                    const int col = u.pn * 256 + bj * 128 + wc * 32 + fq * 8;
                    f32x4 a = acc[ai][bj][m][0], b = acc[ai][bj][m][1], ga, gb;
                    bf16_t* op = O + (size_t)r * 1024 + col;
                    if (MODE == 0) { unpack8(*(const u32x4*)(G + ((size_t)(col >> 4) * T + r) * 16 + (col & 15)), ga, gb);
#pragma unroll
                        for (int j = 0; j < 4; ++j) { a[j] = ga[j] * sigmoidf_(a[j]); b[j] = gb[j] * sigmoidf_(b[j]); } }
                    else { unpack8(*(const u32x4*)(G + (size_t)r * 1024 + col), ga, gb); a = a * ga; b = b * gb;
                        if (MODE == 2) { f32x4 pa, pb; unpack8(*(const u32x4*)op, pa, pb); a = a + pa; b = b + pb; } }
                    *(u32x4*)op = pack8(a, b);
                }
            }
    }
};
struct EpiOut {
    const float* x; const float* mod; bf16_t* O;
    __device__ __forceinline__ void operator()(const Acc& acc, const Unit& u, int wr, int wc, int fr, int fq) const {
#pragma unroll
        for (int ai = 0; ai < 2; ++ai)
#pragma unroll
            for (int m = 0; m < 4; ++m) {
                const int r = u.pm * 256 + ai * 128 + wr * 64 + m * 16 + fr; const float* g1 = mod + (size_t)(r >> 11) * 6144 + 2048;
#pragma unroll
                for (int bj = 0; bj < 2; ++bj) {
                    const int col = u.pn * 256 + bj * 128 + wc * 32 + fq * 8;
                    const f32x4 x0 = *(const f32x4*)(x + (size_t)r * 1024 + col), x1 = *(const f32x4*)(x + (size_t)r * 1024 + col + 4);
                    const f32x4 g0 = *(const f32x4*)(g1 + col), g1v = *(const f32x4*)(g1 + col + 4);
                    *(u32x4*)(O + (size_t)r * 1024 + col) = pack8(x0 * ALPHA + g0 * acc[ai][bj][m][0], x1 * ALPHA + g1v * acc[ai][bj][m][1]);
                }
            }
    }
};
template <bool UP> struct EpiMoe {
    bf16_t* O;
    __device__ __forceinline__ void operator()(const Acc& acc, const Unit& u, int wr, int wc, int fr, int fq) const {
#pragma unroll
        for (int ai = 0; ai < 2; ++ai)
#pragma unroll
            for (int m = 0; m < 4; ++m) {
                const int r = ai * 128 + wr * 64 + m * 16 + fr;
                if (r < u.x1) {
                    if (UP) { f32x4 a = acc[ai][0][m][0], b = acc[ai][0][m][1];
#pragma unroll
                        for (int j = 0; j < 4; ++j) { a[j] = silu_(a[j]) * acc[ai][1][m][0][j]; b[j] = silu_(b[j]) * acc[ai][1][m][1][j]; }
                        *(u32x4*)(O + (size_t)(u.pm + r) * 256 + u.pn * 128 + wc * 32 + fq * 8) = pack8(a, b);
                    } else {
#pragma unroll
                        for (int bj = 0; bj < 2; ++bj) *(u32x4*)(O + (size_t)(u.pm + r) * 1024 + u.pn * 256 + bj * 128 + wc * 32 + fq * 8) = pack8(acc[ai][bj][m][0], acc[ai][bj][m][1]);
                    }
                }
            }
    }
};
}
#include <hip/hip_bf16.h>
#include <cmath>
namespace attn_body {
using bf16=__hip_bfloat16;
using bf16x8=__attribute__((ext_vector_type(8)))short;
using s16x4=__attribute__((ext_vector_type(4)))short;
using f32x16=__attribute__((ext_vector_type(16)))float;
using u32x4=__attribute__((ext_vector_type(4)))unsigned;
constexpr int NHEAD=16,SEQ=2048,SKVA=2304,D=64,DM=NHEAD*D,DKV=256;
constexpr int NW=8,QBLK=32,QB=QBLK*NW,KVBLK=64,NQB=SEQ/QB;
constexpr int ATTN_PITCH=DM, ATTN_UNIT_ROWS=QB;
__device__ __forceinline__ int crow(int r,int hi){return (r&3)+8*(r>>2)+4*hi;}
#define SBAR() __builtin_amdgcn_sched_barrier(0)
__device__ __forceinline__ void cmask(f32x16&p0,f32x16&p1,int jb,int qrel,int hi){
  const float NEG=-INFINITY; int kb=64*jb+4*hi;
  #pragma unroll
  for(int r=0;r<16;++r){int kv=kb+(r&3)+8*(r>>2); if(kv>qrel)p0[r]=NEG; if(kv+32>qrel)p1[r]=NEG;}
}

constexpr int NSLOT=3, SLOTB=8192;
constexpr int LDS_K=0, LDS_V=NSLOT*SLOTB, LDS_WS=2*NSLOT*SLOTB, LDS_OST=LDS_WS+NW*64*4, LDS_BYTES=LDS_OST+NW*4096;
constexpr float C2=0.125f*1.4426950408889634f;
__device__ __forceinline__ void glds16(const void*gsrc,unsigned lds_dst){unsigned keep;
  asm volatile("s_mov_b32 %0, m0\n\ts_mov_b32 m0, %2\n\ts_nop 0\n\tglobal_load_lds_dwordx4 %1, off\n\ts_mov_b32 m0, %0":"=&s"(keep):"v"(gsrc),"s"(lds_dst):"memory");}
__device__ __forceinline__ float max3f(float a,float b,float c){float r;asm("v_max3_f32 %0, %1, %2, %3":"=v"(r):"v"(a),"v"(b),"v"(c));return r;}
__device__ __forceinline__ float max2f(float a,float b){float r;asm("v_max_f32_e32 %0, %1, %2":"=v"(r):"v"(a),"v"(b));return r;}
__device__ __forceinline__ float fadd_s(float a,float b){float r;asm("v_add_f32_e32 %0, %1, %2":"=v"(r):"v"(a),"v"(b));return r;}
__device__ __forceinline__ float fsub_s(float a,float b){float r;asm("v_sub_f32_e32 %0, %1, %2":"=v"(r):"v"(a),"v"(b));return r;}
typedef float f32x2_t __attribute__((ext_vector_type(2))); typedef __bf16 bf16x2_t __attribute__((ext_vector_type(2)));
__device__ __forceinline__ unsigned cvtpk_s(float lo,float hi){f32x2_t v={lo,hi};bf16x2_t b=__builtin_convertvector(v,bf16x2_t);return __builtin_bit_cast(unsigned,b);}
#define WAIT_BAR(N) asm volatile("s_waitcnt vmcnt(" #N ") lgkmcnt(0)\n\ts_barrier":::"memory")

__device__ __forceinline__ void qkt(f32x16&p0,f32x16&p1,const char*Kslot,const bf16x8*qr,const f32x16&negm,int r32,int hi){
  const char*kb=Kslot+hi*1024+r32*16;
  #pragma unroll
  for(int d0=0;d0<4;++d0){
    const bf16x8 b0=*reinterpret_cast<const bf16x8*>(kb+d0*2048);
    const bf16x8 b1=*reinterpret_cast<const bf16x8*>(kb+d0*2048+512);
    if(d0==0){p0=__builtin_amdgcn_mfma_f32_32x32x16_bf16(b0,qr[0],negm,0,0,0);p1=__builtin_amdgcn_mfma_f32_32x32x16_bf16(b1,qr[0],negm,0,0,0);}
    else{p0=__builtin_amdgcn_mfma_f32_32x32x16_bf16(b0,qr[d0],p0,0,0,0);p1=__builtin_amdgcn_mfma_f32_32x32x16_bf16(b1,qr[d0],p1,0,0,0);}}
}
typedef __attribute__((address_space(3))) const char* lds_cptr;
typedef short v4i16_t __attribute__((ext_vector_type(4)));
__device__ __forceinline__ void kload8(bf16x8*kf,lds_cptr kp){
  kf[0]=*(const __attribute__((address_space(3))) bf16x8*)(kp);      kf[1]=*(const __attribute__((address_space(3))) bf16x8*)(kp+512);
  kf[2]=*(const __attribute__((address_space(3))) bf16x8*)(kp+2048); kf[3]=*(const __attribute__((address_space(3))) bf16x8*)(kp+2560);
  kf[4]=*(const __attribute__((address_space(3))) bf16x8*)(kp+4096); kf[5]=*(const __attribute__((address_space(3))) bf16x8*)(kp+4608);
  kf[6]=*(const __attribute__((address_space(3))) bf16x8*)(kp+6144); kf[7]=*(const __attribute__((address_space(3))) bf16x8*)(kp+6656);
}
__device__ __forceinline__ void kload2(bf16x8*kf,lds_cptr kp,int j){ kf[2*j]=*(const __attribute__((address_space(3))) bf16x8*)(kp+j*2048); kf[2*j+1]=*(const __attribute__((address_space(3))) bf16x8*)(kp+j*2048+512); }
__device__ __forceinline__ s16x4 vtr(lds_cptr p){ return __builtin_bit_cast(s16x4,__builtin_amdgcn_ds_read_tr16_b64_v4i16((__attribute__((address_space(3))) v4i16_t*)p)); }
__device__ __forceinline__ float rowmax(const f32x16&p0,const f32x16&p1){
  float a=max3f(p0[0],p0[1],p1[0]),b=max3f(p0[2],p0[3],p1[1]);a=max3f(a,p1[2],p1[3]);
  #pragma unroll
  for(int r=4;r<16;r+=4){a=max3f(a,p0[r],p0[r+1]);b=max3f(b,p0[r+2],p0[r+3]);a=max3f(a,p1[r],p1[r+1]);b=max3f(b,p1[r+2],p1[r+3]);}
  const float m=max2f(a,b);
  auto rr=__builtin_amdgcn_permlane32_swap(__float_as_uint(m),__float_as_uint(m),false,false);
  return max2f(__uint_as_float(rr[0]),__uint_as_float(rr[1]));
}
__device__ __forceinline__ void pv(f32x16*o,int vb,bf16x8 pa0,bf16x8 pa1,bf16x8 pa2,bf16x8 pa3){
  #pragma unroll
  for(int d0=0;d0<2;++d0){s16x4 lo[4],hi[4];
    #pragma unroll
    for(int ks=0;ks<4;++ks){
      asm volatile("ds_read_b64_tr_b16 %0,%1 offset:%c2":"=&v"(lo[ks]):"v"(vb),"i"(d0*4096+ks*1024):"memory");
      asm volatile("ds_read_b64_tr_b16 %0,%1 offset:%c2":"=&v"(hi[ks]):"v"(vb),"i"(d0*4096+ks*1024+512):"memory");}
    asm volatile("s_waitcnt lgkmcnt(0)":::"memory");SBAR();
    #define PK(k) (bf16x8){lo[k][0],lo[k][1],lo[k][2],lo[k][3],hi[k][0],hi[k][1],hi[k][2],hi[k][3]}
    o[d0]=__builtin_amdgcn_mfma_f32_32x32x16_bf16(pa0,PK(0),o[d0],0,0,0);
    o[d0]=__builtin_amdgcn_mfma_f32_32x32x16_bf16(pa1,PK(1),o[d0],0,0,0);
    o[d0]=__builtin_amdgcn_mfma_f32_32x32x16_bf16(pa2,PK(2),o[d0],0,0,0);
    o[d0]=__builtin_amdgcn_mfma_f32_32x32x16_bf16(pa3,PK(3),o[d0],0,0,0);
    #undef PK
  }
}

#ifndef ATTN_STORE16
#define ATTN_STORE16(p,v) (*(u32x4*)(p)=(v))
#endif
template<int THRL> __device__ __forceinline__ void attn_unit(int b,int h,int qb,const bf16*Q,const bf16*__restrict__ K,const bf16*__restrict__ V,bf16*O,char*shm){
  int tid_=threadIdx.x; asm volatile("":"+v"(tid_)); const int tid=tid_,lane=tid&63,r32=lane&31,hi=lane>>5; const int wid=__builtin_amdgcn_readfirstlane(tid>>6);
  const long rowbase=(long)b*SEQ; const long kvbase=(long)b*SKVA; const int q0=qb*QB;
  const bf16*Qw=Q+(rowbase+q0+wid*QBLK)*DM+h*D;
  const bf16*Kh=K+kvbase*DKV+(h>>2)*D,*Vh=V+kvbase*DKV+(h>>2)*D;
  const unsigned lds0=(unsigned)(uintptr_t)shm;
  float*wsf=(float*)(shm+LDS_WS)+wid*64;
  const bf16*ksrc=Kh+(long)lane*DKV+wid*8;
  const bf16*vsrc=Vh+(long)(16*(wid&3)+(lane>>2))*DKV+(wid>>2)*32+(lane&3)*8;
  const unsigned kdst=lds0+LDS_K+wid*1024, vdst=lds0+LDS_V+wid*1024;
  #define DMA_K(t,slot) glds16(ksrc+(long)(t)*KVBLK*DKV,(unsigned)__builtin_amdgcn_readfirstlane(kdst+(slot)))
  #define DMA_V(t,slot) glds16(vsrc+(long)(t)*KVBLK*DKV,(unsigned)__builtin_amdgcn_readfirstlane(vdst+(slot)))
  const int vb0=(int)(lds0+LDS_V)+((lane>>4)&1)*32+(lane&3)*8+(4*hi+((lane&15)>>2))*64;
  const char*Kbase=shm+LDS_K; bf16x8 kf[8];
  const lds_cptr shm3=(lds_cptr)shm; const lds_cptr kp0=shm3+LDS_K+hi*1024+r32*16; const lds_cptr vp0=shm3+LDS_V+((lane>>4)&1)*32+(lane&3)*8+(4*hi+((lane&15)>>2))*64;
  const int NT=SKVA/KVBLK;
  DMA_K(0,0);DMA_V(0,0);DMA_K(1,SLOTB);
  bf16x8 qr[4];
  #pragma unroll
  for(int d0=0;d0<4;++d0)qr[d0]=*reinterpret_cast<const bf16x8*>(&Qw[(long)r32*DM+d0*16+hi*8]);
  float mhat=0.f,l_reg=0.f;f32x16 o[2];o[0]=f32x16{};o[1]=f32x16{};f32x16 negm=f32x16{};asm volatile("":"+v"(negm));
  #define CMASK(P0,P1,t) do{}while(0)
  bool resc=false;
  #define START(P0,P1) do{ const float rm=rowmax(P0,P1); resc=false; \
    { const float dl=rm; mhat=fadd_s(mhat,dl); \
      _Pragma("unroll") for(int r=0;r<16;++r){P0[r]=fsub_s(P0[r],dl);P1[r]=fsub_s(P1[r],dl);} \
      _Pragma("unroll") for(int r=0;r<16;++r)negm[r]=-mhat; asm volatile("":"+v"(negm)); } \
    _Pragma("unroll") for(int r=0;r<16;++r)P0[r]=__builtin_amdgcn_exp2f(P0[r]); }while(0)
  #define RESC() do{ if(resc){ asm volatile("s_waitcnt lgkmcnt(0)":::"memory"); \
      _Pragma("unroll") for(int d_=0;d_<2;++d_) _Pragma("unroll") for(int r=0;r<16;++r)o[d_][r]*=wsf[crow(r,hi)]; } }while(0)
  f32x16 pA0,pA1,pB0,pB1;
  int sl_prev=0,sl_cur=0,sl_next=SLOTB;
  #define ROT() do{sl_prev=sl_cur;sl_cur=sl_next;sl_next=(sl_next==(NSLOT-1)*SLOTB)?0:sl_next+SLOTB;}while(0)
  DMA_K(2,2*SLOTB);
  WAIT_BAR(3);
  qkt(pA0,pA1,Kbase,qr,negm,r32,hi);asm volatile("s_nop 15\n\ts_nop 7":"+v"(pA0),"+v"(pA1));CMASK(pA0,pA1,0);
  START(pA0,pA1);
  _Pragma("unroll") for(int r=0;r<16;++r)pA1[r]=__builtin_amdgcn_exp2f(pA1[r]);
  WAIT_BAR(0);
  DMA_K(3,0);DMA_V(1,SLOTB);
  ROT();
  kload8(kf,kp0+sl_cur);
  WAIT_BAR(2);
  s16x4 vlo[8],vhi[8]; u32x4 pw0,pw1,pw2,pw3;
  #define PKW(P,B) cvtpk_s(P[B],P[B+1])
  #define PAF(k) __builtin_bit_cast(bf16x8,pw##k)
  #define VFR(i) (bf16x8){vlo[i][0],vlo[i][1],vlo[i][2],vlo[i][3],vhi[i][0],vhi[i][1],vhi[i][2],vhi[i][3]}
  #define PIN(x) asm volatile("":"+v"(x))
  #define MX3(a,b,c) __builtin_fmaxf(__builtin_fmaxf((a),(b)),(c))
  #define GAPA(MF,A0,A1,A2,A3,W0,W1,PW) do{ MF; sacc+=A0; sacc+=A1; sacc+=A2; sacc+=A3; PIN(sacc); W0; W1; PIN(PW); SBAR(); }while(0)
  #define EX(v) __builtin_amdgcn_exp2f(v)
  #define GAPB(MF,X,B) do{ MF; X[B]=EX(X[B]); X[B+1]=EX(X[B+1]); X[B+2]=EX(X[B+2]); X[B+3]=EX(X[B+3]); PIN(X); SBAR(); }while(0)
  #define VRD(i) do{ vlo[i]=vtr(vp_+(((i)>>2)*4096+((i)&3)*1024)); vhi[i]=vtr(vp_+(((i)>>2)*4096+((i)&3)*1024+512)); }while(0)
  #define KRD(G,j) do{ if(G){ kload2(kf,kp0+sl_next,j); SBAR(); } }while(0)
  #define STEP(C0,C1,P0,P1,t,GK,GV,GL) do{ SBAR(); \
    const lds_cptr vp_=vp0+sl_prev; \
    VRD(0); SBAR(); float sacc=(P0[0]+P0[1]); \
    GAPA(C0=__builtin_amdgcn_mfma_f32_32x32x16_bf16(kf[0],qr[0],negm,0,0,0), P0[2],P0[3],P0[4],P0[5],     pw0[0]=PKW(P0,0), pw0[1]=PKW(P0,2), pw0); \
    VRD(4); SBAR(); GAPA(C1=__builtin_amdgcn_mfma_f32_32x32x16_bf16(kf[1],qr[0],negm,0,0,0), P0[6],P0[7],P0[8],P0[9],     pw0[2]=PKW(P0,4), pw0[3]=PKW(P0,6), pw0); \
    VRD(1); SBAR(); GAPA(C0=__builtin_amdgcn_mfma_f32_32x32x16_bf16(kf[2],qr[1],C0,0,0,0),   P0[10],P0[11],P0[12],P0[13], pw1[0]=PKW(P0,8), pw1[1]=PKW(P0,10), pw1); \
    VRD(5); SBAR(); GAPA(C1=__builtin_amdgcn_mfma_f32_32x32x16_bf16(kf[3],qr[1],C1,0,0,0),   P0[14],P0[15],P1[0],P1[1],   pw1[2]=PKW(P0,12),pw1[3]=PKW(P0,14), pw1); \
    VRD(2); SBAR(); GAPA(C0=__builtin_amdgcn_mfma_f32_32x32x16_bf16(kf[4],qr[2],C0,0,0,0),   P1[2],P1[3],P1[4],P1[5],     pw2[0]=PKW(P1,0), pw2[1]=PKW(P1,2), pw2); \
    VRD(6); SBAR(); GAPA(C1=__builtin_amdgcn_mfma_f32_32x32x16_bf16(kf[5],qr[2],C1,0,0,0),   P1[6],P1[7],P1[8],P1[9],     pw2[2]=PKW(P1,4), pw2[3]=PKW(P1,6), pw2); \
    VRD(3); SBAR(); GAPA(C0=__builtin_amdgcn_mfma_f32_32x32x16_bf16(kf[6],qr[3],C0,0,0,0),   P1[10],P1[11],P1[12],P1[13], pw3[0]=PKW(P1,8), pw3[1]=PKW(P1,10), pw3); \
    VRD(7); SBAR(); GAPA(C1=__builtin_amdgcn_mfma_f32_32x32x16_bf16(kf[7],qr[3],C1,0,0,0),   P1[14],P1[15],0.f,0.f,       pw3[2]=PKW(P1,12),pw3[3]=PKW(P1,14), pw3); \
    l_reg+=sacc; \
    if(GK){DMA_K((t)+3,sl_cur);} if(GV){DMA_V((t)+1,sl_next);} \
    CMASK(C0,C1,t); \
    { float a=MX3(C0[0],C0[1],C1[0]),b=MX3(C0[2],C0[3],C1[1]); a=MX3(a,C1[2],C1[3]); \
      _Pragma("unroll") for(int r=4;r<16;r+=4){a=MX3(a,C0[r],C0[r+1]);b=MX3(b,C0[r+2],C0[r+3]);a=MX3(a,C1[r],C1[r+1]);b=MX3(b,C1[r+2],C1[r+3]);} \
      float rm=__builtin_fmaxf(a,b); { auto rr=__builtin_amdgcn_permlane32_swap(__float_as_uint(rm),__float_as_uint(rm),false,false); rm=__builtin_fmaxf(__uint_as_float(rr[0]),__uint_as_float(rr[1])); } \
      resc=false; \
      if(__builtin_expect(__any(rm>(float)THRL),0)){ const float dl=__builtin_fmaxf(rm,0.f); mhat+=dl; \
        _Pragma("unroll") for(int r=0;r<16;++r){C0[r]-=dl;C1[r]-=dl;} \
        _Pragma("unroll") for(int r=0;r<16;++r)negm[r]=-mhat; asm volatile("":"+v"(negm)); \
        const float f=__builtin_amdgcn_exp2f(-dl); l_reg*=f; if(hi==0)wsf[r32]=f; resc=true; } } \
    SBAR(); \
    GAPB(o[0]=__builtin_amdgcn_mfma_f32_32x32x16_bf16(PAF(0),VFR(0),o[0],0,0,0), C0,0); \
    GAPB(o[1]=__builtin_amdgcn_mfma_f32_32x32x16_bf16(PAF(0),VFR(4),o[1],0,0,0), C0,4); \
    KRD(GL,0); GAPB(o[0]=__builtin_amdgcn_mfma_f32_32x32x16_bf16(PAF(1),VFR(1),o[0],0,0,0), C0,8); \
    KRD(GL,1); GAPB(o[1]=__builtin_amdgcn_mfma_f32_32x32x16_bf16(PAF(1),VFR(5),o[1],0,0,0), C0,12); \
    KRD(GL,2); GAPB(o[0]=__builtin_amdgcn_mfma_f32_32x32x16_bf16(PAF(2),VFR(2),o[0],0,0,0), C1,0); \
    KRD(GL,3); GAPB(o[1]=__builtin_amdgcn_mfma_f32_32x32x16_bf16(PAF(2),VFR(6),o[1],0,0,0), C1,4); \
    GAPB(o[0]=__builtin_amdgcn_mfma_f32_32x32x16_bf16(PAF(3),VFR(3),o[0],0,0,0), C1,8); \
    GAPB(o[1]=__builtin_amdgcn_mfma_f32_32x32x16_bf16(PAF(3),VFR(7),o[1],0,0,0), C1,12); \
    }while(0)
  int t=1;
  #undef CMASK
  #define CMASK(P0,P1,t) do{}while(0)
  for(;t+5<NT;t+=2){
    STEP(pB0,pB1,pA0,pA1,t,true,true,true);     WAIT_BAR(2); RESC(); ROT();
    STEP(pA0,pA1,pB0,pB1,t+1,true,true,true);   WAIT_BAR(2); RESC(); ROT();
  }
  #undef CMASK
  #define CMASK(P0,P1,t) do{}while(0)
  #define ENDW(tt) do{ if((tt)+3<NT){WAIT_BAR(2);} else if((tt)+2<NT){WAIT_BAR(1);} else {WAIT_BAR(0);} }while(0)
  for(;t+1<NT;t+=2){
    STEP(pB0,pB1,pA0,pA1,t,(t+3<NT),(t+1<NT),(t+1<NT));       ENDW(t);   RESC(); ROT();
    STEP(pA0,pA1,pB0,pB1,t+1,(t+4<NT),(t+2<NT),(t+2<NT));     ENDW(t+1); RESC(); ROT();
  }
  STEP(pB0,pB1,pA0,pA1,NT-1,false,false,false); RESC();
  { float sacc=pB0[0]+pB0[1]; _Pragma("unroll") for(int r=2;r<16;++r)sacc+=pB0[r]; _Pragma("unroll") for(int r=0;r<16;++r)sacc+=pB1[r]; l_reg+=sacc;
    pw0=(u32x4){PKW(pB0,0),PKW(pB0,2),PKW(pB0,4),PKW(pB0,6)};pw1=(u32x4){PKW(pB0,8),PKW(pB0,10),PKW(pB0,12),PKW(pB0,14)};pw2=(u32x4){PKW(pB1,0),PKW(pB1,2),PKW(pB1,4),PKW(pB1,6)};pw3=(u32x4){PKW(pB1,8),PKW(pB1,10),PKW(pB1,12),PKW(pB1,14)};
    SBAR(); pv(o,vb0+sl_cur,PAF(0),PAF(1),PAF(2),PAF(3)); }
  #undef PKW
  #undef PAF
  #undef VFR
  #undef PIN
  #undef MX3
  #undef GAPA
  #undef GAPB
  #undef EX
  #undef VRD
  #undef KRD
  #undef STEP
  #undef ENDW
  {auto rr=__builtin_amdgcn_permlane32_swap(__float_as_uint(l_reg),__float_as_uint(l_reg),false,false);l_reg=__uint_as_float(rr[0])+__uint_as_float(rr[1]);}
  if(hi==0)wsf[32+r32]=l_reg;asm volatile("s_waitcnt lgkmcnt(0)":::"memory");
  float rli[16];
  #pragma unroll
  for(int r=0;r<16;++r)rli[r]=__builtin_amdgcn_rcpf(wsf[32+crow(r,hi)]);
  bf16*Ow=O+(rowbase+q0+wid*QBLK)*DM+h*D;
  { bf16*stg=(bf16*)(shm+LDS_OST)+wid*2048;
    #pragma unroll
    for(int r=0;r<16;++r){const int orow=crow(r,hi);
      #pragma unroll
      for(int d0=0;d0<2;++d0)stg[orow*64+d0*32+r32]=__float2bfloat16(o[d0][r]*rli[r]);}
    asm volatile("s_waitcnt lgkmcnt(0)":::"memory");
    #pragma unroll
    for(int i=0;i<4;++i){const int row=i*8+(lane>>3),ch=lane&7; const u32x4 v=*(const u32x4*)(stg+row*64+ch*8); ATTN_STORE16(Ow+(long)row*DM+ch*8,v);} }
  asm volatile("s_waitcnt lgkmcnt(0)\n\ts_barrier":::"memory");
  #undef DMA_K
  #undef DMA_V
  #undef CMASK
  #undef START
  #undef RESC
  #undef ROT
}
constexpr int ATTN_LDS_BYTES=LDS_BYTES;
struct AttnTensors { const bf16* Q; const bf16* K; const bf16* V; bf16* O; };
struct AttnUnit { int bh; int qb; };
struct StaticOrder {
  int vcu,G;
  __device__ __forceinline__ explicit StaticOrder(int grid,int block):vcu((grid%8==0)?(block%8)*(grid/8)+block/8:block),G(grid){}
  __device__ __forceinline__ bool next(int i,AttnUnit&u)const{ const int L=i*G+vcu; if(L>=4096)return false; const int pair=L>>5,j=L&31; const int b=pair>>2,kvh=pair&3; u.bh=b*NHEAD+kvh*4+(j>>3); u.qb=j&7; return true; }
  __device__ __forceinline__ void a_ready(const AttnUnit&)const{}
  __device__ __forceinline__ void done(const AttnUnit&)const{}
};
template<class Sched,int THRL=8> __device__ __forceinline__ void attn_phase(char*lds,const AttnTensors&T,const Sched&S){
  AttnUnit u;
  for(int i=0;S.next(i,u);++i){ S.a_ready(u); attn_unit<THRL>(u.bh/NHEAD,u.bh%NHEAD,u.qb,T.Q,T.K,T.V,T.O,lds); S.done(u); }
}
#undef SBAR
#undef WAIT_BAR
}
typedef GAS unsigned gu32;
struct Params { const float* in[33]; float* out; unsigned char* ws; unsigned long long ws_size; int ph_lo, ph_hi, li, pad; };
struct Frame {
    LAS unsigned char* lds; volatile LAS unsigned* MISC; unsigned* ctl;
    int tid, lane, wave, vcu, G, gw, NGW;
    const float* const* in; float* out; unsigned char* ws;
};
enum { I_X = 0, I_C, I_CTX, I_CCTX, I_WMOD, I_BMOD, I_WIN, I_LAMRE, I_LAMIM, I_LOGDT, I_BRE, I_BIM, I_CRE, I_CIM, I_SD, I_WGLU, I_QG, I_KG, I_WBS, I_WBA, I_WOUT, I_LN1G, I_LN1B,
       I_WR, I_RB, I_WEG, I_WEU, I_WED, I_WSG, I_WSU, I_WSD, I_LN2G, I_LN2B };

__device__ __forceinline__ void p0_transpose_item(const float* W, int ldw, int K, bf16_t* WT, int n0, int k0, int drow, bool gen, LAS float* scr, int lane) {
#pragma unroll 8
    for (int i = 0; i < 32; ++i) { const int kk = 2 * i + (lane >> 5); scr[kk * 33 + (lane & 31)] = W[(size_t)(k0 + kk) * ldw + n0 + (lane & 31)]; }
    LDS_WAIT(); asm volatile("" ::: "memory");
    const int c = lane & 7;
#pragma unroll
    for (int j = 0; j < 4; ++j) { const int n = (lane >> 3) + 8 * j; const LAS float* s = scr + (8 * c) * 33 + n;
        u32x4 o; o.x = cvt_pk_bf16(s[0 * 33], s[1 * 33]); o.y = cvt_pk_bf16(s[2 * 33], s[3 * 33]); o.z = cvt_pk_bf16(s[4 * 33], s[5 * 33]); o.w = cvt_pk_bf16(s[6 * 33], s[7 * 33]);
        const int pr = drow + (gen ? pg8::invperm32(n) : n);
        *(GAS u32x4*)(WT + (size_t)pr * K + k0 + 8 * c) = o; }
    LDS_WAIT(); asm volatile("" ::: "memory");
}
__device__ __forceinline__ int win_phys_base(int n0, bool& gen) {
    if (n0 >= 1024 && n0 < 2304) {
        const int seg = n0 < 2048 ? 1024 : 2048, lq = n0 - seg, tile = lq >> 8, wc = (lq >> 6) & 3, bj = (lq >> 5) & 1;
        gen = false; return seg + tile * 256 + 128 * bj + 32 * wc;
    }
    gen = true; return n0;
}
__device__ __forceinline__ void p0_mixer_weights(Frame& F) {
    LAS float* scr = (LAS float*)(F.lds + F.wave * 16384);
    constexpr int I_IN = 16 * (NIN / 32), I_SQ = 16 * 32, I_R = 16 * 8;
    constexpr int NIT = I_IN + 4 * I_SQ + I_R;
    for (int it = F.gw; it < NIT; it += F.NGW) {
        int r = it;
        if (r < I_IN) { const int nb = r % (NIN / 32), kb = r / (NIN / 32); bool gen; const int pr = win_phys_base(nb * 32, gen);
            p0_transpose_item(F.in[I_WIN], NIN, 1024, (bf16_t*)(F.ws + WS_WIN), nb * 32, kb * 64, pr, gen, scr, F.lane); continue; }
        r -= I_IN;
        if (r < 4 * I_SQ) { const int w = r / I_SQ, q = r % I_SQ, nb = q % 32, kb = q / 32;
            const float* src = F.in[w == 0 ? I_WGLU : w == 1 ? I_WBS : w == 2 ? I_WBA : I_WOUT];
            bf16_t* dst = (bf16_t*)(F.ws + (w == 0 ? WS_WGLU : w == 1 ? WS_WBS : w == 2 ? WS_WBA : WS_WOUT));
            p0_transpose_item(src, 1024, 1024, dst, nb * 32, kb * 64, nb * 32, true, scr, F.lane); continue; }
        r -= 4 * I_SQ;
        { const int nb = r % 8, kb = r / 8; p0_transpose_item(F.in[I_WR], 256, 1024, (bf16_t*)(F.ws + WS_WR), nb * 32, kb * 64, nb * 32, true, scr, F.lane); }
    }
}
__device__ __forceinline__ void p9_expert_weights(Frame& F) {
    LAS float* scr = (LAS float*)(F.lds + F.wave * 16384);
    constexpr int PER_E = 128 + 128 + 128;
    for (int it = F.gw; it < NEXPS * PER_E; it += F.NGW) {
        const int e = it / PER_E, r = it % PER_E;
        if (r < 256) { const int up = r >> 7, q = r & 127, nb = q & 7, kb = q >> 3;
            const float* src = e < NEXP ? F.in[up ? I_WEU : I_WEG] + (size_t)e * 1024 * 256 : F.in[up ? I_WSU : I_WSG];
            const int h0 = nb * 32, pr = (h0 >> 7) * 256 + up * 128 + (h0 & 127);
            p0_transpose_item(src, 256, 1024, (bf16_t*)(F.ws + WS_WGU) + (size_t)e * 512 * 1024, h0, kb * 64, pr, true, scr, F.lane);
        } else { const int q = r - 256, nb = q & 31, kb = q >> 5;
            const float* src = e < NEXP ? F.in[I_WED] + (size_t)e * 256 * 1024 : F.in[I_WSD];
            p0_transpose_item(src, 1024, 256, (bf16_t*)(F.ws + WS_WD) + (size_t)e * 1024 * 256, nb * 32, kb * 64, nb * 32, true, scr, F.lane); }
    }
}
__device__ __forceinline__ void p0_mod_item(Frame& F, int item) {
    const int n0 = item * 64, w = F.wave, lane = F.lane;
    LAS float* sbuf = (LAS float*)F.lds + w * (33 * 64);
    const float* cin = F.in[I_C]; const float* cctx = F.in[I_CCTX]; const float* wm = F.in[I_WMOD];
    float acc[33];
#pragma unroll
    for (int r = 0; r < 33; ++r) acc[r] = 0.f;
    for (int pass = 0; pass < 2; ++pass) {
        const int k0 = w * 128 + pass * 64;
#pragma unroll
        for (int r = 0; r < 33; ++r) { const float cv = r < 32 ? cin[r * 1024 + k0 + lane] : cctx[k0 + lane]; sbuf[r * 64 + lane] = silu_(cv); }
        LDS_WAIT(); asm volatile("" ::: "memory");
#pragma unroll 4
        for (int kk = 0; kk < 64; ++kk) { const float wv = wm[(size_t)(k0 + kk) * 6144 + n0 + lane];
#pragma unroll
            for (int r = 0; r < 33; ++r) acc[r] += sbuf[r * 64 + kk] * wv; }
        LDS_WAIT(); asm volatile("" ::: "memory");
    }
    __syncthreads();
    LAS float* red = (LAS float*)F.lds;
#pragma unroll
    for (int r = 0; r < 33; ++r) red[(w * 33 + r) * 64 + lane] = acc[r];
    __syncthreads();
    float* mod = (float*)(F.ws + WS_MOD);
    for (int o = F.tid; o < 33 * 64; o += NTHR) { const int r = o >> 6, l = o & 63; float s = F.in[I_BMOD][n0 + l];
#pragma unroll
        for (int w2 = 0; w2 < 8; ++w2) s += red[(w2 * 33 + r) * 64 + l];
        mod[r * 6144 + n0 + l] = s; }
    __syncthreads();
}
__device__ __forceinline__ void p0_s5_tables(Frame& F, int g) {
    LAS f32x2* pw = (LAS f32x2*)F.lds;
    LAS f32x2* bb = (LAS f32x2*)(F.lds + 33792);
    LAS f32x2* cc = (LAS f32x2*)(F.lds + 33792 + 16384);
    LAS float* ktab = (LAS float*)(F.lds + 33792 + 32768);
    const int tid = F.tid;
    if (tid < 128) {
        const int d = tid >> 6, p = tid & 63, base = (d * 64 + g) * 64 + p;
        const double lr = fmin((double)F.in[I_LAMRE][base], -1e-4), li = (double)F.in[I_LAMIM][base], dt = exp((double)F.in[I_LOGDT][d * 64 + g]);
        for (int k = 0; k <= 32; ++k) { const double mag = exp(k * lr * dt), ang = k * li * dt; pw[(d * 33 + k) * 64 + p] = (f32x2){(float)(mag * cos(ang)), (float)(mag * sin(ang))}; }
        { const double mag = exp(32 * lr * dt), ang = 32 * li * dt; float* laml = (float*)(F.ws + WS_LAML) + (size_t)base * 2; laml[0] = (float)(mag * cos(ang)); laml[1] = (float)(mag * sin(ang)); }
        const double m1 = exp(lr * dt), nr = m1 * cos(li * dt) - 1.0, ni = m1 * sin(li * dt), den = lr * lr + li * li;
        const double qr = (nr * lr + ni * li) / den, qi = (ni * lr - nr * li) / den;
        for (int c = 0; c < 16; ++c) { const double br = F.in[I_BRE][(size_t)base * 16 + c], bi = F.in[I_BIM][(size_t)base * 16 + c];
            bb[(d * 64 + p) * 16 + c] = (f32x2){(float)(qr * br - qi * bi), (float)(qr * bi + qi * br)}; }
    }
    for (int e = tid; e < 2048; e += NTHR) { const int d = e >> 10, c = (e >> 6) & 15, p = e & 63; const size_t gi = ((size_t)(d * 64 + g) * 16 + c) * 64 + p;
        cc[e] = (f32x2){F.in[I_CRE][gi], F.in[I_CIM][gi]}; }
    __syncthreads();
    for (int e = tid; e < 2 * 32 * 256; e += NTHR) {
        const int d = e >> 13, k = (e >> 8) & 31, c = (e >> 4) & 15, c2 = e & 15; float s = 0.f;
        for (int p = 0; p < 64; ++p) { const f32x2 C = cc[(d * 16 + c) * 64 + p], P = pw[(d * 33 + k) * 64 + p], B = bb[(d * 64 + p) * 16 + c2];
            const float tr = C.x * P.x - C.y * P.y, ti = C.x * P.y + C.y * P.x; s += tr * B.x - ti * B.y; }
        ktab[e] = s;
    }
    __syncthreads();
    const float* dsk = F.in[I_SD] + g * 16;
    bf16_t* tm = (bf16_t*)(F.ws + WS_TMAT) + (size_t)g * NS5 * KAUG;
    for (int ch = tid; ch < NS5 * (KAUG / 8); ch += NTHR) {
        const int rho = ch / (KAUG / 8), kc = ch % (KAUG / 8), n = (rho & ~31) + pg8::perm32(rho & 31), t = n >> 4, c = n & 15;
        float v[8];
#pragma unroll
        for (int i = 0; i < 8; ++i) { const int kk = kc * 8 + i;
            if (kk < NS5) { const int s = kk >> 4, c2 = kk & 15;
                v[i] = t > s ? ktab[(t - s) * 256 + c * 16 + c2] : s > t ? ktab[8192 + (s - t) * 256 + c * 16 + c2] : ktab[c * 16 + c2] + ktab[8192 + c * 16 + c2] + (c == c2 ? dsk[c] : 0.f);
            } else { const int j = kk - NS5, d = j >> 7, p = (j & 127) >> 1, ri = j & 1, e = d == 0 ? t + 1 : LC5 - t;
                const f32x2 C = cc[(d * 16 + c) * 64 + p], P = pw[(d * 33 + e) * 64 + p];
                v[i] = ri == 0 ? C.x * P.x - C.y * P.y : -(C.x * P.y + C.y * P.x); } }
        u32x4 o; o.x = cvt_pk_bf16(v[0], v[1]); o.y = cvt_pk_bf16(v[2], v[3]); o.z = cvt_pk_bf16(v[4], v[5]); o.w = cvt_pk_bf16(v[6], v[7]);
        *(u32x4*)(tm + (size_t)rho * KAUG + kc * 8) = o;
    }
    bf16_t* wh = (bf16_t*)(F.ws + WS_WH) + (size_t)g * 256 * NS5;
    for (int ch = tid; ch < 256 * (NS5 / 8); ch += NTHR) {
        const int rho = ch / (NS5 / 8), kc = ch % (NS5 / 8), n = (rho & ~31) + pg8::perm32(rho & 31), d = n >> 7, p = (n & 127) >> 1, ri = n & 1;
        float v[8];
#pragma unroll
        for (int i = 0; i < 8; ++i) { const int kk = kc * 8 + i, s = kk >> 4, c2 = kk & 15, e = d == 0 ? LC5 - 1 - s : s;
            const f32x2 P = pw[(d * 33 + e) * 64 + p], B = bb[(d * 64 + p) * 16 + c2];
            v[i] = ri == 0 ? P.x * B.x - P.y * B.y : P.x * B.y + P.y * B.x; }
        u32x4 o; o.x = cvt_pk_bf16(v[0], v[1]); o.y = cvt_pk_bf16(v[2], v[3]); o.z = cvt_pk_bf16(v[4], v[5]); o.w = cvt_pk_bf16(v[6], v[7]);
        *(u32x4*)(wh + (size_t)rho * NS5 + kc * 8) = o;
    }
    __syncthreads();
}
__device__ __forceinline__ void p0_rope(Frame& F) {
    float* rope = (float*)(F.ws + WS_ROPE);
    for (int idx = F.lane; idx < 64 * 16; idx += 64) { const int pos = idx >> 4, i = idx & 15;
        const double inv = exp(-9.210340371976184 * (double)i / 16.0), ang = (double)pos * inv; rope[idx * 2] = (float)cos(ang); rope[idx * 2 + 1] = (float)sin(ang); }
}

__device__ __forceinline__ void row_stats(const float (&v)[16], float eps, float& mean, float& rstd) {
    float s = 0.f;
#pragma unroll
    for (int i = 0; i < 16; ++i) s += v[i];
    mean = wave_sum(s) * (1.f / 1024.f); float q = 0.f;
#pragma unroll
    for (int i = 0; i < 16; ++i) { const float d = v[i] - mean; q += d * d; }
    rstd = 1.0f / sqrtf(wave_sum(q) * (1.f / 1024.f) + eps);
}
__device__ __forceinline__ void load16f(const float* row, int lane, float (&v)[16]) {
#pragma unroll
    for (int h = 0; h < 2; ++h) { const f32x4 a = *(const f32x4*)(row + h * 512 + lane * 8), b = *(const f32x4*)(row + h * 512 + lane * 8 + 4);
#pragma unroll
        for (int j = 0; j < 4; ++j) { v[h * 8 + j] = a[j]; v[h * 8 + 4 + j] = b[j]; } }
}
__device__ __forceinline__ void load16b(const bf16_t* row, int lane, float (&v)[16]) {
#pragma unroll
    for (int h = 0; h < 2; ++h) { const u32x4 w = *(const u32x4*)(row + h * 512 + lane * 8);
        v[h * 8 + 0] = bflo(w.x); v[h * 8 + 1] = bfhi(w.x); v[h * 8 + 2] = bflo(w.y); v[h * 8 + 3] = bfhi(w.y); v[h * 8 + 4] = bflo(w.z); v[h * 8 + 5] = bfhi(w.z); v[h * 8 + 6] = bflo(w.w); v[h * 8 + 7] = bfhi(w.w); }
}
__device__ __forceinline__ void store16b(bf16_t* row, int lane, const float (&v)[16]) {
#pragma unroll
    for (int h = 0; h < 2; ++h) { u32x4 w; w.x = cvt_pk_bf16(v[h * 8 + 0], v[h * 8 + 1]); w.y = cvt_pk_bf16(v[h * 8 + 2], v[h * 8 + 3]); w.z = cvt_pk_bf16(v[h * 8 + 4], v[h * 8 + 5]); w.w = cvt_pk_bf16(v[h * 8 + 6], v[h * 8 + 7]);
        *(u32x4*)(row + h * 512 + lane * 8) = w; }
}
__device__ __forceinline__ void p1_modulate(Frame& F) {
    const float* mod = (const float*)(F.ws + WS_MOD);
    for (int row = F.gw; row < T + TC; row += F.NGW) {
        const bool isc = row >= T; const int r = isc ? row - T : row, b = isc ? 32 : (row >> 11);
        float v[16], sh[16], sc[16]; load16f((isc ? F.in[I_CTX] : F.in[I_X]) + (size_t)r * 1024, F.lane, v);
        load16f(mod + (size_t)b * 6144, F.lane, sh); load16f(mod + (size_t)b * 6144 + 1024, F.lane, sc);
        float mean, rstd; row_stats(v, 1e-6f, mean, rstd);
#pragma unroll
        for (int i = 0; i < 16; ++i) v[i] = (v[i] - mean) * rstd * (1.f + sc[i]) + sh[i];
        store16b((bf16_t*)(F.ws + (isc ? WS_UC : WS_A)) + (size_t)r * 1024, F.lane, v);
    }
}
__device__ __forceinline__ void p9_ln1(Frame& F) {
    const float* mod = (const float*)(F.ws + WS_MOD);
    float g[16], bta[16]; load16f(F.in[I_LN1G], F.lane, g); load16f(F.in[I_LN1B], F.lane, bta);
    for (int row = F.gw; row < T; row += F.NGW) {
        bf16_t* xr = (bf16_t*)(F.ws + WS_X1) + (size_t)row * 1024; const int b = row >> 11;
        float v[16], sh[16], sc[16]; load16b(xr, F.lane, v);
        load16f(mod + (size_t)b * 6144 + 3072, F.lane, sh); load16f(mod + (size_t)b * 6144 + 4096, F.lane, sc);
        float mean, rstd; row_stats(v, 1e-5f, mean, rstd);
#pragma unroll
        for (int i = 0; i < 16; ++i) v[i] = (v[i] - mean) * rstd * g[i] + bta[i];
        store16b(xr, F.lane, v);
        row_stats(v, 1e-6f, mean, rstd);
#pragma unroll
        for (int i = 0; i < 16; ++i) v[i] = (v[i] - mean) * rstd * (1.f + sc[i]) + sh[i];
        store16b((bf16_t*)(F.ws + WS_U2) + (size_t)row * 1024, F.lane, v);
    }
}
__device__ __forceinline__ void p4_carry_scan(Frame& F) {
    const float* hfin = (const float*)(F.ws + WS_HFIN); const float* laml = (const float*)(F.ws + WS_LAML); bf16_t* saug = (bf16_t*)(F.ws + WS_SAUG);
    for (int item = F.gw; item < NB * 64 * 2; item += F.NGW) {
        const int d = item & 1, g = (item >> 1) & 63, b = item >> 7, p = F.lane;
        const f32x2 lam = *(const f32x2*)(laml + ((size_t)(d * 64 + g) * 64 + p) * 2);
        float cr = 0.f, ci = 0.f;
        const size_t gbase = (size_t)g * ROWS_G;
        f32x2 hv[8];
#pragma unroll
        for (int j = 0; j < 8; ++j) { const int jj = d == 0 ? j : 7 - j; hv[j] = *(const f32x2*)(hfin + (gbase + 2048 + b * 8 + jj) * 256 + d * 128 + p * 2); }
#pragma unroll
        for (int j = 0; j < 8; ++j) { const float nr = lam.x * cr - lam.y * ci + hv[j].x, ni = lam.x * ci + lam.y * cr + hv[j].y; cr = nr; ci = ni; }
        for (int j0 = 0; j0 < 64; j0 += 8) {
#pragma unroll
            for (int j = 0; j < 8; ++j) { const int jj = d == 0 ? j0 + j : 63 - (j0 + j); hv[j] = *(const f32x2*)(hfin + (gbase + b * 64 + jj) * 256 + d * 128 + p * 2); }
#pragma unroll
            for (int j = 0; j < 8; ++j) { const int jj = d == 0 ? j0 + j : 63 - (j0 + j);
                *(unsigned*)(saug + (gbase + b * 64 + jj) * KAUG + NS5 + d * 128 + p * 2) = cvt_pk_bf16(cr, ci);
                const float nr = lam.x * cr - lam.y * ci + hv[j].x, ni = lam.x * ci + lam.y * cr + hv[j].y; cr = nr; ci = ni; }
        }
    }
}
__device__ __forceinline__ void p11_routing(Frame& F) {
    const float* logits = (const float*)(F.ws + WS_LOGIT); const float* rb = F.in[I_RB];
    int* eidx = (int*)(F.ws + WS_EIDX); float* gate = (float*)(F.ws + WS_GATE); int* slot = (int*)(F.ws + WS_SLOT); unsigned* cnt = F.ctl + CW_CNT;
    const int g8 = F.lane & 7, sub = F.lane >> 3;
    float bias[32];
#pragma unroll
    for (int j = 0; j < 8; ++j) { const f32x4 t = *(const f32x4*)(rb + g8 * 32 + j * 4); bias[j * 4] = t[0]; bias[j * 4 + 1] = t[1]; bias[j * 4 + 2] = t[2]; bias[j * 4 + 3] = t[3]; }
    for (int tg = F.gw; tg < T / 8; tg += F.NGW) {
        const int token = tg * 8 + sub; const float NEG = -INFINITY;
        float sc[32], bs[32];
#pragma unroll
        for (int j = 0; j < 8; ++j) { const f32x4 t = *(const f32x4*)(logits + (size_t)token * 256 + g8 * 32 + j * 4);
#pragma unroll
            for (int q = 0; q < 4; ++q) { sc[j * 4 + q] = 1.0f / (1.0f + __expf(-t[q])); bs[j * 4 + q] = sc[j * 4 + q] + bias[j * 4 + q]; } }
        float m1 = NEG, m2 = NEG;
#pragma unroll
        for (int j = 0; j < 32; ++j) { const float v = bs[j]; if (v > m1) { m2 = m1; m1 = v; } else if (v > m2) m2 = v; }
        const float gsc = m1 + m2; int rank = 0;
#pragma unroll
        for (int o = 1; o < 8; ++o) { const int og = (g8 + o) & 7; const float other = __shfl(gsc, (F.lane & ~7) | og); rank += (other > gsc || (other == gsc && og < g8)) ? 1 : 0; }
        if (rank >= 4) {
#pragma unroll
            for (int j = 0; j < 32; ++j) bs[j] = NEG; }
        int my_e = 0; float my_s = 0.f;
#pragma unroll 1
        for (int r = 0; r < 8; ++r) {
            float bv = NEG; int bi = 0;
#pragma unroll
            for (int j = 0; j < 32; ++j) if (bs[j] > bv) { bv = bs[j]; bi = j; }
            int gi = g8 * 32 + bi;
#pragma unroll
            for (int o = 1; o < 8; o <<= 1) { const float ov = __shfl_xor(bv, o); const int oi = __shfl_xor(gi, o); if (ov > bv || (ov == bv && oi < gi)) { bv = ov; gi = oi; } }
            float sw = 0.f; const bool mine = (gi >> 5) == g8;
#pragma unroll
            for (int j = 0; j < 32; ++j) if (mine && j == (gi & 31)) { sw = sc[j]; bs[j] = NEG; }
            sw = __shfl(sw, (F.lane & ~7) | (gi >> 5));
            if (g8 == r) { my_e = gi; my_s = sw; }
        }
        float ssum = my_s;
#pragma unroll
        for (int o = 1; o < 8; o <<= 1) ssum += __shfl_xor(ssum, o);
        const int pos = (int)__hip_atomic_fetch_add(cnt + (token / TCH) * 256 + my_e, 1u, RLX_AGENT);
        eidx[(size_t)token * 8 + g8] = my_e; gate[(size_t)token * 8 + g8] = my_s / ssum * 2.5f; slot[(size_t)token * 8 + g8] = pos;
    }
}
__device__ __forceinline__ void p12_dispatch(Frame& F) {
    LAS int* offs = (LAS int*)F.lds;
    unsigned* cnt = F.ctl + CW_CNT;
    for (int i = F.tid; i < NCHUNK * 256; i += NTHR) offs[i] = (int)__hip_atomic_load(cnt + i, RLX_AGENT);
    __syncthreads();
    if (F.tid < NCHUNK) { int run = 0; for (int e = 0; e < 256; ++e) { const int n = offs[F.tid * 256 + e]; offs[F.tid * 256 + e] = run; run += n; } }
    __syncthreads();
    const int* eidx = (const int*)(F.ws + WS_EIDX); int* slot = (int*)(F.ws + WS_SLOT); int* stok = (int*)(F.ws + WS_STOK);
    const int gt = F.vcu * NTHR + F.tid, NT_ = F.G * NTHR;
    for (int a = gt; a < T * 8; a += NT_) { const int token = a >> 3, c = token / TCH; const int s = offs[c * 256 + eidx[a]] + slot[a]; stok[(size_t)c * (SLOTS_CH + 256) + s] = token; slot[a] = s; }
    for (int a = gt; a < T; a += NT_) { const int c = a / TCH; stok[(size_t)c * (SLOTS_CH + 256) + TCH * 8 + (a - c * TCH)] = a; }
    if (blockIdx.x < NCHUNK && F.tid == 0) {
        const int c = blockIdx.x; int* tiles = (int*)(F.ws + WS_TILES) + c * 4096; int nt_ = 0;
        for (int e = 0; e <= 256; ++e) { const int n = e < 256 ? (int)__hip_atomic_load(cnt + c * 256 + e, RLX_AGENT) : TCH; const int off = e < 256 ? offs[c * 256 + e] : TCH * 8;
            for (int r0 = 0; r0 < n; r0 += 256) { tiles[4 + nt_ * 4 + 0] = e; tiles[4 + nt_ * 4 + 1] = off + r0; tiles[4 + nt_ * 4 + 2] = (n - r0) < 256 ? (n - r0) : 256; tiles[4 + nt_ * 4 + 3] = 0; ++nt_; } }
        tiles[0] = nt_;
    }
    __syncthreads();
}
__device__ __forceinline__ void p15_combine(Frame& F, int c) {
    const float* mod = (const float*)(F.ws + WS_MOD); const bf16_t* Y = (const bf16_t*)(F.ws + WS_Y); const bf16_t* X1 = (const bf16_t*)(F.ws + WS_X1);
    const int* slot = (const int*)(F.ws + WS_SLOT); const float* gate = (const float*)(F.ws + WS_GATE);
    float g[16], bta[16]; load16f(F.in[I_LN2G], F.lane, g); load16f(F.in[I_LN2B], F.lane, bta);
    for (int tt = F.gw; tt < TCH; tt += F.NGW) {
        const int token = c * TCH + tt, b = token >> 11;
        int s = 0; float gt = 0.f; if (F.lane < 8) { s = slot[(size_t)token * 8 + F.lane]; gt = gate[(size_t)token * 8 + F.lane]; }
        float f[16], y[16];
        load16b(Y + (size_t)(TCH * 8 + tt) * 1024, F.lane, f);
#pragma unroll
        for (int k = 0; k < 8; ++k) { const int sk = __shfl(s, k); const float gk = __shfl(gt, k); load16b(Y + (size_t)sk * 1024, F.lane, y);
#pragma unroll
            for (int i = 0; i < 16; ++i) f[i] += gk * y[i]; }
        float x1[16], g2[16]; load16b(X1 + (size_t)token * 1024, F.lane, x1); load16f(mod + (size_t)b * 6144 + 5120, F.lane, g2);
#pragma unroll
        for (int i = 0; i < 16; ++i) f[i] = ALPHA * x1[i] + g2[i] * f[i];
        float mean, rstd; row_stats(f, 1e-5f, mean, rstd);
        float* orow = F.out + (size_t)token * 1024;
#pragma unroll
        for (int h = 0; h < 2; ++h) { f32x4 a, bq;
#pragma unroll
            for (int j = 0; j < 4; ++j) { a[j] = (f[h * 8 + j] - mean) * rstd * g[h * 8 + j] + bta[h * 8 + j]; bq[j] = (f[h * 8 + 4 + j] - mean) * rstd * g[h * 8 + 4 + j] + bta[h * 8 + 4 + j]; }
            *(f32x4*)(orow + h * 512 + F.lane * 8) = a; *(f32x4*)(orow + h * 512 + F.lane * 8 + 4) = bq; }
    }
}
#if MK_DIAG
__device__ __forceinline__ unsigned dhash(unsigned i) { unsigned h = (i + 1u) * 2654435761u; h ^= h >> 15; h *= 2246822519u; h ^= h >> 13; return h; }
__device__ __forceinline__ void dreport(Frame& F, int k, float err) { atomicMax(F.ctl + CW_CHK + k, __float_as_uint(err)); }
__device__ __forceinline__ float relerr(float got, float exp_, float floor_) { return fabsf(got - exp_) / (fabsf(exp_) + floor_); }
__device__ __forceinline__ float ddot_b(const bf16_t* arow, int K, const float* W, int ldw, int col) { float s = 0.f; for (int k = 0; k < K; ++k) s += bf2f(arow[k]) * W[(size_t)k * ldw + col]; return s; }
__device__ __forceinline__ float dqk_ref(const bf16_t* urow, const float* win, int colbase, const float* gvec, bool rope, int l, int lane, int& spos) {
    const float d = ddot_b(urow, 1024, win, NIN, colbase + lane);
    const float ss = wave_sum(d * d), y = d * (1.0f / sqrtf(ss / 64.f + 1e-6f)) * gvec[lane];
    const float yp = __shfl(y, lane ^ 16);
    const int axis = lane >> 5, hd = lane & 31, i = hd & 15;
    float o = y;
    if (rope) { const float pos = axis == 0 ? (float)(l >> 6) : (float)(l & 63); const float ang = pos * powf(10000.f, -(float)i / 16.f); const float cs = cosf(ang), sn = sinf(ang);
        o = hd < 16 ? y * cs - yp * sn : yp * sn + y * cs; }
    const int bj = lane >> 5, n = (lane >> 4) & 1, fq = (lane >> 2) & 3, j = lane & 3; spos = 16 * fq + 8 * bj + 4 * n + j;
    return o;
}
#ifndef MK_DIAG_MASK
#define MK_DIAG_MASK 0xffffffffu
#endif
#define DCHK(k) (((MK_DIAG_MASK) >> (k)) & 1u)
template <int k> __device__ __forceinline__ void diag_checks(Frame& F) {
    unsigned char* ws = F.ws; const int lane = F.lane;
    if constexpr (k == 0) {
        const float* mod = (const float*)(ws + WS_MOD);
        for (int s = F.gw; s < 512; s += F.NGW) { const unsigned h = dhash(s); const int r = h % 33, n = (h >> 8) % 6144; float a = 0.f;
            for (int kk = lane; kk < 1024; kk += 64) { const float cv = r < 32 ? F.in[I_C][r * 1024 + kk] : F.in[I_CCTX][kk]; a += cv / (1.f + expf(-cv)) * F.in[I_WMOD][(size_t)kk * 6144 + n]; }
            a = wave_sum(a) + F.in[I_BMOD][n]; dreport(F, 0, relerr(mod[r * 6144 + n], a, 0.05f)); }
        const bf16_t* wt = (const bf16_t*)(ws + WS_WIN);
        for (int s = F.gw * 64 + lane; s < 65536; s += F.NGW * 64) { const unsigned h = dhash(s + 777); const int n = h % NIN, kk = (h >> 13) % 1024; bool gen; const int base = win_phys_base(n & ~31, gen);
            const int pr = base + (gen ? pg8::invperm32(n & 31) : (n & 31)); dreport(F, 1, relerr(bf2f(wt[(size_t)pr * 1024 + kk]), F.in[I_WIN][(size_t)kk * NIN + n], 0.02f)); }
    } else if constexpr (k == 1) {
        const float* mod = (const float*)(ws + WS_MOD);
        for (int s = F.gw; s < 512; s += F.NGW) { const unsigned h = dhash(s + 31); const bool isc = (s & 7) == 7; const int r = isc ? h % TC : h % T, b = isc ? 32 : r >> 11;
            const float* xr = (isc ? F.in[I_CTX] : F.in[I_X]) + (size_t)r * 1024; float a = 0.f, q = 0.f;
            for (int c = lane; c < 1024; c += 64) a += xr[c];
            const float mean = wave_sum(a) / 1024.f;
            for (int c = lane; c < 1024; c += 64) q += (xr[c] - mean) * (xr[c] - mean);
            const float rstd = 1.f / sqrtf(wave_sum(q) / 1024.f + 1e-6f);
            const bf16_t* ur = (const bf16_t*)(ws + (isc ? WS_UC : WS_A)) + (size_t)r * 1024;
            for (int c = lane; c < 1024; c += 64) { const float e = (xr[c] - mean) * rstd * (1.f + mod[b * 6144 + 1024 + c]) + mod[b * 6144 + c]; dreport(F, 2, relerr(bf2f(ur[c]), e, 0.05f)); } }
    } else if constexpr (k == 2) {
        const bf16_t* U = (const bf16_t*)(ws + WS_A); const bf16_t* UC = (const bf16_t*)(ws + WS_UC); const float* win = F.in[I_WIN];
        for (int s = F.gw; s < 1024; s += F.NGW) {
            const unsigned h = dhash(s + 99); const bool isc = (s & 3) == 3; const int r = isc ? h % TC : h % T, b = isc ? r >> 8 : r >> 11, l = isc ? r & 255 : r & 2047;
            const bf16_t* ur = (isc ? UC : U) + (size_t)r * 1024; const int kind = (h >> 20) % 6;
            const int cb = (h >> 24) & 15;
            if (kind == 0) { const int n = (cb * 64 + lane), g = n >> 4, c = n & 15; const float d = ddot_b(ur, 1024, win, NIN, n);
                const int grow = isc ? 2048 + b * 8 + (l >> 5) : b * 64 + (l >> 5); const float got = bf2f(((const bf16_t*)(ws + WS_SAUG))[((size_t)g * ROWS_G + grow) * KAUG + (l & 31) * 16 + c]); dreport(F, 3, relerr(got, d, 0.5f)); }
            else if (kind == 1 && !isc) { const int head = cb; int sp; const float e = dqk_ref(ur, win, 1024 + head * 64, F.in[I_QG], true, l, lane, sp) * C2Q;
                dreport(F, 4, relerr(bf2f(((const bf16_t*)(ws + WS_Q))[(size_t)r * 1024 + head * 64 + sp]), e, 0.1f)); }
            else if (kind == 2) { const int head = cb & 3; int sp; const float e = dqk_ref(ur, win, 2048 + head * 64, F.in[I_KG], !isc, l, lane, sp);
                dreport(F, 5, relerr(bf2f(((const bf16_t*)(ws + WS_K))[((size_t)b * SKV + (isc ? l : CTX + l)) * 256 + head * 64 + sp]), e, 0.5f)); }
            else if (kind == 3) { const int n = (cb & 3) * 64 + lane; const float d = ddot_b(ur, 1024, win, NIN, 2304 + n);
                dreport(F, 6, relerr(bf2f(((const bf16_t*)(ws + WS_V))[((size_t)b * SKV + (isc ? l : CTX + l)) * 256 + n]), d, 0.5f)); }
            else if (kind >= 4 && !isc) { const int n = cb * 64 + lane; const float d = ddot_b(ur, 1024, win, NIN, (kind == 4 ? 2560 : 3584) + n);
                dreport(F, 7, relerr(bf2f(((const bf16_t*)(ws + (kind == 4 ? WS_GS : WS_GA)))[(size_t)r * 1024 + n]), 1.f / (1.f + expf(-d)), 0.2f)); }
        }
    } else if constexpr (k == 4) {
        const bf16_t* U = (const bf16_t*)(ws + WS_A); const float* win = F.in[I_WIN]; const bf16_t* Kb = (const bf16_t*)(ws + WS_K); const bf16_t* Vb = (const bf16_t*)(ws + WS_V); const bf16_t* O = (const bf16_t*)(ws + WS_Q);
        LAS float* sp_ = (LAS float*)(F.lds) + F.wave * 4096;
        for (int s = F.gw; s < 512; s += F.NGW) {
            const unsigned h = dhash(s + 4242); const int r = h % T, b = r >> 11, l = r & 2047, head = (h >> 20) & 15, kvh = head >> 2;
            int spos; const float qv = dqk_ref(U + (size_t)r * 1024, win, 1024 + head * 64, F.in[I_QG], true, l, lane, spos) * C2Q;
            sp_[spos] = bf2f(f2bf(qv)); LDS_WAIT();
            float mx = -1e30f;
            for (int j = lane; j < SKV; j += 64) { const bf16_t* kr = Kb + ((size_t)b * SKV + j) * 256 + kvh * 64; float d = 0.f; for (int e = 0; e < 64; ++e) d += sp_[e] * bf2f(kr[e]); sp_[64 + j] = d; mx = fmaxf(mx, d); }
#pragma unroll
            for (int o = 1; o < 64; o <<= 1) mx = fmaxf(mx, __shfl_xor(mx, o));
            float sm = 0.f;
            for (int j = lane; j < SKV; j += 64) { const float p = exp2f(sp_[64 + j] - mx); sp_[64 + j] = p; sm += p; }
            sm = wave_sum(sm); LDS_WAIT();
            float o = 0.f;
            for (int j = 0; j < SKV; ++j) o += sp_[64 + j] * bf2f(Vb[((size_t)b * SKV + j) * 256 + kvh * 64 + lane]);
            o /= sm;
            dreport(F, 8, relerr(bf2f(O[(size_t)r * 1024 + head * 64 + lane]), o, 0.05f));
            LDS_WAIT();
        }
    } else if constexpr (k == 5) {
        const bf16_t* SA = (const bf16_t*)(ws + WS_SAUG); const bf16_t* Z = (const bf16_t*)(ws + WS_A);
        for (int s = F.gw; s < 256; s += F.NGW) {
            const unsigned h = dhash(s + 555); const int b = h & 31, l = (h >> 5) & 2047, g = (h >> 16) & 63, p = lane;
            float y[16];
#pragma unroll
            for (int c = 0; c < 16; ++c) y[c] = 0.f;
            for (int d = 0; d < 2; ++d) {
                const int base = (d * 64 + g) * 64 + p;
                const float lr = fminf(F.in[I_LAMRE][base], -1e-4f), li = F.in[I_LAMIM][base], dt = expf(F.in[I_LOGDT][d * 64 + g]);
                const float mg = expf(lr * dt), lbr = mg * cosf(li * dt), lbi = mg * sinf(li * dt), nr = lbr - 1.f, ni = lbi, den = lr * lr + li * li, qr = (nr * lr + ni * li) / den, qi = (ni * lr - nr * li) / den;
                float Br[16], Bi[16];
#pragma unroll
                for (int c = 0; c < 16; ++c) { const float br = F.in[I_BRE][(size_t)base * 16 + c], bi = F.in[I_BIM][(size_t)base * 16 + c]; Br[c] = qr * br - qi * bi; Bi[c] = qr * bi + qi * br; }
                float hr = 0.f, hi = 0.f;
                const int nlat = d == 0 ? l + 1 : SEQ - l;
                for (int st = 0; st < CTX + nlat; ++st) {
                    int grow, t;
                    if (st < CTX) { const int lc = d == 0 ? st : CTX - 1 - st; grow = 2048 + b * 8 + (lc >> 5); t = lc & 31; }
                    else { const int ll = d == 0 ? st - CTX : SEQ - 1 - (st - CTX); grow = b * 64 + (ll >> 5); t = ll & 31; }
                    const bf16_t* up = SA + ((size_t)g * ROWS_G + grow) * KAUG + t * 16;
                    float ur = 0.f, ui = 0.f;
#pragma unroll
                    for (int c = 0; c < 16; ++c) { const float u = bf2f(up[c]); ur += Br[c] * u; ui += Bi[c] * u; }
                    const float n1 = lbr * hr - lbi * hi + ur, n2 = lbr * hi + lbi * hr + ui; hr = n1; hi = n2;
                }
#pragma unroll
                for (int c = 0; c < 16; ++c) { const size_t ci = ((size_t)(d * 64 + g) * 16 + c) * 64 + p; y[c] += F.in[I_CRE][ci] * hr - F.in[I_CIM][ci] * hi; }
            }
            const bf16_t* ul = SA + ((size_t)g * ROWS_G + b * 64 + (l >> 5)) * KAUG + (l & 31) * 16;
#pragma unroll
            for (int c = 0; c < 16; ++c) { float v = wave_sum(y[c]) + F.in[I_SD][g * 16 + c] * bf2f(ul[c]); const float u0 = 0.7978845608f * (v + 0.044715f * v * v * v); v = 0.5f * v * (1.f + tanhf(u0));
                if (lane == c) dreport(F, 9, relerr(bf2f(Z[((size_t)g * T + b * 2048 + l) * 16 + c]), v, 0.3f)); }
        }

    } else if constexpr (k == 6) {
        const bf16_t* Z = (const bf16_t*)(ws + WS_A); const bf16_t* SSM = (const bf16_t*)(ws + WS_SAUG);
        for (int s = F.gw; s < 512; s += F.NGW) { const unsigned h = dhash(s + 66); const int r = h % T, col = ((h >> 20) & 15) * 64 + lane; float d = 0.f;
            for (int kk = 0; kk < 1024; ++kk) d += bf2f(Z[((size_t)(kk >> 4) * T + r) * 16 + (kk & 15)]) * F.in[I_WGLU][(size_t)kk * 1024 + col];
            const float z = bf2f(Z[((size_t)(col >> 4) * T + r) * 16 + (col & 15)]); dreport(F, 10, relerr(bf2f(SSM[(size_t)r * 1024 + col]), z / (1.f + expf(-d)), 0.2f)); }
    } else if constexpr (k == 7) {
        const bf16_t* SSM = (const bf16_t*)(ws + WS_SAUG); const bf16_t* O = (const bf16_t*)(ws + WS_Q); const bf16_t* MG = (const bf16_t*)(ws + WS_A);
        for (int s = F.gw; s < 512; s += F.NGW) { const unsigned h = dhash(s + 77); const int r = h % T, col = ((h >> 20) & 15) * 64 + lane;
            const float d1 = ddot_b(SSM + (size_t)r * 1024, 1024, F.in[I_WBS], 1024, col), d2 = ddot_b(O + (size_t)r * 1024, 1024, F.in[I_WBA], 1024, col);
            const float e = bf2f(((const bf16_t*)(ws + WS_GS))[(size_t)r * 1024 + col]) * d1 + bf2f(((const bf16_t*)(ws + WS_GA))[(size_t)r * 1024 + col]) * d2;
            dreport(F, 11, relerr(bf2f(MG[(size_t)r * 1024 + col]), e, 0.3f)); }
    } else if constexpr (k == 8) {
        const bf16_t* MG = (const bf16_t*)(ws + WS_A); const float* mod = (const float*)(ws + WS_MOD);
        for (int s = F.gw; s < 512; s += F.NGW) { const unsigned h = dhash(s + 88); const int r = h % T, col = ((h >> 20) & 15) * 64 + lane;
            const float d = ddot_b(MG + (size_t)r * 1024, 1024, F.in[I_WOUT], 1024, col), e = ALPHA * F.in[I_X][(size_t)r * 1024 + col] + mod[(size_t)(r >> 11) * 6144 + 2048 + col] * d;
            dreport(F, 12, relerr(bf2f(((const bf16_t*)(ws + WS_X1))[(size_t)r * 1024 + col]), e, 0.5f)); }
    } else if constexpr (k == 9) {
        const bf16_t* X1 = (const bf16_t*)(ws + WS_X1); const bf16_t* U2 = (const bf16_t*)(ws + WS_U2); const float* mod = (const float*)(ws + WS_MOD);
        for (int s = F.gw; s < 512; s += F.NGW) { const unsigned h = dhash(s + 909); const int r = h % T, b = r >> 11; const bf16_t* xr = X1 + (size_t)r * 1024; float a = 0.f, q = 0.f, a2 = 0.f, q2 = 0.f;
            for (int c = lane; c < 1024; c += 64) { const float v = bf2f(xr[c]), w = (v - F.in[I_LN1B][c]) / F.in[I_LN1G][c]; a += v; a2 += w; }
            const float mean = wave_sum(a) / 1024.f, mean2 = wave_sum(a2) / 1024.f;
            for (int c = lane; c < 1024; c += 64) { const float v = bf2f(xr[c]), w = (v - F.in[I_LN1B][c]) / F.in[I_LN1G][c]; q += (v - mean) * (v - mean); q2 += (w - mean2) * (w - mean2); }
            const float rstd = 1.f / sqrtf(wave_sum(q) / 1024.f + 1e-6f), var2 = wave_sum(q2) / 1024.f;
            if (lane == 0) dreport(F, 13, fabsf(mean2) * 3.f + fabsf(var2 - 1.f) * 3.f);
            for (int c = lane; c < 1024; c += 64) { const float e = (bf2f(xr[c]) - mean) * rstd * (1.f + mod[b * 6144 + 4096 + c]) + mod[b * 6144 + 3072 + c]; dreport(F, 14, relerr(bf2f(U2[(size_t)r * 1024 + c]), e, 0.5f)); } }
        const bf16_t* wgu = (const bf16_t*)(ws + WS_WGU); const bf16_t* wd = (const bf16_t*)(ws + WS_WD);
        for (int s = F.gw * 64 + lane; s < 65536; s += F.NGW * 64) { const unsigned h = dhash(s + 1234); const int e = h % NEXPS, kk = (h >> 9) & 1023, hid = (h >> 19) & 255, up = (h >> 27) & 1;
            const float* src = e < NEXP ? F.in[up ? I_WEU : I_WEG] + (size_t)e * 1024 * 256 : F.in[up ? I_WSU : I_WSG];
            const int pr = (hid >> 7) * 256 + up * 128 + (hid & 96) + pg8::invperm32(hid & 31);
            dreport(F, 15, relerr(bf2f(wgu[((size_t)e * 512 + pr) * 1024 + kk]), src[(size_t)kk * 256 + hid], 0.02f));
            const float* sd = e < NEXP ? F.in[I_WED] + (size_t)e * 256 * 1024 : F.in[I_WSD]; const int col = kk, k2 = hid;
            dreport(F, 16, relerr(bf2f(wd[((size_t)e * 1024 + (col & ~31) + pg8::invperm32(col & 31)) * 256 + k2]), sd[(size_t)k2 * 1024 + col], 0.02f)); }
    } else if constexpr (k == 10) {
        const bf16_t* U2 = (const bf16_t*)(ws + WS_U2); const float* lg = (const float*)(ws + WS_LOGIT);
        for (int s = F.gw; s < 512; s += F.NGW) { const unsigned h = dhash(s + 1010); const int r = h % T, col = ((h >> 20) & 3) * 64 + lane;
            dreport(F, 17, relerr(lg[(size_t)r * 256 + col], ddot_b(U2 + (size_t)r * 1024, 1024, F.in[I_WR], 256, col), 0.5f)); }
    } else if constexpr (k == 11) {
        const float* lg = (const float*)(ws + WS_LOGIT); const int* eidx = (const int*)(ws + WS_EIDX); const float* gate = (const float*)(ws + WS_GATE);
        LAS float* sc = (LAS float*)(F.lds) + F.wave * 1024; LAS float* bs = sc + 256; LAS float* gsc = sc + 512;
        for (int s = F.gw; s < 2048; s += F.NGW) { const unsigned h = dhash(s + 1111); const int tok = h % T;
            for (int e = lane; e < 256; e += 64) { const float v = 1.f / (1.f + expf(-lg[(size_t)tok * 256 + e])); sc[e] = v; bs[e] = v + F.in[I_RB][e]; }
            LDS_WAIT();
            if (lane == 0) {
                for (int g = 0; g < 8; ++g) { float m1 = -1e30f, m2 = -1e30f; for (int j = 0; j < 32; ++j) { const float v = bs[g * 32 + j]; if (v > m1) { m2 = m1; m1 = v; } else if (v > m2) m2 = v; } gsc[g] = m1 + m2; }
                for (int g = 0; g < 8; ++g) { int rank = 0; for (int o = 0; o < 8; ++o) if (gsc[o] > gsc[g] || (gsc[o] == gsc[g] && o < g)) ++rank; if (rank >= 4) for (int j = 0; j < 32; ++j) bs[g * 32 + j] = -1e30f; }
                float sel[8]; int se[8]; float ssum = 0.f; float err = 0.f;
#pragma unroll
                for (int r = 0; r < 8; ++r) { float bv = -1e31f; int bi = 0; for (int e = 0; e < 256; ++e) if (bs[e] > bv) { bv = bs[e]; bi = e; } bs[bi] = -1e31f; se[r] = bi; sel[r] = sc[bi]; ssum += sc[bi]; }
#pragma unroll
                for (int r = 0; r < 8; ++r) { if (eidx[(size_t)tok * 8 + r] != se[r]) err = 1.f; err = fmaxf(err, relerr(gate[(size_t)tok * 8 + r], sel[r] / ssum * 2.5f, 0.1f)); }
                dreport(F, 18, err);
            }
            LDS_WAIT();
        }
    } else if constexpr (k == 12) {
        const int* eidx = (const int*)(ws + WS_EIDX); const int* slot = (const int*)(ws + WS_SLOT); const int* stok = (const int*)(ws + WS_STOK);
        for (int s = F.gw * 64 + lane; s < 65536; s += F.NGW * 64) { const unsigned h = dhash(s + 1212); const int a = h % (T * 8), tok = a >> 3, c = tok / TCH; const int sl = slot[a];
            float err = 0.f; if (sl < 0 || sl >= TCH * 8) err = 1.f; else if (stok[(size_t)c * (SLOTS_CH + 256) + sl] != tok) err = 2.f;
            if (stok[(size_t)c * (SLOTS_CH + 256) + TCH * 8 + (tok - c * TCH)] != tok) err = 3.f;
            dreport(F, 19, err); }
        if (F.gw < NCHUNK && lane == 0) { int sum = 0; for (int e = 0; e < 256; ++e) sum += (int)__hip_atomic_load(F.ctl + CW_CNT + F.gw * 256 + e, RLX_AGENT); dreport(F, 20, sum == TCH * 8 ? 0.f : 1.f);
            const int* tiles = (const int*)(ws + WS_TILES) + F.gw * 4096; const int ntl = tiles[0]; int rows = 0; float err = (ntl < 64 || ntl > 1000) ? 1.f : 0.f;
            for (int i = 0; i < ntl && i < 1000; ++i) { if (tiles[4 + i * 4 + 1] != rows) err = 2.f; rows += tiles[4 + i * 4 + 2]; }
            if (rows != SLOTS_CH) err = 3.f; dreport(F, 21, err); }
    } else if constexpr (k == 20 || k == 21) {
        const int* eidx = (const int*)(ws + WS_EIDX); const int* slot = (const int*)(ws + WS_SLOT); const int* stok = (const int*)(ws + WS_STOK);
        const bf16_t* U2 = (const bf16_t*)(ws + WS_U2); const bf16_t* H = (const bf16_t*)(ws + WS_H); const bf16_t* Y = (const bf16_t*)(ws + WS_Y);
        for (int s = F.gw; s < 768; s += F.NGW) { const unsigned h = dhash(s + 2020 + k); const int sl = (s & 7) == 7 ? TCH * 8 + (h % TCH) : h % (TCH * 8); const int tok = stok[sl]; int e = 256;
            if (sl < TCH * 8) { e = -1; for (int kk = 0; kk < 8; ++kk) if (slot[(size_t)tok * 8 + kk] == sl) e = eidx[(size_t)tok * 8 + kk]; }
            if (e < 0 || tok < 0 || tok >= TCH) { dreport(F, 22, 5.f); continue; }
            if (k == 20) { const int hid = ((h >> 20) & 3) * 64 + lane;
                const float* wg = e < NEXP ? F.in[I_WEG] + (size_t)e * 1024 * 256 : F.in[I_WSG]; const float* wu = e < NEXP ? F.in[I_WEU] + (size_t)e * 1024 * 256 : F.in[I_WSU];
                const float g = ddot_b(U2 + (size_t)tok * 1024, 1024, wg, 256, hid), u = ddot_b(U2 + (size_t)tok * 1024, 1024, wu, 256, hid);
                dreport(F, 22, relerr(bf2f(H[(size_t)sl * 256 + hid]), g / (1.f + expf(-g)) * u, 0.3f));
            } else { const int col = ((h >> 20) & 15) * 64 + lane; const float* wdn = e < NEXP ? F.in[I_WED] + (size_t)e * 256 * 1024 : F.in[I_WSD];
                dreport(F, 23, relerr(bf2f(Y[(size_t)sl * 1024 + col]), ddot_b(H + (size_t)sl * 256, 256, wdn, 1024, col), 0.2f)); }
        }
    }
}
__device__ __forceinline__ void diag_finish(Frame& F, const XcdBarrier& bar, const Params& P) {
    xcd_barrier(bar);
    int code = 0;
    for (int j = 63; j >= 0; --j) { const float e = __uint_as_float(__hip_atomic_load(F.ctl + CW_CHK + j, RLX_AGENT)); if (!(e < 0.06f)) code = j + 1; }
#if MK_DIAG == 3
    code = 0; for (int j = 0; j < 6; ++j) { const float e = __uint_as_float(__hip_atomic_load(F.ctl + CW_CHK + MK_DIAG_BASE + j, RLX_AGENT)); if (!(e < 0.06f)) code |= 1 << j; }
#endif
#if MK_DIAG == 2
    code = (int)((P.ws_size - 1100000000ull) / 10000000ull); if (code < 0) code = 0; if (code > 80) code = 80;
#endif
    if (__hip_atomic_load(F.ctl + CW_BAR + XB_TMO, RLX_AGENT) != 0u) code = 90;
    const float v = sqrtf(10.f * (float)(code + 1));
    for (size_t i = (size_t)F.vcu * NTHR + F.tid; i < (size_t)T * DM / 4; i += (size_t)F.G * NTHR) ((f32x4*)F.out)[i] = (f32x4){v, v, v, v};
}
#endif
constexpr int N_PHASES = 16;
__global__ void __launch_bounds__(NTHR, 2) mk_fwd(Params P) {
    extern __shared__ __attribute__((aligned(16))) unsigned char lds_raw[];
    Frame F;
    F.lds = (LAS unsigned char*)lds_raw;
    F.MISC = (volatile LAS unsigned*)(F.lds + LDSCTL_OFF);
    F.tid = threadIdx.x; F.lane = F.tid & 63; F.wave = __builtin_amdgcn_readfirstlane(F.tid >> 6);
    F.G = gridDim.x; { const int bx = blockIdx.x; F.vcu = (F.G % 8 == 0) ? (bx % 8) * (F.G / 8) + bx / 8 : bx; }
    F.gw = F.vcu * NWAVES + F.wave; F.NGW = F.G * NWAVES;
    F.in = P.in; F.out = P.out; F.ws = P.ws; F.ctl = (unsigned*)(P.ws + WS_CTL);
    for (int u = F.tid; u < 128; u += NTHR) ((LAS unsigned*)(F.lds + LDSCTL_OFF))[u] = 0u;
    __syncthreads();
    XcdBarrier bar = xcd_barrier_post(F.ctl + CW_BAR + P.li * XCD_BAR_WORDS, F.MISC + 8);
    const int lo = P.ph_lo, hi = P.ph_hi;
    unsigned char* ws = P.ws;
    const int blk = (int)blockIdx.x;
#ifndef MK_PHMASK
#define MK_PHMASK 0xffffffffu
#endif
#define IN(k) (((MK_PHMASK >> (k)) & 1u) && lo <= (k) && (k) < hi)
#if MK_DIAG
#define SEAM(k) do { if (IN(k)) { xcd_barrier(bar); if constexpr (DCHK(k) != 0) { diag_checks<k>(F); xcd_barrier(bar); } } } while (0)
#else
#define SEAM(k) do { if (IN(k) && IN((k) + 1)) xcd_barrier(bar); } while (0)
#endif

    if (IN(0)) {
        if (blk < 96) p0_mod_item(F, blk);
        else if (blk < 160) p0_s5_tables(F, blk - 96);
        else if (blk == 160 && F.wave == 0) p0_rope(F);
        p0_mixer_weights(F);
    }
    SEAM(0);
    if (IN(1)) { p1_modulate(F); }
    SEAM(1);
    if (IN(2)) {
        pg8::SchedInProj S{(unsigned)WS_A, (unsigned)WS_UC, (unsigned)WS_WIN, 16, F.G, blk};
        pg8::EpiInProj E{(bf16_t*)(ws + WS_SAUG), (bf16_t*)(ws + WS_Q), (bf16_t*)(ws + WS_K), (bf16_t*)(ws + WS_V), (bf16_t*)(ws + WS_GS), (bf16_t*)(ws + WS_GA),
                         (const float*)(ws + WS_ROPE), F.in[I_QG], F.in[I_KG]};
        pg8::gemm_phase(F.lds, ws, S, E);
    }
    SEAM(2);
    if (IN(3)) {
        pg8::SchedGroup S{(unsigned)WS_SAUG, (unsigned)WS_WH, KAUG * 2, NS5 * 2, (unsigned)ROWS_G * KAUG * 2, 256u * NS5 * 2, NS5 / 64, ROWS_G / 256, 1, F.G, blk};
        pg8::EpiF32 E{(float*)(ws + WS_HFIN), 256, (size_t)ROWS_G * 256};
        pg8::gemm_phase(F.lds, ws, S, E);
    }
    SEAM(3);
    if (IN(4)) {
        p4_carry_scan(F);
        const attn_body::AttnTensors AT{(const attn_body::bf16*)(ws + WS_Q), (const attn_body::bf16*)(ws + WS_K), (const attn_body::bf16*)(ws + WS_V), (attn_body::bf16*)(ws + WS_Q)};
        const attn_body::StaticOrder S((int)F.G, blk);
        VM_WAIT(); __syncthreads();
        attn_body::attn_phase<attn_body::StaticOrder>((char*)lds_raw, AT, S);
    }
    SEAM(4);
    if (IN(5)) {
        pg8::SchedGroup S{(unsigned)WS_SAUG, (unsigned)WS_TMAT, KAUG * 2, KAUG * 2, (unsigned)ROWS_G * KAUG * 2, (unsigned)NS5 * KAUG * 2, KAUG / 64, 2048 / 256, 2, F.G, blk};
        pg8::EpiBf16<1> E{(bf16_t*)(ws + WS_A), NS5, (size_t)T * 16};
        pg8::gemm_phase(F.lds, ws, S, E);
    }
    SEAM(5);
    if (IN(6)) {
        pg8::SchedDense S{(unsigned)WS_A, (unsigned)WS_WGLU, 32u, (unsigned)T * 32u, 2048u, 4u * T * 32u, 256u * 32u, 256u * 2048u, 16, 256, 4, F.G, blk};
        pg8::EpiGate<0> E{(const bf16_t*)(ws + WS_A), (bf16_t*)(ws + WS_SAUG)};
        pg8::gemm_phase(F.lds, ws, S, E);
    }
    SEAM(6);
    if (IN(7)) {
        { pg8::SchedDense S{(unsigned)WS_SAUG, (unsigned)WS_WBS, 2048u, 32u, 2048u, 128u, 256u * 2048u, 256u * 2048u, 16, 256, 4, F.G, blk};
          pg8::EpiGate<1> E{(const bf16_t*)(ws + WS_GS), (bf16_t*)(ws + WS_A)};
          pg8::gemm_phase(F.lds, ws, S, E); }
        VM_WAIT(); __syncthreads();
        { pg8::SchedDense S{(unsigned)WS_Q, (unsigned)WS_WBA, 2048u, 32u, 2048u, 128u, 256u * 2048u, 256u * 2048u, 16, 256, 4, F.G, blk};
          pg8::EpiGate<2> E{(const bf16_t*)(ws + WS_GA), (bf16_t*)(ws + WS_A)};
          pg8::gemm_phase(F.lds, ws, S, E); }
    }
    SEAM(7);
    if (IN(8)) {
        pg8::SchedDense S{(unsigned)WS_A, (unsigned)WS_WOUT, 2048u, 32u, 2048u, 128u, 256u * 2048u, 256u * 2048u, 16, 256, 4, F.G, blk};
        pg8::EpiOut E{F.in[I_X], (const float*)(ws + WS_MOD), (bf16_t*)(ws + WS_X1)};
        pg8::gemm_phase(F.lds, ws, S, E);
    }
    SEAM(8);
    if (IN(9)) { p9_ln1(F); p9_expert_weights(F); }
    SEAM(9);
    if (IN(10)) {
        pg8::SchedDense S{(unsigned)WS_U2, (unsigned)WS_WR, 2048u, 32u, 2048u, 128u, 256u * 2048u, 256u * 2048u, 16, 256, 1, F.G, blk};
        pg8::EpiF32 E{(float*)(ws + WS_LOGIT), 256, 0};
        pg8::gemm_phase(F.lds, ws, S, E);
    }
    SEAM(10);
    if (IN(11)) { p11_routing(F); }
    SEAM(11);
    if (IN(12)) { p12_dispatch(F); }
    SEAM(12);
    if (IN(13)) {
        for (int c = 0; c < NCHUNK; ++c) {
            const int* tiles = (const int*)(ws + WS_TILES) + c * 4096;
            const int ntiles = __builtin_amdgcn_readfirstlane(__hip_atomic_load(tiles, RLX_AGENT));
#if !defined(MK_T13) || MK_T13 == 1
            { pg8::SchedMoe<true> S{tiles + 4, ntiles, (unsigned)WS_U2, (unsigned)WS_WGU, (const int*)(ws + WS_STOK) + (size_t)c * (SLOTS_CH + 256), F.G, blk, 16};
              pg8::EpiMoe<true> E{(bf16_t*)(ws + WS_H)};
              pg8::gemm_phase(F.lds, ws, S, E); }
#endif
            xcd_barrier(bar);
#if MK_DIAG
            if constexpr (DCHK(20) != 0) { if (c == 0) { diag_checks<20>(F); xcd_barrier(bar); } }
#endif
#if !defined(MK_T13) || MK_T13 == 2
            { pg8::SchedMoe<false> S{tiles + 4, ntiles, (unsigned)WS_H, (unsigned)WS_WD, nullptr, F.G, blk, 4};
              pg8::EpiMoe<false> E{(bf16_t*)(ws + WS_Y)};
              pg8::gemm_phase(F.lds, ws, S, E); }
#endif
            xcd_barrier(bar);
#if MK_DIAG
            if constexpr (DCHK(21) != 0) { if (c == 0) { diag_checks<21>(F); xcd_barrier(bar); } }
#endif
#if !defined(MK_T13) || MK_T13 == 3
            p15_combine(F, c);
#endif
        }
    }
#if MK_DIAG
    diag_finish(F, bar, P);
#endif
#undef IN
#undef SEAM
}

extern "C" void kernel_launch(void* const* d_in, const int* in_sizes, int n_in, void* d_out, int out_size, void* d_ws, size_t ws_size, hipStream_t stream) {
    static int grid = 0;
    if (grid == 0) {
        if (n_in != 33 || in_sizes[0] != T * DM || out_size != T * DM || ws_size < WS_END) {
            fprintf(stderr, "kernel_launch: unexpected shapes or workspace (n_in %d, in0 %d, out %d, ws %zu, need %zu); nothing launched\n", n_in, n_in > 0 ? in_sizes[0] : -1, out_size, ws_size, (size_t)WS_END); grid = -1; return; }
        int dev = 0, cus = 0, per_cu = 0;
        if (hipGetDevice(&dev) != hipSuccess || hipDeviceGetAttribute(&cus, hipDeviceAttributeMultiprocessorCount, dev) != hipSuccess) { grid = -1; return; }
        if (hipFuncSetAttribute((const void*)mk_fwd, hipFuncAttributeMaxDynamicSharedMemorySize, LDS_BYTES) != hipSuccess) { fprintf(stderr, "kernel_launch: hipFuncSetAttribute failed\n"); grid = -1; return; }
        if (hipOccupancyMaxActiveBlocksPerMultiprocessor(&per_cu, (const void*)mk_fwd, NTHR, LDS_BYTES) != hipSuccess || per_cu < 1) { fprintf(stderr, "kernel_launch: occupancy query reports %d workgroups per CU\n", per_cu); }
        (void)hipGetLastError();
        grid = cus;
    }
    if (grid < 0) return;
    if (hipMemsetAsync((char*)d_ws + WS_CTL, 0, CTL_ZERO_BYTES, stream) != hipSuccess) { fprintf(stderr, "kernel_launch: memset failed\n"); return; }
    Params p{};
    for (int i = 0; i < 33; ++i) p.in[i] = (const float*)d_in[i];
    p.out = (float*)d_out; p.ws = (unsigned char*)d_ws; p.ws_size = (unsigned long long)ws_size;
#ifndef MK_CUTS
#ifndef MK_PH_HI
#define MK_PH_HI N_PHASES
#endif
    p.ph_lo = 0; p.ph_hi = MK_PH_HI;
    hipLaunchKernelGGL(mk_fwd, dim3(grid), dim3(NTHR), LDS_BYTES, stream, p);
#else
    { const int cuts[] = {MK_CUTS}; const int nc = (int)(sizeof(cuts) / sizeof(cuts[0]));
      for (int i = 0; i + 1 < nc; ++i) { p.ph_lo = cuts[i]; p.ph_hi = cuts[i + 1]; p.li = i; hipLaunchKernelGGL(mk_fwd, dim3(grid), dim3(NTHR), LDS_BYTES, stream, p); } }
#endif
    const hipError_t le = hipPeekAtLastError();
    if (le != hipSuccess) fprintf(stderr, "kernel_launch: launch failed: %s\n", hipGetErrorName(le));
}
```

```cpp
#include <hip/hip_runtime.h>
#include <cstdio>
#include <cstdint>


#ifndef MK_DIAG
#define MK_DIAG 0
#endif

#define LAS __attribute__((address_space(3)))
#define GAS __attribute__((address_space(1)))
typedef unsigned short bf16_t;
typedef short bf16x8 __attribute__((ext_vector_type(8)));
typedef float f32x4 __attribute__((ext_vector_type(4)));
typedef float f32x2 __attribute__((ext_vector_type(2)));
typedef unsigned u32x4 __attribute__((ext_vector_type(4)));
typedef unsigned u32x2 __attribute__((ext_vector_type(2)));

constexpr int NB = 32, SEQ = 2048, CTX = 256, DM = 1024, T = NB * SEQ, TC = NB * CTX;
constexpr int NIN = 4608;
constexpr int SKV = CTX + SEQ;
constexpr int LC5 = 32;
constexpr int NCHL = SEQ / LC5, NCHC = CTX / LC5;
constexpr int ROWS_G = NB * (NCHL + NCHC);
constexpr int NS5 = LC5 * 16;
constexpr int KAUG = NS5 + 256;
constexpr int NEXP = 256, NEXPS = 257, EH = 256, TOPK = 8;
constexpr int NCHUNK = 2, TCH = T / NCHUNK;
constexpr int SLOTS_CH = TCH * (TOPK + 1);
constexpr int TILE_INTS = 8192;
constexpr float CARRY_SCALE = 16.f;
constexpr int TMAT_SHIFT = 6, WH_SHIFT = 10;
constexpr float YSCALE = 16.f;
constexpr float ALPHA = 1.189207115002721f;
constexpr float C2Q = 0.125f * 1.4426950408889634f;

constexpr size_t MiB = 1u << 20;
constexpr size_t WS_CTL = 0, CTL_ZERO_BYTES = 1 * MiB;
constexpr size_t WS_MOD = 1 * MiB;
constexpr size_t WS_ROPE = 2 * MiB;
constexpr size_t WS_LAML = 2 * MiB + 65536;
constexpr size_t WS_TILES = 2 * MiB + 262144;
constexpr size_t WS_WGH = 2 * MiB + 524288;
constexpr size_t WS_EIDX = 3 * MiB;
constexpr size_t WS_GATE = 5 * MiB;
constexpr size_t WS_SLOT = 7 * MiB;
constexpr size_t WS_STOK = 9 * MiB;
constexpr size_t WS_WIN = 16 * MiB;
constexpr size_t WS_WGLU = 25 * MiB, WS_WBS = 27 * MiB, WS_WBA = 29 * MiB, WS_WOUT = 31 * MiB, WS_WR = 33 * MiB;
constexpr size_t WS_WGU = 34 * MiB;
constexpr size_t WS_WD = 163 * MiB;
constexpr size_t WS_X1 = 420 * MiB;
constexpr size_t WS_U2 = 548 * MiB;
constexpr size_t WS_WRB = 884 * MiB;
constexpr size_t WS_RVB = 900 * MiB;
constexpr size_t WS_STAT = 901 * MiB;
constexpr size_t WS_H = 676 * MiB;
constexpr size_t WS_Y = 820 * MiB;
constexpr size_t WS_LOGIT = 820 * MiB;
constexpr size_t WS_END_MOE = 1108 * MiB;
constexpr size_t WS_TMAT = 866 * MiB;
constexpr size_t WS_WH = 914 * MiB;
constexpr size_t WS_HFIN = 994 * MiB;
constexpr size_t WS_A = 242 * MiB;
constexpr size_t WS_CAT = 242 * MiB;
constexpr size_t WS_O8 = WS_CAT + 1024;
constexpr size_t WS_Z8 = 494 * MiB;
constexpr size_t WS_UC = 370 * MiB;
constexpr size_t WS_SAUG = 386 * MiB;
constexpr size_t WS_MG8 = 730 * MiB;
constexpr size_t WS_Q = 602 * MiB;
constexpr size_t WS_K = 730 * MiB;
constexpr size_t WS_V = 766 * MiB;
constexpr size_t WS_GS = 802 * MiB;
constexpr size_t WS_GA = 930 * MiB;
constexpr size_t WS_END = 1108 * MiB;
static_assert(WS_SAUG + (size_t)64 * ROWS_G * KAUG * 2 <= WS_Q && WS_HFIN + (size_t)64 * ROWS_G * 256 * 2 <= WS_END && WS_TMAT + (size_t)64 * NS5 * KAUG * 2 <= WS_WH && WS_WH + (size_t)64 * 256 * NS5 * 2 <= 930 * MiB, "ws map");
static_assert(WS_WGU + (size_t)NEXPS * 512 * 1024 <= WS_WD && WS_WD + (size_t)NEXPS * 1024 * 256 <= 242 * MiB && WS_H + (size_t)SLOTS_CH * 256 * 2 <= WS_Y && WS_Y + (size_t)SLOTS_CH * 1024 <= WS_END_MOE, "ws map moe");
constexpr int CW_TMO = 0, CW_CODE = 1;
constexpr int CW_CHK = 64;
constexpr int CW_BAR = 4096;
constexpr int CW_CNT = 65536;

constexpr int RING_BYTES = 131072;
constexpr int LDSCTL_OFF = 143360;
constexpr int IDX_OFF = LDSCTL_OFF + 512;
constexpr int LDS_BYTES = 147456;
constexpr int NWAVES = 8, NTHR = 512;

#define RLX_AGENT __ATOMIC_RELAXED, __HIP_MEMORY_SCOPE_AGENT
#define LDS_WAIT() asm volatile("s_waitcnt lgkmcnt(0)" ::: "memory")
#define VM_WAIT() asm volatile("s_waitcnt vmcnt(0)" ::: "memory")
__device__ __forceinline__ unsigned cvt_pk_bf16(float lo, float hi) { unsigned r; asm volatile("v_cvt_pk_bf16_f32 %0, %1, %2" : "=v"(r) : "v"(lo), "v"(hi)); return r; }
__device__ __forceinline__ float bf2f(unsigned short b) { return __uint_as_float((unsigned)b << 16); }
__device__ __forceinline__ float bflo(unsigned w) { return __uint_as_float(w << 16); }
__device__ __forceinline__ float bfhi(unsigned w) { return __uint_as_float(w & 0xffff0000u); }
__device__ __forceinline__ unsigned short f2bf(float f) { return (unsigned short)(cvt_pk_bf16(f, 0.f) & 0xffffu); }
__device__ __forceinline__ float sigmoidf_(float v) { return __builtin_amdgcn_rcpf(1.f + __builtin_amdgcn_exp2f(-1.4426950408889634f * v)); }
__device__ __forceinline__ float wave_sum(float v) {
#pragma unroll
    for (int o = 1; o < 64; o <<= 1) v += __shfl_xor(v, o);
    return v;
}
__device__ __forceinline__ float gelu_tanh(float x) { const float u = 0.7978845608028654f * (x + 0.044715f * x * x * x); return x * __builtin_amdgcn_rcpf(1.f + __builtin_amdgcn_exp2f(-2.885390081777927f * u)); }
__device__ __forceinline__ float silu_(float x) { return x * sigmoidf_(x); }

#define XB_TMO      128
#define XB_XCNT(j)  (256  + 64 * (j))
#define XB_XSUB(j)  (1280 + 64 * (j))
#define XB_XGEN(j)  (2304 + 64 * (j))
#define XB_TOP      3328
#define XB_TOPGEN   3392
#define XCD_BAR_WORDS 3456
#define XB_SPIN_CAP (1u << 18)
__device__ __forceinline__ unsigned xb_ld(unsigned* p)              { return __hip_atomic_load(p, __ATOMIC_RELAXED, __HIP_MEMORY_SCOPE_AGENT); }
__device__ __forceinline__ unsigned xb_add(unsigned* p, unsigned v) { return __hip_atomic_fetch_add(p, v, __ATOMIC_RELAXED, __HIP_MEMORY_SCOPE_AGENT); }
__device__ __forceinline__ unsigned xb_xcc_id() { return (unsigned)__builtin_amdgcn_s_getreg((3 << 11) | 20) & 0xFu; }
#define XB_SPIN(cond, bar) do { unsigned _sp = 0; while (cond) { __builtin_amdgcn_s_sleep(1); \
    if ((++_sp & 255u) == 0u) { if (xb_ld(&(bar)[XB_TMO])) break; if (_sp > XB_SPIN_CAP) { atomicAdd(&(bar)[XB_TMO], 1u); break; } } } } while (0)
struct XcdBarrier { unsigned* bar; unsigned x; volatile LAS unsigned* st; };
__device__ __forceinline__ XcdBarrier xcd_barrier_post(unsigned* bar, volatile LAS unsigned* st) {
    XcdBarrier b; b.bar = bar; b.x = xb_xcc_id(); b.st = st;
    if (threadIdx.x == 0) (void)xb_add(&bar[XB_XCNT(b.x)], 1u);
    return b;
}
__device__ __forceinline__ void xcd_barrier_complete(unsigned* bar, unsigned x, unsigned& nloc, unsigned& nx) {
    const unsigned G = gridDim.x * gridDim.y * gridDim.z;
    unsigned sum, cnt, sp = 0u;
    for (;;) {
        sum = 0u; cnt = 0u;
#pragma unroll 1
        for (unsigned j = 0; j < 16; ++j) { const unsigned c = xb_ld(&bar[XB_XCNT(j)]); sum += c; cnt += (c > 0u) ? 1u : 0u; }
        if (sum == G) break;
        __builtin_amdgcn_s_sleep(1);
        if ((++sp & 255u) == 0u) { if (xb_ld(&bar[XB_TMO])) break; if (sp > XB_SPIN_CAP) { atomicAdd(&bar[XB_TMO], 1u); break; } }
    }
    const unsigned mine = xb_ld(&bar[XB_XCNT(x)]);
    nloc = mine > 0u ? mine : 1u; nx = cnt > 0u ? cnt : 1u;
}
__device__ __forceinline__ void xcd_barrier(const XcdBarrier& b) {
    asm volatile("s_waitcnt vmcnt(0)" ::: "memory");
    __syncthreads();
    if (threadIdx.x == 0) {
        unsigned* bar = b.bar;
        __builtin_amdgcn_s_waitcnt(0);
        unsigned nloc = b.st[0], nx = b.st[1];
        if (nloc == 0u) { xcd_barrier_complete(bar, b.x, nloc, nx); b.st[0] = nloc; b.st[1] = nx; }
        const unsigned old = xb_add(&bar[XB_XSUB(b.x)], 1u);
        const unsigned gen = old / nloc;
        if (old + 1u == (gen + 1u) * nloc) {
            __builtin_amdgcn_fence(__ATOMIC_RELEASE, "agent");
            asm volatile("s_waitcnt vmcnt(0)" ::: "memory");
            const unsigned og = xb_add(&bar[XB_TOP], 1u);
            const unsigned tg = og / nx;
            if (og + 1u == (tg + 1u) * nx) xb_add(&bar[XB_TOPGEN], 1u);
            else XB_SPIN(xb_ld(&bar[XB_TOPGEN]) == tg, bar);
            __builtin_amdgcn_fence(__ATOMIC_ACQUIRE, "agent");
            xb_add(&bar[XB_XGEN(b.x)], 1u);
            asm volatile("s_waitcnt vmcnt(0)" ::: "memory");
        } else {
            XB_SPIN(xb_ld(&bar[XB_XGEN(b.x)]) == gen, bar);
            __builtin_amdgcn_fence(__ATOMIC_ACQUIRE, "agent");
            asm volatile("s_waitcnt vmcnt(0)" ::: "memory");
        }
    }
    __syncthreads();
}
namespace pg8 {
constexpr int BM = 256, BK = 64, HALF = 128, HTB = HALF * BK * 2, STAGE_BYTES = 8 * HTB;
__host__ __device__ __forceinline__ int lds_byte(int r, int c) { const int st = (r >> 4) * 2 + (c >> 5), rr = r & 15, cc = c & 31, ob = rr * 64 + cc * 2; return st * 1024 + (ob ^ (((ob >> 9) & 1) << 5)); }
__host__ __device__ __forceinline__ void stage_rc(int b, int& R, int& C) { const int st = b / 1024, sb = b % 1024, swz = sb ^ (((sb >> 9) & 1) << 5); R = (st >> 1) * 16 + swz / 64; C = (st & 1) * 32 + (swz % 64) / 2; }
__host__ __device__ __forceinline__ int perm32(int rho) { const int n = rho >> 4, i = rho & 15; return 8 * (i >> 2) + 4 * n + (i & 3); }
__host__ __device__ __forceinline__ int invperm32(int l) { return 16 * ((l >> 2) & 1) + 4 * (l >> 3) + (l & 3); }

struct Unit { unsigned A, B; int pm, pn, x0, x1; };
typedef f32x4 Acc[2][2][4][2];
typedef int v4i32 __attribute__((ext_vector_type(4)));
typedef int v8i32 __attribute__((ext_vector_type(8)));
constexpr int W8_SHIFT = 6;

struct NoHook { __device__ __forceinline__ void operator()(int) const {} };
template <class Epi, class Sched, class Hook = NoHook>
__device__ __forceinline__ void gemm_phase(LAS unsigned char* lds, const unsigned char* wsb, const Sched& S, const Epi& E, const Hook& H = Hook()) {
    int tid_ = threadIdx.x; asm volatile("" : "+v"(tid_));
    const int tid = tid_, wid = __builtin_amdgcn_readfirstlane(tid >> 6), lane = tid & 63, wr = wid >> 2, wc = wid & 3, fr = lane & 15, fq = lane >> 4;
    int nt_ = S.nt; asm volatile("" : "+s"(nt_)); const int nt = nt_;
    const unsigned kstepA = S.kstepA; constexpr unsigned kstepB = 128u;
    int sR[2], sC[2];
#pragma unroll
    for (int i = 0; i < 2; ++i) stage_rc(tid * 16 + i * 8192, sR[i], sC[i]);
    unsigned voffB[2], voC[2];
#pragma unroll
    for (int i = 0; i < 2; ++i) { voffB[i] = S.boff(sR[i], sC[i]); voC[i] = Sched::GATHER ? 0u : S.aoff(sR[i], sC[i]); }
    const unsigned hstepA = Sched::GATHER ? 0u : S.aoff(HALF, 0) - S.aoff(0, 0), hstepB = S.boff(HALF, 0) - S.boff(0, 0);
    int sclA = 0x7f7f7f7f, sclB = 0x7f7f7f7f - 0x01010101 * Sched::BSHIFT; asm volatile("" : "+v"(sclA), "+v"(sclB));
    const unsigned ldsw = (unsigned)wid * 1024u;
    const int aoff = lds_byte(wr * 64 + fr, fq * 8), boff = lds_byte(wc * 32 + fr, fq * 8);
#define PG8_SA(b, h) (((b) * 2 + (h)) * HTB)
#define PG8_SB(b, h) ((4 + (b) * 2 + (h)) * HTB)
#define PG8_STG(bufoff, gbase, v0, v1) do { \
        __builtin_amdgcn_global_load_lds((const unsigned*)(wsb + ((gbase) + (v0))), (LAS unsigned*)(lds + (bufoff) + ldsw), 16, 0, 0); \
        __builtin_amdgcn_global_load_lds((const unsigned*)(wsb + ((gbase) + (v1))), (LAS unsigned*)(lds + (bufoff) + ldsw + 8192), 16, 0, 0); } while (0)
#define PG8_STG_A(b, h, gbase, NR, IB) do { if constexpr (Sched::GATHER) { const unsigned v0_ = S.goff(NR, IB, lds, (h) * HALF + sR[0], sC[0]), v1_ = S.goff(NR, IB, lds, (h) * HALF + sR[1], sC[1]); PG8_STG(PG8_SA(b, h), gbase, v0_, v1_); } \
        else PG8_STG(PG8_SA(b, h), (gbase) + (h) * hstepA, voC[0], voC[1]); } while (0)
#define PG8_STG_B(b, h, gbase) PG8_STG(PG8_SB(b, h), (gbase) + (h) * hstepB, voffB[0], voffB[1])
#define PG8_LD32(p) __builtin_shufflevector(*(const LAS v4i32*)(p), *(const LAS v4i32*)((p) + 1024), 0, 1, 2, 3, 4, 5, 6, 7)
#define PG8_LDA(dst, b, h) do { _Pragma("unroll") for (int m = 0; m < 4; ++m) dst[m] = PG8_LD32(lds + PG8_SA(b, h) + aoff + m * 2048); } while (0)
#define PG8_LDB(dst, b, h) do { _Pragma("unroll") for (int n = 0; n < 2; ++n) dst[n] = PG8_LD32(lds + PG8_SB(b, h) + boff + n * 2048); } while (0)
#define PG8_MMA(ai, bj, At, Bt) do { __builtin_amdgcn_s_setprio(1); _Pragma("unroll") for (int m = 0; m < 4; ++m) _Pragma("unroll") for (int n = 0; n < 2; ++n) { \
        if constexpr (Sched::FP8) asm volatile("v_mfma_scale_f32_16x16x128_f8f6f4 %0, %1, %2, %0, %3, %4 op_sel_hi:[0,0,0]" : "+v"(acc[ai][bj][m][n]) : "v"(Bt[n]), "v"(At[m]), "v"(sclB), "v"(sclA)); \
        else { acc[ai][bj][m][n] = __builtin_amdgcn_mfma_f32_16x16x32_bf16(__builtin_bit_cast(bf16x8, __builtin_shufflevector(Bt[n], Bt[n], 0, 1, 2, 3)), __builtin_bit_cast(bf16x8, __builtin_shufflevector(At[m], At[m], 0, 1, 2, 3)), acc[ai][bj][m][n], 0, 0, 0); \
               acc[ai][bj][m][n] = __builtin_amdgcn_mfma_f32_16x16x32_bf16(__builtin_bit_cast(bf16x8, __builtin_shufflevector(Bt[n], Bt[n], 4, 5, 6, 7)), __builtin_bit_cast(bf16x8, __builtin_shufflevector(At[m], At[m], 4, 5, 6, 7)), acc[ai][bj][m][n], 0, 0, 0); } } \
        __builtin_amdgcn_s_setprio(0); } while (0)
#define PG8_WAIT_V(n) asm volatile("s_waitcnt vmcnt(" #n ")" ::: "memory")
#define PG8_WAIT_VN(n) do { const int n_ = (n); if (n_ == 4) asm volatile("s_waitcnt vmcnt(4)" ::: "memory"); else if (n_ == 6) asm volatile("s_waitcnt vmcnt(6)" ::: "memory"); else asm volatile("s_waitcnt vmcnt(8)" ::: "memory"); } while (0)
#define PG8_WAIT_V8X(fresh) do { if ((fresh) && Epi::NSTORE > 0) asm volatile("s_waitcnt vmcnt(%0)" :: "n"(8 + Epi::NSTORE) : "memory"); else asm volatile("s_waitcnt vmcnt(8)" ::: "memory"); } while (0)
#define PG8_WAIT_L(n) asm volatile("s_waitcnt lgkmcnt(" #n ")" ::: "memory")
#define PG8_BAR __builtin_amdgcn_s_barrier()
#define PG8_SCHED __builtin_amdgcn_sched_barrier(0)
    Unit cur, nxt; int ui = 0; bool ra = false;
    if (!S.next(0, cur)) return;
    if constexpr (Sched::STAGGER > 0) {
        const unsigned long long t0 = __builtin_amdgcn_s_memrealtime(), dt = (unsigned long long)((blockIdx.x >> 3) & 3) * Sched::STAGGER;
        while (__builtin_amdgcn_s_memrealtime() - t0 < dt) __builtin_amdgcn_s_sleep(8);
    }
    Acc acc;
#pragma unroll
    for (int a = 0; a < 2; ++a)
#pragma unroll
        for (int b = 0; b < 2; ++b)
#pragma unroll
            for (int m = 0; m < 4; ++m)
#pragma unroll
                for (int n = 0; n < 2; ++n) acc[a][b][m][n] = (f32x4){0.f, 0.f, 0.f, 0.f};
    v8i32 At[4], B0[2], B1[2];
    unsigned cA = cur.A, cB = cur.B;
    if constexpr (Sched::GATHER) { S.fetch(cur, 0, lds, wid, lane); PG8_WAIT_V(0); PG8_BAR; asm volatile("" ::: "memory"); }
    PG8_STG_B(0, 0, cB); PG8_STG_B(0, 1, cB); PG8_STG_A(0, 0, cA, cur.x1, 0); PG8_STG_A(0, 1, cA, cur.x1, 0);
    if (wr == 1) PG8_BAR;
    PG8_WAIT_V(2); PG8_BAR;
    PG8_STG_B(1, 0, cB + kstepB); PG8_STG_A(1, 0, cA + kstepA, cur.x1, 0); PG8_STG_B(1, 1, cB + kstepB);
    PG8_WAIT_V(6); PG8_BAR;
    for (;;) {
        const bool has_next = S.next(ui + 1, nxt);
        const unsigned nA = has_next ? nxt.A : cA, nB = has_next ? nxt.B : cB;
        bool rb = false; if constexpr (Sched::ARES) rb = has_next && (nxt.A == cA);
        if constexpr (Sched::GATHER) { if (has_next) S.fetch(nxt, (ui + 1) & 1, lds, wid, lane); }
#pragma unroll 1
        for (int t = 0; t < nt; t += 2) {
            const bool last = (t == nt - 2);
            const unsigned a1 = cA + (unsigned)(t + 1) * kstepA;
            const unsigned a2 = last ? nA : cA + (unsigned)(t + 2) * kstepA, b2 = last ? nB : cB + (unsigned)(t + 2) * kstepB;
            const unsigned a3 = a2 + kstepA, b3 = b2 + kstepB;
            if constexpr (Epi::MIDK > 0) { if (t == Epi::MIDK) { if constexpr (Sched::FP8) asm volatile("s_nop 15\n\ts_nop 15" ::: "memory"); E.mid(acc, cur, wr, wc, fr, fq); } }
            const bool fresh = (t == 0) && (ui > 0);
            const bool swn = last && has_next; const int nr1 = cur.x1, ib1 = ui & 1, nr2 = swn ? nxt.x1 : cur.x1, ib2 = swn ? ((ui + 1) & 1) : (ui & 1);
            PG8_LDB(B0, 0, 0); PG8_LDB(B1, 0, 1); PG8_SCHED; PG8_LDA(At, 0, 0); if (!(Sched::ARES && ra)) PG8_STG_A(1, 1, a1, nr1, ib1);
            if constexpr (Sched::ARES) PG8_WAIT_VN(ra ? 4 : 8); else PG8_WAIT_V8X(fresh); PG8_WAIT_L(0); PG8_BAR; PG8_MMA(0, 0, At, B0); PG8_MMA(0, 1, At, B1); PG8_BAR; PG8_SCHED;
            PG8_LDA(At, 0, 1); PG8_STG_B(0, 0, b2); PG8_STG_B(0, 1, b2); if (!(Sched::ARES && rb)) PG8_STG_A(0, 0, a2, nr2, ib2);
            if constexpr (Sched::ARES) PG8_WAIT_VN(4 + (ra ? 0 : 2) + (rb ? 0 : 2)); else PG8_WAIT_V8X(fresh); PG8_WAIT_L(0); PG8_BAR; PG8_MMA(1, 0, At, B0); PG8_MMA(1, 1, At, B1); PG8_BAR; PG8_SCHED;
            PG8_LDB(B0, 1, 0); PG8_LDB(B1, 1, 1); PG8_SCHED; PG8_LDA(At, 1, 0); if (!(Sched::ARES && rb)) PG8_STG_A(0, 1, a2, nr2, ib2);
            if constexpr (Sched::ARES) PG8_WAIT_VN(rb ? 4 : 8); else PG8_WAIT_V(8); PG8_WAIT_L(0); PG8_BAR; PG8_MMA(0, 0, At, B0); PG8_MMA(0, 1, At, B1); PG8_BAR; PG8_SCHED;
            PG8_LDA(At, 1, 1); PG8_STG_B(1, 0, b3); PG8_STG_B(1, 1, b3); if (!(Sched::ARES && rb)) PG8_STG_A(1, 0, a3, nr2, ib2);
            if constexpr (Sched::ARES) PG8_WAIT_VN(rb ? 4 : 8); else PG8_WAIT_V(8); PG8_WAIT_L(0); PG8_BAR; PG8_MMA(1, 0, At, B0); PG8_MMA(1, 1, At, B1); PG8_BAR; PG8_SCHED;
        }
        if (wr == 0) PG8_BAR;
        if constexpr (Sched::FP8) asm volatile("s_nop 15\n\ts_nop 15" ::: "memory");
        E(acc, cur, wr, wc, fr, fq);
        H(ui);
        if (!has_next) break;
#pragma unroll
        for (int a = 0; a < 2; ++a)
#pragma unroll
            for (int b = 0; b < 2; ++b)
#pragma unroll
                for (int m = 0; m < 4; ++m)
#pragma unroll
                    for (int n = 0; n < 2; ++n) acc[a][b][m][n] = (f32x4){0.f, 0.f, 0.f, 0.f};
        cur = nxt; cA = nA; cB = nB; ++ui; ra = rb;
        if (wr == 1) PG8_BAR;
    }
    PG8_WAIT_V(0);
    PG8_BAR;
#undef PG8_SA
#undef PG8_SB
#undef PG8_STG
#undef PG8_STG_A
#undef PG8_STG_B
#undef PG8_LDA
#undef PG8_LDB
#undef PG8_MMA
#undef PG8_WAIT_V
#undef PG8_WAIT_VN
#undef PG8_WAIT_L
#undef PG8_BAR
#undef PG8_SCHED
}

__device__ __forceinline__ int xcd_remap(int L, int nwg) { const int q = nwg / 8, r = nwg % 8, xcd = L % 8, off = L / 8; return (xcd < r ? xcd * (q + 1) : r * (q + 1) + (xcd - r) * q) + off; }
__device__ __forceinline__ void tile_of(int wgid, int nM, int nN, int& pm, int& pn) { const int WGM = 8; const int nig = WGM * nN, gid = wgid / nig, fm = gid * WGM, gsz = (nM - fm) < WGM ? (nM - fm) : WGM; pm = fm + ((wgid % nig) % gsz); pn = (wgid % nig) / gsz; }
}
namespace pg8 {
template <bool F8, bool GM> struct SchedDenseT {
    static constexpr bool GATHER = false; static constexpr int STAGGER = 0; static constexpr bool FP8 = F8; static constexpr int BSHIFT = W8_SHIFT; static constexpr bool ARES = false;
    unsigned A, B, rsA, gsA, rsB, kstepA, tileA, tileB; int nt, nM, nN, G, c;
    __device__ __forceinline__ unsigned aoff(int row, int C) const { return GM ? (unsigned)row * 16u + (unsigned)(C >> 3) * gsA + (unsigned)(C & 7) * 2u : (unsigned)row * rsA + (unsigned)C * 2u; }
    __device__ __forceinline__ unsigned boff(int row, int C) const { return (unsigned)row * rsB + (unsigned)C * 2u; }
    __device__ __forceinline__ bool next(int i, Unit& u) const {
        const int nwg = nM * nN; const long L = (long)i * G + c; if (L >= nwg) return false;
        int pm, pn; tile_of(xcd_remap((int)L, nwg), nM, nN, pm, pn);
        u.A = A + (unsigned)pm * tileA; u.B = B + (unsigned)pn * tileB; u.pm = pm; u.pn = pn; u.x0 = 0; u.x1 = 0; return true;
    }
};
typedef SchedDenseT<false, false> SchedDense;
struct SchedOutRow {
    static constexpr bool GATHER = false; static constexpr int STAGGER = 0; static constexpr bool FP8 = true; static constexpr int BSHIFT = W8_SHIFT; static constexpr bool ARES = false;
    unsigned A, B; int nt, pm; static constexpr unsigned kstepA = 128u;
    __device__ __forceinline__ unsigned aoff(int row, int C) const { return (unsigned)row * 1024u + (unsigned)C * 2u; }
    __device__ __forceinline__ unsigned boff(int row, int C) const { return (unsigned)row * 1024u + (unsigned)C * 2u; }
    __device__ __forceinline__ bool next(int i, Unit& u) const {
        if (i >= 4) return false;
        u.A = A + (unsigned)pm * (256u * 1024u); u.B = B + (unsigned)i * (256u * 1024u); u.pm = pm; u.pn = i; u.x0 = 0; u.x1 = 0; return true;
    }
};
struct SchedRouter {
    static constexpr bool GATHER = false; static constexpr int STAGGER = 0; static constexpr bool FP8 = false; static constexpr int BSHIFT = W8_SHIFT; static constexpr bool ARES = false;
    unsigned A, B; int nt, G, c; static constexpr unsigned kstepA = 128u;
    __device__ __forceinline__ unsigned aoff(int row, int C) const { return (unsigned)row * 2048u + (unsigned)C * 2u; }
    __device__ __forceinline__ unsigned boff(int row, int C) const { return (unsigned)row * 2048u + (unsigned)C * 2u; }
    __device__ __forceinline__ bool next(int i, Unit& u) const {
        const long L = (long)i * G + c; if (L >= 256) return false;
        int pm, pn; tile_of(xcd_remap((int)L, 256), 256, 1, pm, pn);
        u.A = A + (unsigned)pm * (256u * 2048u); u.B = B + (unsigned)(pm >> 3) * (256u * 2048u); u.pm = pm; u.pn = 0; u.x0 = 0; u.x1 = 0; return true;
    }
};
struct SchedInProj {
    static constexpr bool GATHER = false; static constexpr int STAGGER = 0; static constexpr bool FP8 = true; static constexpr int BSHIFT = W8_SHIFT; static constexpr bool ARES = false;
    unsigned U, Uc, W; int nt, G, c, pm0, nMh, nctx; static constexpr unsigned kstepA = 128u;
    __device__ __forceinline__ unsigned aoff(int row, int C) const { return (unsigned)row * 1024u + (unsigned)C * 2u; }
    __device__ __forceinline__ unsigned boff(int row, int C) const { return (unsigned)row * 1024u + (unsigned)C * 2u; }
    __device__ __forceinline__ bool next(int i, Unit& u) const {
        const long L = (long)i * G + c; const int NL = nMh * 18;
        if (L < NL) { int pm, pn; tile_of(xcd_remap((int)L, NL), nMh, 18, pm, pn); pm += pm0; u.A = U + (unsigned)pm * 256u * 1024u; u.B = W + (unsigned)pn * 256u * 1024u; if (pn == 9) { const unsigned t_ = u.A; u.A = u.B; u.B = t_; } u.pm = pm; u.pn = pn; u.x0 = 0; u.x1 = 0; return true; }
        const int j = (int)(L - NL); if (j >= nctx) return false;
        const int pm = j / 6, q = j % 6, pn = q < 4 ? q : q + 4;
        u.A = Uc + (unsigned)pm * 256u * 1024u; u.B = W + (unsigned)pn * 256u * 1024u; if (pn == 9) { const unsigned t_ = u.A; u.A = u.B; u.B = t_; } u.pm = pm; u.pn = pn; u.x0 = 1; u.x1 = 0; return true;
    }
};
template <int BS> struct SchedGroupT {
    static constexpr bool GATHER = false; static constexpr int STAGGER = 0; static constexpr bool FP8 = true; static constexpr int BSHIFT = BS; static constexpr bool ARES = false;
    unsigned A, B, rsA, rsB, grpA, grpB; int nt, mt, ntn, G, c; static constexpr unsigned kstepA = 128u;
    __device__ __forceinline__ unsigned aoff(int row, int C) const { return (unsigned)row * rsA + (unsigned)C * 2u; }
    __device__ __forceinline__ unsigned boff(int row, int C) const { return (unsigned)row * rsB + (unsigned)C * 2u; }
    __device__ __forceinline__ bool next(int i, Unit& u) const {
        const int per = mt * ntn, nwg = 64 * per; const long L = (long)i * G + c; if (L >= nwg) return false;
        const int w = xcd_remap((int)L, nwg), g = w / per, r = w % per, pm = r / ntn, pn = r % ntn;
        u.A = A + (unsigned)g * grpA + (unsigned)pm * 256u * rsA; u.B = B + (unsigned)g * grpB + (unsigned)pn * 256u * rsB; u.pm = pm; u.pn = pn; u.x0 = g; u.x1 = 0; return true;
    }
};
#ifndef MK_STAG_DOWN
#define MK_STAG_DOWN 0
#endif
#ifndef MK_STAG_UP
#define MK_STAG_UP 0
#endif
template <bool UP> struct SchedMoe {
    static constexpr bool GATHER = true; static constexpr int STAGGER = UP ? MK_STAG_UP : MK_STAG_DOWN; static constexpr bool FP8 = true; static constexpr int BSHIFT = W8_SHIFT; static constexpr bool ARES = !UP;
    const LAS unsigned* tt; int ntiles; unsigned A, B; const int* stok; int G, c; static constexpr unsigned kstepA = 128u; int nt;
    __device__ __forceinline__ unsigned aoff(int, int) const { return 0u; }
    __device__ __forceinline__ unsigned boff(int row, int C) const { return (unsigned)row * (UP ? 1024u : 256u) + (unsigned)C * 2u; }
    __device__ __forceinline__ bool next(int i, Unit& u) const {
        int tile, pn;
        if (UP) { const int nwg = ntiles * 2; const long L = (long)i * G + c; if (L >= nwg) return false; const int w = xcd_remap((int)L, nwg); tile = w >> 1; pn = w & 1; }
        else {
            const int nfull = ntiles / G;
            if (i < 4 * nfull) { tile = xcd_remap((i >> 2) * G + c, ntiles); pn = i & 3; }
            else { const long q = (long)(i - 4 * nfull) * G + c; const int rem = ntiles - nfull * G; if (q >= 4L * rem) return false; tile = xcd_remap(nfull * G + (int)(q >> 2), ntiles); pn = (int)(q & 3); }
        }
        const unsigned w0 = __builtin_amdgcn_readfirstlane(tt[tile * 2]), w1 = __builtin_amdgcn_readfirstlane(tt[tile * 2 + 1]);
        const int e = (int)w1, row0 = (int)(w0 & 0xfffffu), nrows = (int)(w0 >> 20) + 1;
        if (UP) { u.A = A; u.B = B + ((unsigned)e * 512u + (unsigned)pn * 256u) * 1024u; }
        else    { u.A = A + (unsigned)row0 * 256u; u.B = B + ((unsigned)e * 1024u + (unsigned)pn * 256u) * 256u; }
        u.pm = row0; u.pn = pn; u.x0 = e; u.x1 = nrows; return true;
    }
    __device__ __forceinline__ void fetch(const Unit& u, int buf, LAS unsigned char* lds, int wid, int lane) const {
        if (UP) { if (wid < 4) __builtin_amdgcn_global_load_lds((const unsigned*)(stok + u.pm + wid * 64 + lane), (LAS unsigned*)(lds + IDX_OFF + buf * 1024 + wid * 256), 4, 0, 0); }
    }
    __device__ __forceinline__ unsigned goff(int nrows, int buf, LAS unsigned char* lds, int row, int C) const {
        const int r = row < nrows ? row : nrows - 1;
        if (UP) { const int tok = *(const LAS int*)(lds + IDX_OFF + buf * 1024 + r * 4); return (unsigned)tok * 1024u + (unsigned)C * 2u; }
        return (unsigned)r * 256u + (unsigned)C * 2u;
    }
};

__device__ __forceinline__ u32x4 pack8(const f32x4& a, const f32x4& b) { u32x4 w; w.x = cvt_pk_bf16(a[0], a[1]); w.y = cvt_pk_bf16(a[2], a[3]); w.z = cvt_pk_bf16(b[0], b[1]); w.w = cvt_pk_bf16(b[2], b[3]); return w; }
__device__ __forceinline__ void unpack8(const u32x4& w, f32x4& a, f32x4& b) { a = (f32x4){bflo(w.x), bfhi(w.x), bflo(w.y), bfhi(w.y)}; b = (f32x4){bflo(w.z), bfhi(w.z), bflo(w.w), bfhi(w.w)}; }

struct EpiInProj {
    static constexpr int NSTORE = 8; static constexpr int MIDK = 0;
    bf16_t *saug, *q, *k, *v, *gs, *ga; const float *rope, *qg, *kg;
    __device__ __forceinline__ void operator()(const Acc& acc, const Unit& u, int wr, int wc, int fr, int fq) const {
        const int pn = u.pn; const bool ctx = u.x0 != 0;
        if (pn < 4) {
            const int g = (pn * 256 + wc * 64 + fq * 16) >> 4;
#pragma unroll
            for (int ai = 0; ai < 2; ++ai)
#pragma unroll
                for (int m = 0; m < 4; ++m) {
                    const int r = u.pm * 256 + ai * 128 + wr * 64 + m * 16 + fr;
                    int b, l; if (!ctx) { b = r >> 11; l = r & 2047; } else { b = r >> 8; l = r & 255; }
                    const int grow = ctx ? 2048 + b * 8 + (l >> 5) : b * 64 + (l >> 5), t = l & 31; u32x4 w;
#pragma unroll
                    for (int bj = 0; bj < 2; ++bj)
#pragma unroll
                        for (int n = 0; n < 2; ++n) { const f32x4 x = acc[ai][bj][m][n]; int p = __builtin_amdgcn_cvt_pk_fp8_f32(x[0], x[1], 0, false); p = __builtin_amdgcn_cvt_pk_fp8_f32(x[2], x[3], p, true); w[bj * 2 + n] = (unsigned)p; }
                    *(u32x4*)((unsigned char*)saug + ((size_t)(g * ROWS_G + grow) * KAUG + t * 16)) = w;
                }
        } else if (pn < 9) {
            const bool isq = pn < 8; const float* gv = isq ? qg : kg;
            f32x4 g4[2][2];
#pragma unroll
            for (int bj = 0; bj < 2; ++bj)
#pragma unroll
                for (int n = 0; n < 2; ++n) g4[bj][n] = *(const f32x4*)(gv + bj * 32 + n * 16 + fq * 4);
            const float osc = isq ? 1.4426950408889634f : 1.f;
            f32x4 invf;
#pragma unroll
            for (int j = 0; j < 4; ++j) invf[j] = __builtin_amdgcn_exp2f(-0.8304820237218406f * (float)(fq * 4 + j)) * 0.15915494309189535f;
#pragma unroll
            for (int ai = 0; ai < 2; ++ai)
#pragma unroll
                for (int m = 0; m < 4; ++m) {
                    const int r = u.pm * 256 + ai * 128 + wr * 64 + m * 16 + fr;
                    int b, l; if (!ctx) { b = r >> 11; l = r & 2047; } else { b = r >> 8; l = r & 255; }
                    float ss = 0.f;
#pragma unroll
                    for (int bj = 0; bj < 2; ++bj)
#pragma unroll
                        for (int n = 0; n < 2; ++n) { const f32x4 x = acc[ai][bj][m][n]; ss += (x[0] * x[0] + x[1] * x[1]) + (x[2] * x[2] + x[3] * x[3]); }
                    ss += __shfl_xor(ss, 16); ss += __shfl_xor(ss, 32);
                    const float rstd = 1.0f / sqrtf(ss * (1.0f / 64.0f) + 1e-6f) * osc;
                    const int tt = l & 255, kslot = (l & ~255) + 64 * ((tt >> 5) & 3) + 32 * ((tt >> 2) & 1) + 16 * (tt >> 7) + 8 * ((tt >> 4) & 1) + 4 * ((tt >> 3) & 1) + (tt & 3);
                    unsigned char* dst = isq ? (unsigned char*)q + ((size_t)r * 1024 + (4 * (pn - 4) + wc) * 64 + fq * 16)
                                             : (unsigned char*)k + ((size_t)(b * 4 + wc) * (SKV * 64) + (size_t)((ctx ? kslot : CTX + kslot) >> 6) * 4096 + fq * 1024 + ((ctx ? kslot : CTX + kslot) & 63) * 16);
                    u32x4 w8;
#pragma unroll
                    for (int bj = 0; bj < 2; ++bj) {
                        f32x4 a = acc[ai][bj][m][0] * g4[bj][0] * rstd, bb = acc[ai][bj][m][1] * g4[bj][1] * rstd;
                        if (!ctx) {
                            const float pos = (float)(bj == 0 ? (l >> 6) : (l & 63)); f32x4 cs, sn;
#pragma unroll
                            for (int j = 0; j < 4; ++j) { const float rev = pos * invf[j]; cs[j] = __builtin_amdgcn_cosf(rev); sn[j] = __builtin_amdgcn_sinf(rev); }
                            const f32x4 o1 = a * cs - bb * sn, o2 = a * sn + bb * cs; a = o1; bb = o2;
                        }
                        int p0 = __builtin_amdgcn_cvt_pk_fp8_f32(a[0], a[1], 0, false); p0 = __builtin_amdgcn_cvt_pk_fp8_f32(a[2], a[3], p0, true);
                        int p1 = __builtin_amdgcn_cvt_pk_fp8_f32(bb[0], bb[1], 0, false); p1 = __builtin_amdgcn_cvt_pk_fp8_f32(bb[2], bb[3], p1, true);
                        w8[bj * 2] = (unsigned)p0; w8[bj * 2 + 1] = (unsigned)p1;
                    }
                    *(u32x4*)dst = w8;
                }
        } else if (pn == 9) {
            const int r0 = u.pm * 256; int b, kb; if (!ctx) { b = r0 >> 11; kb = CTX + (r0 & 2047); } else { b = u.pm; kb = 0; }
            unsigned char* base = (unsigned char*)v + (size_t)b * 4 * (SKV * 64) + (size_t)((kb >> 6) + wc) * 4096 + fq * 1024;
#pragma unroll
            for (int ai = 0; ai < 2; ++ai)
#pragma unroll
                for (int m = 0; m < 4; ++m) {
                    const int d = ai * 128 + wr * 64 + m * 16 + fr; u32x4 w;
#pragma unroll
                    for (int bj = 0; bj < 2; ++bj)
#pragma unroll
                        for (int n = 0; n < 2; ++n) { const f32x4 x = acc[ai][bj][m][n]; int p = __builtin_amdgcn_cvt_pk_fp8_f32(x[0], x[1], 0, false); p = __builtin_amdgcn_cvt_pk_fp8_f32(x[2], x[3], p, true); w[bj * 2 + n] = (unsigned)p; }
                    *(u32x4*)(base + (size_t)(d >> 6) * (SKV * 64) + (d & 63) * 16) = w;
                }
        } else {
            unsigned char* base = (unsigned char*)(pn < 14 ? gs : ga) + (pn < 14 ? pn - 10 : pn - 14) * 256 + wc * 64 + fq * 16;
#pragma unroll
            for (int ai = 0; ai < 2; ++ai)
#pragma unroll
                for (int m = 0; m < 4; ++m) {
                    const int r = u.pm * 256 + ai * 128 + wr * 64 + m * 16 + fr; u32x4 w;
#pragma unroll
                    for (int bj = 0; bj < 2; ++bj)
#pragma unroll
                        for (int n = 0; n < 2; ++n) { f32x4 a = acc[ai][bj][m][n];
#pragma unroll
                            for (int j = 0; j < 4; ++j) a[j] = sigmoidf_(a[j]);
                            int p = __builtin_amdgcn_cvt_pk_fp8_f32(a[0], a[1], 0, false); p = __builtin_amdgcn_cvt_pk_fp8_f32(a[2], a[3], p, true); w[bj * 2 + n] = (unsigned)p; }
                    *(u32x4*)(base + (size_t)r * 1024) = w;
                }
        }
    }
};
struct EpiF32 {
    static constexpr int NSTORE = 32; static constexpr int MIDK = 0;
    float* C; int ldc; size_t grp;
    __device__ __forceinline__ void operator()(const Acc& acc, const Unit& u, int wr, int wc, int fr, int fq) const {
        float* base = C + (size_t)u.x0 * grp + (size_t)(u.pm * 256 + wr * 64 + fr) * ldc + u.pn * 256 + wc * 32 + fq * 8;
#pragma unroll
        for (int ai = 0; ai < 2; ++ai)
#pragma unroll
            for (int m = 0; m < 4; ++m)
#pragma unroll
                for (int bj = 0; bj < 2; ++bj) { float* p = base + (size_t)(ai * 128 + m * 16) * ldc + bj * 128; *(f32x4*)p = acc[ai][bj][m][0]; *(f32x4*)(p + 4) = acc[ai][bj][m][1]; }
    }
};
template <int ACT> struct EpiBf16 {
    static constexpr int NSTORE = 16; static constexpr int MIDK = 0;
    bf16_t* O; int ldc; size_t grp;
    __device__ __forceinline__ void operator()(const Acc& acc, const Unit& u, int wr, int wc, int fr, int fq) const {
        bf16_t* base = O + (size_t)u.x0 * grp + (size_t)(u.pm * 256 + wr * 64 + fr) * ldc + u.pn * 256 + wc * 32 + fq * 8;
#pragma unroll
        for (int ai = 0; ai < 2; ++ai)
#pragma unroll
            for (int m = 0; m < 4; ++m)
#pragma unroll
                for (int bj = 0; bj < 2; ++bj) { f32x4 a = acc[ai][bj][m][0], b = acc[ai][bj][m][1];
                    if (ACT == 1) {
#pragma unroll
                        for (int j = 0; j < 4; ++j) { a[j] = gelu_tanh(a[j]); b[j] = gelu_tanh(b[j]); } }
                    *(u32x4*)(base + (size_t)(ai * 128 + m * 16) * ldc + bj * 128) = pack8(a, b); }
    }
};
template <int MODE> struct EpiGate {
    static constexpr int NSTORE = 16; static constexpr int MIDK = 0;
    const bf16_t* G; bf16_t* O;
    __device__ __forceinline__ void operator()(const Acc& acc, const Unit& u, int wr, int wc, int fr, int fq) const {
#pragma unroll
        for (int ai = 0; ai < 2; ++ai) {
            u32x4 gw[4][2], pw[4][2];
#pragma unroll
            for (int m = 0; m < 4; ++m) { const int r = u.pm * 256 + ai * 128 + wr * 64 + m * 16 + fr;
#pragma unroll
                for (int bj = 0; bj < 2; ++bj) { const int col = u.pn * 256 + bj * 128 + wc * 32 + fq * 8;
                    gw[m][bj] = MODE == 0 ? *(const u32x4*)(G + ((size_t)(col >> 4) * T + r) * 16 + (col & 15)) : *(const u32x4*)(G + (size_t)r * 1024 + col);
                    if (MODE == 2) pw[m][bj] = *(const u32x4*)(O + (size_t)r * 1024 + col); } }
#pragma unroll
            for (int m = 0; m < 4; ++m) { const int r = u.pm * 256 + ai * 128 + wr * 64 + m * 16 + fr;
#pragma unroll
                for (int bj = 0; bj < 2; ++bj) { const int col = u.pn * 256 + bj * 128 + wc * 32 + fq * 8;
                    f32x4 a = acc[ai][bj][m][0], b = acc[ai][bj][m][1], ga, gb; unpack8(gw[m][bj], ga, gb);
                    if (MODE == 0) {
#pragma unroll
                        for (int j = 0; j < 4; ++j) { a[j] = ga[j] * sigmoidf_(a[j]); b[j] = gb[j] * sigmoidf_(b[j]); } }
                    else { a = a * ga; b = b * gb; if (MODE == 2) { f32x4 pa, pb; unpack8(pw[m][bj], pa, pb); a = a + pa; b = b + pb; } }
                    *(u32x4*)(O + (size_t)r * 1024 + col) = pack8(a, b); } }
        }
    }
};
__device__ __forceinline__ unsigned pk4f8(const f32x4& x) { int p = __builtin_amdgcn_cvt_pk_fp8_f32(x[0], x[1], 0, false); p = __builtin_amdgcn_cvt_pk_fp8_f32(x[2], x[3], p, true); return (unsigned)p; }
__device__ __forceinline__ f32x4 up4f8(unsigned w) { const f32x2 a = __builtin_amdgcn_cvt_pk_f32_fp8((int)w, false), b = __builtin_amdgcn_cvt_pk_f32_fp8((int)w, true); return (f32x4){a[0], a[1], b[0], b[1]}; }
struct EpiZ8 {
    static constexpr int NSTORE = 8; static constexpr int MIDK = 0;
    unsigned char* O; size_t grp;
    __device__ __forceinline__ void operator()(const Acc& acc, const Unit& u, int wr, int wc, int fr, int fq) const {
        unsigned char* base = O + (size_t)u.x0 * grp + (size_t)(u.pm * 256 + wr * 64 + fr) * NS5 + u.pn * 256 + wc * 64 + fq * 16;
#pragma unroll
        for (int ai = 0; ai < 2; ++ai)
#pragma unroll
            for (int m = 0; m < 4; ++m) { u32x4 w;
#pragma unroll
                for (int bj = 0; bj < 2; ++bj)
#pragma unroll
                    for (int n = 0; n < 2; ++n) { f32x4 x = acc[ai][bj][m][n];
#pragma unroll
                        for (int j = 0; j < 4; ++j) x[j] = gelu_tanh(x[j]);
                        w[bj * 2 + n] = pk4f8(x); }
                *(u32x4*)(base + (size_t)(ai * 128 + m * 16) * NS5) = w; }
    }
};
template <int MODE> struct EpiGate8 {
    static constexpr int NSTORE = 8; static constexpr int MIDK = 0;
    const unsigned char* G; const unsigned char* P; unsigned char* O; int ldo;
    __device__ __forceinline__ void operator()(const Acc& acc, const Unit& u, int wr, int wc, int fr, int fq) const {
        const int col = u.pn * 256 + wc * 64 + fq * 16;
#pragma unroll
        for (int ai = 0; ai < 2; ++ai) {
            u32x4 gw[4], pw[4];
#pragma unroll
            for (int m = 0; m < 4; ++m) { const int r = u.pm * 256 + ai * 128 + wr * 64 + m * 16 + fr;
                gw[m] = MODE == 0 ? *(const u32x4*)(G + ((size_t)(col >> 4) * T + r) * 16) : *(const u32x4*)(G + (size_t)r * 1024 + col);
                if (MODE == 2) pw[m] = *(const u32x4*)(P + (size_t)r * 1024 + col); }
#pragma unroll
            for (int m = 0; m < 4; ++m) { const int r = u.pm * 256 + ai * 128 + wr * 64 + m * 16 + fr; u32x4 w8;
#pragma unroll
                for (int bj = 0; bj < 2; ++bj)
#pragma unroll
                    for (int n = 0; n < 2; ++n) { f32x4 a = acc[ai][bj][m][n]; const f32x4 g = up4f8(gw[m][bj * 2 + n]);
                        if (MODE == 0) {
#pragma unroll
                            for (int j = 0; j < 4; ++j) a[j] = g[j] * sigmoidf_(a[j]); }
                        else { a = a * g; if (MODE == 2) a = a + up4f8(pw[m][bj * 2 + n]); }
                        w8[bj * 2 + n] = pk4f8(a); }
                *(u32x4*)(O + (size_t)r * ldo + col) = w8; }
        }
    }
};
struct EpiMerge8 {
    static constexpr int NSTORE = 8; static constexpr int MIDK = 8;
    const unsigned char* GS; const unsigned char* GA; unsigned char* O;
    __device__ __forceinline__ static f32x4 gate4(unsigned w) { f32x4 g = up4f8(w);
#pragma unroll
        for (int j = 0; j < 4; ++j) g[j] = fmaxf(g[j], 0.001953125f); return g; }
    __device__ __forceinline__ void mid(Acc& acc, const Unit& u, int wr, int wc, int fr, int fq) const {
        const int col = u.pn * 256 + wc * 64 + fq * 16;
#pragma unroll
        for (int ai = 0; ai < 2; ++ai) {
            u32x4 sw[4], aw[4];
#pragma unroll
            for (int m = 0; m < 4; ++m) { const size_t o = (size_t)(u.pm * 256 + ai * 128 + wr * 64 + m * 16 + fr) * 1024 + col; sw[m] = *(const u32x4*)(GS + o); aw[m] = *(const u32x4*)(GA + o); }
#pragma unroll
            for (int m = 0; m < 4; ++m)
#pragma unroll
                for (int bj = 0; bj < 2; ++bj)
#pragma unroll
                    for (int n = 0; n < 2; ++n) { const f32x4 gs = up4f8(sw[m][bj * 2 + n]), ga = gate4(aw[m][bj * 2 + n]); f32x4 rho;
#pragma unroll
                        for (int j = 0; j < 4; ++j) rho[j] = gs[j] * __builtin_amdgcn_rcpf(ga[j]);
                        acc[ai][bj][m][n] = acc[ai][bj][m][n] * rho; }
        }
    }
    __device__ __forceinline__ void operator()(const Acc& acc, const Unit& u, int wr, int wc, int fr, int fq) const {
        const int col = u.pn * 256 + wc * 64 + fq * 16;
#pragma unroll
        for (int ai = 0; ai < 2; ++ai) {
            u32x4 aw[4];
#pragma unroll
            for (int m = 0; m < 4; ++m) aw[m] = *(const u32x4*)(GA + (size_t)(u.pm * 256 + ai * 128 + wr * 64 + m * 16 + fr) * 1024 + col);
#pragma unroll
            for (int m = 0; m < 4; ++m) { u32x4 w8;
#pragma unroll
                for (int bj = 0; bj < 2; ++bj)
#pragma unroll
                    for (int n = 0; n < 2; ++n) w8[bj * 2 + n] = pk4f8(acc[ai][bj][m][n] * gate4(aw[m][bj * 2 + n]));
                *(u32x4*)(O + (size_t)(u.pm * 256 + ai * 128 + wr * 64 + m * 16 + fr) * 1024 + col) = w8; }
        }
    }
};
struct EpiOut16 {
    static constexpr int NSTORE = 16; static constexpr int MIDK = 0;
    const float* x; const float* mod; bf16_t* O;
    __device__ __forceinline__ void operator()(const Acc& acc, const Unit& u, int wr, int wc, int fr, int fq) const {
        const int col = u.pn * 256 + wc * 64 + fq * 16;
        const float* g1 = mod + (size_t)((u.pm * 256) >> 11) * 6144 + 2048 + col;
        f32x4 gv[4];
#pragma unroll
        for (int q = 0; q < 4; ++q) gv[q] = *(const f32x4*)(g1 + q * 4);
#pragma unroll
        for (int ai = 0; ai < 2; ++ai) {
            f32x4 xv[4][4];
#pragma unroll
            for (int m = 0; m < 4; ++m) { const float* xr = x + (size_t)(u.pm * 256 + ai * 128 + wr * 64 + m * 16 + fr) * 1024 + col;
#pragma unroll
                for (int q = 0; q < 4; ++q) xv[m][q] = *(const f32x4*)(xr + q * 4); }
#pragma unroll
            for (int m = 0; m < 4; ++m) { bf16_t* orow = O + (size_t)(u.pm * 256 + ai * 128 + wr * 64 + m * 16 + fr) * 1024 + col;
#pragma unroll
                for (int bj = 0; bj < 2; ++bj) *(u32x4*)(orow + bj * 8) = pack8(xv[m][bj * 2] * ALPHA + gv[bj * 2] * acc[ai][bj][m][0], xv[m][bj * 2 + 1] * ALPHA + gv[bj * 2 + 1] * acc[ai][bj][m][1]); }
        }
    }
};
struct EpiOut {
    static constexpr int NSTORE = 16; static constexpr int MIDK = 0;
    const float* x; const float* mod; bf16_t* O;
    __device__ __forceinline__ void operator()(const Acc& acc, const Unit& u, int wr, int wc, int fr, int fq) const {
        const float* g1 = mod + (size_t)((u.pm * 256) >> 11) * 6144 + 2048 + u.pn * 256 + wc * 32 + fq * 8;
        f32x4 gv[2][2];
#pragma unroll
        for (int bj = 0; bj < 2; ++bj) { gv[bj][0] = *(const f32x4*)(g1 + bj * 128); gv[bj][1] = *(const f32x4*)(g1 + bj * 128 + 4); }
#pragma unroll
        for (int ai = 0; ai < 2; ++ai) {
            f32x4 xv[4][2][2];
#pragma unroll
            for (int m = 0; m < 4; ++m) { const float* xr = x + (size_t)(u.pm * 256 + ai * 128 + wr * 64 + m * 16 + fr) * 1024 + u.pn * 256 + wc * 32 + fq * 8;
#pragma unroll
                for (int bj = 0; bj < 2; ++bj) { xv[m][bj][0] = *(const f32x4*)(xr + bj * 128); xv[m][bj][1] = *(const f32x4*)(xr + bj * 128 + 4); } }
#pragma unroll
            for (int m = 0; m < 4; ++m) { bf16_t* orow = O + (size_t)(u.pm * 256 + ai * 128 + wr * 64 + m * 16 + fr) * 1024 + u.pn * 256 + wc * 32 + fq * 8;
#pragma unroll
                for (int bj = 0; bj < 2; ++bj) *(u32x4*)(orow + bj * 128) = pack8(xv[m][bj][0] * ALPHA + gv[bj][0] * acc[ai][bj][m][0], xv[m][bj][1] * ALPHA + gv[bj][1] * acc[ai][bj][m][1]); }
        }
    }
};
template <bool UP> struct EpiMoe {
    static constexpr int NSTORE = 0; static constexpr int MIDK = 0;
    void* O;
    __device__ __forceinline__ void operator()(const Acc& acc, const Unit& u, int wr, int wc, int fr, int fq) const {
#pragma unroll
        for (int ai = 0; ai < 2; ++ai)
#pragma unroll
            for (int m = 0; m < 4; ++m) {
                const int r = ai * 128 + wr * 64 + m * 16 + fr;
                if (r < u.x1) {
                    if (UP) { f32x4 a = acc[ai][0][m][0], b = acc[ai][0][m][1];
#pragma unroll
                        for (int j = 0; j < 4; ++j) { a[j] = silu_(a[j]) * acc[ai][1][m][0][j]; b[j] = silu_(b[j]) * acc[ai][1][m][1][j]; }
                        u32x2 w; w.x = pk4f8(a); w.y = pk4f8(b);
                        *(u32x2*)((unsigned char*)O + (size_t)(u.pm + r) * 256 + u.pn * 128 + wc * 32 + fq * 8) = w;
                    } else { u32x4 w;
#pragma unroll
                        for (int bj = 0; bj < 2; ++bj)
#pragma unroll
                            for (int n = 0; n < 2; ++n) { const f32x4 x = acc[ai][bj][m][n] * YSCALE; int p = __builtin_amdgcn_cvt_pk_fp8_f32(x[0], x[1], 0, false); p = __builtin_amdgcn_cvt_pk_fp8_f32(x[2], x[3], p, true); w[bj * 2 + n] = (unsigned)p; }
                        *(u32x4*)((unsigned char*)O + (size_t)(u.pm + r) * 1024 + u.pn * 256 + wc * 64 + fq * 16) = w;
                    }
                }
            }
    }
};
struct EpiNull { static constexpr int NSTORE = 0; static constexpr int MIDK = 0; float* sink;
    __device__ __forceinline__ void operator()(const Acc& acc, const Unit& u, int, int, int, int) const { f32x4 s = (f32x4){0.f, 0.f, 0.f, 0.f};
#pragma unroll
        for (int a = 0; a < 2; ++a)
#pragma unroll
            for (int b = 0; b < 2; ++b)
#pragma unroll
                for (int m = 0; m < 4; ++m)
#pragma unroll
                    for (int n = 0; n < 2; ++n) s += acc[a][b][m][n];
        const float t = (s[0] + s[1]) + (s[2] + s[3]); if (t == 12345.678f) sink[threadIdx.x] = t; } };
}
#include <hip/hip_bf16.h>
#include <cmath>
namespace attn_body {
using bf16=__hip_bfloat16;
using bf16x8=__attribute__((ext_vector_type(8)))short;
using s16x4=__attribute__((ext_vector_type(4)))short;
using f32x16=__attribute__((ext_vector_type(16)))float;
using u32x4=__attribute__((ext_vector_type(4)))unsigned;
typedef int v8i32_t __attribute__((ext_vector_type(8))); typedef int v4i32_t __attribute__((ext_vector_type(4)));
constexpr int NHEAD=16,SEQ=2048,SKVA=2304,D=64,DM=NHEAD*D,DKV=256;
constexpr int NW=8,QBLK=32,QB=QBLK*NW,KVBLK=64,NQB=SEQ/QB;
constexpr int ATTN_PITCH=DM, ATTN_UNIT_ROWS=QB, DMO=2048;
__device__ __forceinline__ int crow(int r,int hi){return (r&3)+8*(r>>2)+4*hi;}
#define SBAR() __builtin_amdgcn_sched_barrier(0)
__device__ __forceinline__ void cmask(f32x16&p0,f32x16&p1,int jb,int qrel,int hi){
  const float NEG=-INFINITY; int kb=64*jb+4*hi;
  #pragma unroll
  for(int r=0;r<16;++r){int kv=kb+(r&3)+8*(r>>2); if(kv>qrel)p0[r]=NEG; if(kv+32>qrel)p1[r]=NEG;}
}

constexpr int NSLOT=5, SLOTB=4096;
constexpr int LDS_K=0, LDS_V=NSLOT*SLOTB, LDS_WS=2*NSLOT*SLOTB, LDS_OST=LDS_WS+NW*64*4, LDS_BYTES=LDS_OST+NW*4096;
constexpr float C2=0.125f*1.4426950408889634f;
__device__ __forceinline__ void glds16(const void*gsrc,unsigned lds_dst){unsigned keep;
  asm volatile("s_mov_b32 %0, m0\n\ts_mov_b32 m0, %2\n\ts_nop 0\n\tglobal_load_lds_dwordx4 %1, off\n\ts_mov_b32 m0, %0":"=&s"(keep):"v"(gsrc),"s"(lds_dst):"memory");}
__device__ __forceinline__ float max3f(float a,float b,float c){float r;asm("v_max3_f32 %0, %1, %2, %3":"=v"(r):"v"(a),"v"(b),"v"(c));return r;}
__device__ __forceinline__ float max2f(float a,float b){float r;asm("v_max_f32_e32 %0, %1, %2":"=v"(r):"v"(a),"v"(b));return r;}
__device__ __forceinline__ float fadd_s(float a,float b){float r;asm("v_add_f32_e32 %0, %1, %2":"=v"(r):"v"(a),"v"(b));return r;}
__device__ __forceinline__ float fsub_s(float a,float b){float r;asm("v_sub_f32_e32 %0, %1, %2":"=v"(r):"v"(a),"v"(b));return r;}
typedef float f32x2_t __attribute__((ext_vector_type(2))); typedef __bf16 bf16x2_t __attribute__((ext_vector_type(2)));
__device__ __forceinline__ unsigned cvtpk_s(float lo,float hi){f32x2_t v={lo,hi};bf16x2_t b=__builtin_convertvector(v,bf16x2_t);return __builtin_bit_cast(unsigned,b);}
#define WAIT_BAR(N) asm volatile("s_waitcnt vmcnt(" #N ") lgkmcnt(0)\n\ts_barrier":::"memory")

__device__ __forceinline__ void qkt(f32x16&p0,f32x16&p1,const char*Kslot,const bf16x8*qr,const f32x16&negm,int r32,int hi){
  const char*kb=Kslot+hi*1024+r32*16;
  #pragma unroll
  for(int d0=0;d0<4;++d0){
    const bf16x8 b0=*reinterpret_cast<const bf16x8*>(kb+d0*2048);
    const bf16x8 b1=*reinterpret_cast<const bf16x8*>(kb+d0*2048+512);
    if(d0==0){p0=__builtin_amdgcn_mfma_f32_32x32x16_bf16(b0,qr[0],negm,0,0,0);p1=__builtin_amdgcn_mfma_f32_32x32x16_bf16(b1,qr[0],negm,0,0,0);}
    else{p0=__builtin_amdgcn_mfma_f32_32x32x16_bf16(b0,qr[d0],p0,0,0,0);p1=__builtin_amdgcn_mfma_f32_32x32x16_bf16(b1,qr[d0],p1,0,0,0);}}
}
typedef __attribute__((address_space(3))) const char* lds_cptr;
typedef short v4i16_t __attribute__((ext_vector_type(4)));
__device__ __forceinline__ void kload8(bf16x8*kf,lds_cptr kp){
  kf[0]=*(const __attribute__((address_space(3))) bf16x8*)(kp);      kf[1]=*(const __attribute__((address_space(3))) bf16x8*)(kp+512);
  kf[2]=*(const __attribute__((address_space(3))) bf16x8*)(kp+2048); kf[3]=*(const __attribute__((address_space(3))) bf16x8*)(kp+2560);
  kf[4]=*(const __attribute__((address_space(3))) bf16x8*)(kp+4096); kf[5]=*(const __attribute__((address_space(3))) bf16x8*)(kp+4608);
  kf[6]=*(const __attribute__((address_space(3))) bf16x8*)(kp+6144); kf[7]=*(const __attribute__((address_space(3))) bf16x8*)(kp+6656);
}
__device__ __forceinline__ void kload2(bf16x8*kf,lds_cptr kp,int j){ kf[2*j]=*(const __attribute__((address_space(3))) bf16x8*)(kp+j*2048); kf[2*j+1]=*(const __attribute__((address_space(3))) bf16x8*)(kp+j*2048+512); }
__device__ __forceinline__ void kload8f(v8i32_t*kf,lds_cptr kp,int mb){ kf[mb].lo=*(const __attribute__((address_space(3))) v4i32_t*)(kp+mb*512); kf[mb].hi=*(const __attribute__((address_space(3))) v4i32_t*)(kp+mb*512+1024); }
__device__ __forceinline__ f32x16 qk8(v8i32_t k,v8i32_t q,const f32x16&c){ return __builtin_amdgcn_mfma_scale_f32_32x32x64_f8f6f4(k,q,c,0,0,0,0x7c,0,0x7f); }
__device__ __forceinline__ s16x4 vtr(lds_cptr p){ return __builtin_bit_cast(s16x4,__builtin_amdgcn_ds_read_tr16_b64_v4i16((__attribute__((address_space(3))) v4i16_t*)p)); }
__device__ __forceinline__ float rowmax(const f32x16&p0,const f32x16&p1){
  float a=max3f(p0[0],p0[1],p1[0]),b=max3f(p0[2],p0[3],p1[1]);a=max3f(a,p1[2],p1[3]);
  #pragma unroll
  for(int r=4;r<16;r+=4){a=max3f(a,p0[r],p0[r+1]);b=max3f(b,p0[r+2],p0[r+3]);a=max3f(a,p1[r],p1[r+1]);b=max3f(b,p1[r+2],p1[r+3]);}
  const float m=max2f(a,b);
  auto rr=__builtin_amdgcn_permlane32_swap(__float_as_uint(m),__float_as_uint(m),false,false);
  return max2f(__uint_as_float(rr[0]),__uint_as_float(rr[1]));
}
__device__ __forceinline__ void pv(f32x16*o,int vb,bf16x8 pa0,bf16x8 pa1,bf16x8 pa2,bf16x8 pa3){
  #pragma unroll
  for(int d0=0;d0<2;++d0){s16x4 lo[4],hi[4];
    #pragma unroll
    for(int ks=0;ks<4;++ks){
      asm volatile("ds_read_b64_tr_b16 %0,%1 offset:%c2":"=&v"(lo[ks]):"v"(vb),"i"(d0*4096+ks*1024):"memory");
      asm volatile("ds_read_b64_tr_b16 %0,%1 offset:%c2":"=&v"(hi[ks]):"v"(vb),"i"(d0*4096+ks*1024+512):"memory");}
    asm volatile("s_waitcnt lgkmcnt(0)":::"memory");SBAR();
    #define PK(k) (bf16x8){lo[k][0],lo[k][1],lo[k][2],lo[k][3],hi[k][0],hi[k][1],hi[k][2],hi[k][3]}
    o[d0]=__builtin_amdgcn_mfma_f32_32x32x16_bf16(pa0,PK(0),o[d0],0,0,0);
    o[d0]=__builtin_amdgcn_mfma_f32_32x32x16_bf16(pa1,PK(1),o[d0],0,0,0);
    o[d0]=__builtin_amdgcn_mfma_f32_32x32x16_bf16(pa2,PK(2),o[d0],0,0,0);
    o[d0]=__builtin_amdgcn_mfma_f32_32x32x16_bf16(pa3,PK(3),o[d0],0,0,0);
    #undef PK
  }
}

#ifndef ATTN_STORE16
#define ATTN_STORE16(p,v) (*(u32x4*)(p)=(v))
#endif
template<int THRL> __device__ __forceinline__ void attn_unit(int b,int h,int qb,const bf16*Q,const bf16*__restrict__ K,const bf16*__restrict__ V,bf16*O,char*shm){
  int tid_=threadIdx.x; asm volatile("":"+v"(tid_)); const int tid=tid_,lane=tid&63,r32=lane&31,hi=lane>>5; const int wid=__builtin_amdgcn_readfirstlane(tid>>6);
  const long rowbase=(long)b*SEQ; const long kvbase=(long)b*SKVA; const int q0=qb*QB;
  const unsigned char*Qw=(const unsigned char*)Q+(rowbase+q0+wid*QBLK)*DM+h*D;
  const unsigned char*Kh=(const unsigned char*)K+((long)b*4+(h>>2))*(long)(SKVA*D);
  const unsigned char*Vh=(const unsigned char*)V+((long)b*4+(h>>2))*(long)(SKVA*D);
  const unsigned lds0=(unsigned)(uintptr_t)shm;
  const bool kw=wid<4;
  const unsigned char*ksrc=Kh+(wid&3)*1024+lane*16;
  const unsigned char*vsrc=Vh+(wid&3)*1024+lane*16;
  const unsigned kdst=lds0+LDS_K+(wid&3)*1024, vdst=lds0+LDS_V+(wid&3)*1024;
  #define DMA_K(t,slot) do{ if(kw) glds16(ksrc+(long)(t)*4096,(unsigned)__builtin_amdgcn_readfirstlane(kdst+(slot))); }while(0)
  #define DMA_V(t,slot) do{ if(!kw) glds16(vsrc+(long)(t)*4096,(unsigned)__builtin_amdgcn_readfirstlane(vdst+(slot))); }while(0)
  const unsigned char*rsrc=kw?ksrc+5l*4096:vsrc+3l*4096; const long rstep=4096; const unsigned rdst=kw?kdst:vdst;
  #define DMA_R(t) glds16(rsrc+(long)(t)*rstep,(unsigned)__builtin_amdgcn_readfirstlane(rdst+(kw?sl_cur:sl_m2)))
  v8i32_t kf[2],vf[2];
  const lds_cptr shm3=(lds_cptr)shm; const lds_cptr kp0=shm3+LDS_K+hi*2048+r32*16; const lds_cptr vp0=shm3+LDS_V+hi*2048+r32*16;
  const int NT=SKVA/KVBLK;
  DMA_K(0,0);DMA_V(0,0);
  const v8i32_t qr=*reinterpret_cast<const v8i32_t*>(Qw+(long)r32*DM+hi*32);
  int scl1=0x7f7f7f7f, sclq=0x7c7c7c7c; asm volatile("":"+v"(scl1),"+v"(sclq));
  #define QKA(C,k) asm volatile("v_mfma_scale_f32_32x32x64_f8f6f4 %0, %1, %2, %3, %4, %5 op_sel_hi:[0,0,0]":"=&v"(C):"v"(kf[k]),"v"(qr),"v"(negm),"v"(sclq),"v"(scl1))
  f32x16 o[2];o[0]=f32x16{};o[1]=f32x16{}; f32x16 lacc=f32x16{};
  v8i32_t ones; _Pragma("unroll") for(int r=0;r<8;++r)ones[r]=0x38383838; asm volatile("":"+v"(ones));
  f32x16 negm; _Pragma("unroll") for(int r=0;r<16;++r)negm[r]=-4.0f; asm volatile("":"+v"(negm));
  f32x16 pA0,pA1,pB0,pB1;
  int sl_m2=3*SLOTB,sl_prev=4*SLOTB,sl_cur=0,sl_next=SLOTB;
  #define ROT() do{sl_m2=sl_prev;sl_prev=sl_cur;sl_cur=sl_next;sl_next=(sl_next==(NSLOT-1)*SLOTB)?0:sl_next+SLOTB;}while(0)
  DMA_K(1,SLOTB);DMA_K(2,2*SLOTB);DMA_K(3,3*SLOTB);DMA_K(4,4*SLOTB);DMA_V(1,SLOTB);DMA_V(2,2*SLOTB);
  WAIT_BAR(4);
  #define EX(v) __builtin_amdgcn_exp2f(v)
  kload8f(kf,kp0,0);kload8f(kf,kp0,1);QKA(pA0,0);QKA(pA1,1);asm volatile("s_nop 15\n\ts_nop 15\n\ts_nop 15\n\ts_nop 15\n\ts_nop 15\n\ts_nop 15\n\ts_nop 15\n\ts_nop 15\n\ts_nop 15\n\ts_nop 15":"+v"(pA0),"+v"(pA1));
  _Pragma("unroll") for(int r=0;r<16;++r)pA0[r]=EX(pA0[r]);
  _Pragma("unroll") for(int r=0;r<16;++r)pA1[r]=EX(pA1[r]);
  WAIT_BAR(2);
  DMA_K(5,0);DMA_V(3,3*SLOTB);
  ROT();
  kload8f(kf,kp0+sl_cur,0);kload8f(kf,kp0+sl_cur,1);
  WAIT_BAR(3);
  v8i32_t pw=v8i32_t{};
  #define PK8(I,P,B) do{ int p_=__builtin_amdgcn_cvt_pk_fp8_f32(P[B],P[B+1],pw[I],false); pw[I]=__builtin_amdgcn_cvt_pk_fp8_f32(P[B+2],P[B+3],p_,true); }while(0)
  #define PIN(x) asm volatile("":"+v"(x))
  #define GAPB(X,B) do{ X[B]=EX(X[B]); X[B+1]=EX(X[B+1]); X[B+2]=EX(X[B+2]); X[B+3]=EX(X[B+3]); PIN(X); SBAR(); }while(0)
  #define LSM() asm volatile("v_mfma_scale_f32_32x32x64_f8f6f4 %0, %1, %2, %0, %3, %3 op_sel_hi:[0,0,0]":"+v"(lacc):"v"(ones),"v"(pw),"v"(scl1))
  #define PVM(d) asm volatile("v_mfma_scale_f32_32x32x64_f8f6f4 %0, %1, %2, %0, %3, %3 op_sel_hi:[0,0,0]":"+v"(o[d]):"v"(vf[d]),"v"(pw),"v"(scl1))
  #define EX8(X,B) do{ if(!(THRL&64)){ _Pragma("unroll") for(int e_=0;e_<8;++e_) X[(B)+e_]=EX(X[(B)+e_]); } PIN(X); SBAR(); }while(0)
  #define STEP(C0,C1,P0,P1,t,GK,GV,GL) do{ SBAR(); \
    kload8f(vf,vp0+sl_prev,0); kload8f(vf,vp0+sl_prev,1); SBAR(); \
    if(!(THRL&32)){QKA(C0,0);} SBAR(); \
    if(!(THRL&128)){PK8(0,P0,0); PK8(1,P0,4); PK8(2,P0,8); PK8(3,P0,12); PK8(4,P1,0); PK8(5,P1,4); PK8(6,P1,8); PK8(7,P1,12);} PIN(pw); SBAR(); \
    if(!(THRL&32)){QKA(C1,1);} SBAR(); \
    if((GK)&&(GV)){DMA_R(t);} else { if(GK){DMA_K((t)+5,sl_cur);} if(GV){DMA_V((t)+3,sl_m2);} } \
    asm volatile("s_nop 7":::"memory"); SBAR(); \
    EX8(C0,0); \
    if(!(THRL&16)){PVM(0);} EX8(C0,8); \
    if(!(THRL&16)){PVM(1);} if(GL){ kload8f(kf,kp0+sl_next,0); kload8f(kf,kp0+sl_next,1); SBAR(); } EX8(C1,0); \
    if(!(THRL&16)){LSM();} EX8(C1,8); \
    }while(0)
  int t=1;
  for(;t+6<NT;t+=2){
    STEP(pB0,pB1,pA0,pA1,t,true,true,true);     WAIT_BAR(3); ROT();
    STEP(pA0,pA1,pB0,pB1,t+1,true,true,true);   WAIT_BAR(3); ROT();
  }
  #define ENDW(tt) do{ if((tt)+5<NT){WAIT_BAR(3);} else if((tt)+4<NT){WAIT_BAR(2);} else if((tt)+3<NT){WAIT_BAR(1);} else {WAIT_BAR(0);} }while(0)
  for(;t+1<NT;t+=2){
    STEP(pB0,pB1,pA0,pA1,t,(t+5<NT),(t+3<NT),(t+1<NT));       ENDW(t);   ROT();
    STEP(pA0,pA1,pB0,pB1,t+1,(t+6<NT),(t+4<NT),(t+2<NT));     ENDW(t+1); ROT();
  }
  STEP(pB0,pB1,pA0,pA1,NT-1,false,false,false);
  { PK8(0,pB0,0);PK8(1,pB0,4);PK8(2,pB0,8);PK8(3,pB0,12);PK8(4,pB1,0);PK8(5,pB1,4);PK8(6,pB1,8);PK8(7,pB1,12); PIN(pw);
    kload8f(vf,vp0+sl_cur,0); kload8f(vf,vp0+sl_cur,1); SBAR();
    asm volatile("s_nop 7":::"memory"); LSM(); PVM(0); PVM(1); asm volatile("s_nop 15\n\ts_nop 15\n\ts_nop 15\n\ts_nop 15\n\ts_nop 15\n\ts_nop 15\n\ts_nop 15\n\ts_nop 15\n\ts_nop 15\n\ts_nop 15\n\ts_nop 15\n\ts_nop 15\n\ts_nop 15\n\ts_nop 15":"+v"(o[0]),"+v"(o[1]),"+v"(lacc)); }
  #undef PK8
  #undef PIN
  #undef GAPA
  #undef GAPB
  #undef EX8
  #undef EX
  #undef PVM
  #undef QKA
  #undef LSM
  #undef STEP
  #undef ENDW
  const float rli=__builtin_amdgcn_rcpf(lacc[0]);
  unsigned char*Ow=(unsigned char*)O+(rowbase+q0+wid*QBLK)*DMO+h*D;
  { unsigned char*stg=(unsigned char*)(shm+LDS_OST)+wid*4096;
    #pragma unroll
    for(int db=0;db<2;++db)
      #pragma unroll
      for(int g=0;g<4;++g){ int p_=__builtin_amdgcn_cvt_pk_fp8_f32(o[db][4*g]*rli,o[db][4*g+1]*rli,0,false); p_=__builtin_amdgcn_cvt_pk_fp8_f32(o[db][4*g+2]*rli,o[db][4*g+3]*rli,p_,true);
        *(int*)(stg+r32*64+db*32+8*g+4*hi)=p_; }
    asm volatile("s_waitcnt lgkmcnt(0)":::"memory");
    #pragma unroll
    for(int i=0;i<2;++i){const int p=lane+64*i,row=p>>2,ch=p&3; const u32x4 v=*(const u32x4*)(stg+row*64+ch*16); ATTN_STORE16(Ow+(long)row*DMO+ch*16,v);} }
  asm volatile("s_waitcnt lgkmcnt(0)\n\ts_barrier":::"memory");
  #undef DMA_K
  #undef DMA_V
  #undef DMA_R
  #undef ROT
}
constexpr int ATTN_LDS_BYTES=LDS_BYTES;
struct AttnTensors { const bf16* Q; const bf16* K; const bf16* V; bf16* O; };
struct AttnUnit { int bh; int qb; };
struct StaticOrder {
  int vcu,G;
  __device__ __forceinline__ explicit StaticOrder(int grid,int block):vcu((grid%8==0)?(block%8)*(grid/8)+block/8:block),G(grid){}
  __device__ __forceinline__ bool next(int i,AttnUnit&u)const{ const int L=i*G+vcu; if(L>=4096)return false; const int pair=L>>5,j=L&31; const int b=pair>>2,kvh=pair&3; u.bh=b*NHEAD+kvh*4+(j>>3); u.qb=j&7; return true; }
  __device__ __forceinline__ void a_ready(const AttnUnit&)const{}
  __device__ __forceinline__ void done(const AttnUnit&)const{}
};
template<class Sched,int THRL=8> __device__ __forceinline__ void attn_phase(char*lds,const AttnTensors&T,const Sched&S){
  AttnUnit u;
  for(int i=0;S.next(i,u);++i){ S.a_ready(u); attn_unit<THRL>(u.bh/NHEAD,u.bh%NHEAD,u.qb,T.Q,T.K,T.V,T.O,lds); S.done(u); }
}
#undef SBAR
#undef WAIT_BAR
}
typedef GAS unsigned gu32;
struct Params { const float* in[33]; float* out; unsigned char* ws; unsigned long long ws_size; int ph_lo, ph_hi, li, pad; };
struct Frame {
    LAS unsigned char* lds; volatile LAS unsigned* MISC; unsigned* ctl;
    int tid, lane, wave, vcu, G, gw, NGW;
    const float* const* in; float* out; unsigned char* ws;
};
enum { I_X = 0, I_C, I_CTX, I_CCTX, I_WMOD, I_BMOD, I_WIN, I_LAMRE, I_LAMIM, I_LOGDT, I_BRE, I_BIM, I_CRE, I_CIM, I_SD, I_WGLU, I_QG, I_KG, I_WBS, I_WBA, I_WOUT, I_LN1G, I_LN1B,
       I_WR, I_RB, I_WEG, I_WEU, I_WED, I_WSG, I_WSU, I_WSD, I_LN2G, I_LN2B };

__device__ __forceinline__ unsigned pk4_fp8(float a, float b, float c, float d);
__device__ __forceinline__ int down16_phys(int c) { return 128 * ((c >> 3) & 1) + 32 * (c >> 6) + 16 * ((c >> 2) & 1) + 4 * ((c >> 4) & 3) + (c & 3); }
__device__ __forceinline__ void p0_transpose_item(const float* W, int ldw, int K, bf16_t* WT, int n0, int k0, int drow, int gen, LAS float* scr, int lane) {
#pragma unroll 8
    for (int i = 0; i < 32; ++i) { const int kk = 2 * i + (lane >> 5); scr[kk * 33 + (lane & 31)] = W[(size_t)(k0 + kk) * ldw + n0 + (lane & 31)]; }
    LDS_WAIT(); asm volatile("" ::: "memory");
    const int c = lane & 7;
#pragma unroll
    for (int j = 0; j < 4; ++j) { const int n = (lane >> 3) + 8 * j; const LAS float* s = scr + (8 * c) * 33 + n;
        u32x4 o; o.x = cvt_pk_bf16(s[0 * 33], s[1 * 33]); o.y = cvt_pk_bf16(s[2 * 33], s[3 * 33]); o.z = cvt_pk_bf16(s[4 * 33], s[5 * 33]); o.w = cvt_pk_bf16(s[6 * 33], s[7 * 33]);
        const int pr = gen == 2 ? (drow & ~255) + down16_phys((drow & 255) + n) : drow + (gen ? pg8::invperm32(n) : n);
        *(GAS u32x4*)(WT + (size_t)pr * K + k0 + 8 * c) = o; }
    LDS_WAIT(); asm volatile("" ::: "memory");
}
__device__ __forceinline__ unsigned pk4_fp8(float a, float b, float c, float d) { int p = __builtin_amdgcn_cvt_pk_fp8_f32(a, b, 0, false); p = __builtin_amdgcn_cvt_pk_fp8_f32(c, d, p, true); return (unsigned)p; }
struct T8Item { const float* W; int ldw, K; unsigned char* WT; int n0, k0, drow, gen; };
__device__ __forceinline__ void t8_load(const T8Item& it, int lane, f32x4 (&v)[8]) {
    const int r8 = lane >> 3, c4 = (lane & 7) * 4;
#pragma unroll
    for (int i = 0; i < 8; ++i) v[i] = *(const f32x4*)(it.W + (size_t)(it.k0 + 8 * i + r8) * it.ldw + it.n0 + c4);
}
__device__ __forceinline__ void t8_finish(const T8Item& it, int lane, const f32x4 (&v)[8], LAS float* scr) {
    { const int r8 = lane >> 3, c4 = (lane & 7) * 4;
#pragma unroll
      for (int i = 0; i < 8; ++i) { LAS float* d = scr + (8 * i + r8) * 33 + c4; d[0] = v[i][0]; d[1] = v[i][1]; d[2] = v[i][2]; d[3] = v[i][3]; } }
    LDS_WAIT(); asm volatile("" ::: "memory");
    const int c = lane & 3; const float sc = (float)(1 << pg8::W8_SHIFT);
#pragma unroll
    for (int j = 0; j < 2; ++j) { const int n = (lane >> 2) + 16 * j; const LAS float* s = scr + (16 * c) * 33 + n;
        u32x4 o;
#pragma unroll
        for (int q = 0; q < 4; ++q) o[q] = pk4_fp8(s[(4 * q) * 33] * sc, s[(4 * q + 1) * 33] * sc, s[(4 * q + 2) * 33] * sc, s[(4 * q + 3) * 33] * sc);
        const int pr = it.gen == 2 ? (it.drow & ~255) + down16_phys((it.drow & 255) + n) : it.drow + (it.gen ? pg8::invperm32(n) : n);
        *(GAS u32x4*)(it.WT + (size_t)pr * it.K + it.k0 + 16 * c) = o; }
    LDS_WAIT(); asm volatile("" ::: "memory");
}
__device__ __forceinline__ void p0_transpose_item8(const float* W, int ldw, int K, unsigned char* WT, int n0, int k0, int drow, int gen, LAS float* scr, int lane) {
    const T8Item it{W, ldw, K, WT, n0, k0, drow, gen}; f32x4 v[8]; t8_load(it, lane, v); t8_finish(it, lane, v, scr);
}
__device__ __forceinline__ int win_phys_base(int n0, bool& gen) {
    if (n0 >= 1024 && n0 < 2304) {
        const int seg = n0 < 2048 ? 1024 : 2048, lq = n0 - seg, tile = lq >> 8, wc = (lq >> 6) & 3, bj = (lq >> 5) & 1;
        gen = false; return seg + tile * 256 + 128 * bj + 32 * wc;
    }
    if (n0 >= 2304 && n0 < 2560) { gen = false; return n0; }
    gen = true; return n0;
}
__device__ __forceinline__ int win_gen(int n0, bool gen) { return !gen ? 0 : ((n0 >= 2560 || n0 < 1024) ? 2 : 1); }
__device__ __forceinline__ void p0_mixer_weights(Frame& F, int nwg) {
    LAS float* scr = (LAS float*)(F.lds + F.wave * 16384);
    constexpr int I_IN = 16 * (NIN / 32), I_SQ = 16 * 32, I_R = 16 * 8;
    constexpr int NIT = I_IN + 4 * I_SQ + I_R;
    for (int it = (int)blockIdx.x * NWAVES + F.wave; it < NIT; it += nwg * NWAVES) {
        int r = it;
        if (r < I_IN) { const int nb = r % (NIN / 32), kb = r / (NIN / 32); bool gen; const int pr = win_phys_base(nb * 32, gen);
            p0_transpose_item8(F.in[I_WIN], NIN, 1024, (unsigned char*)(F.ws + WS_WIN), nb * 32, kb * 64, pr, win_gen(nb * 32, gen), scr, F.lane); continue; }
        r -= I_IN;
        if (r < 4 * I_SQ) { const int w = r / I_SQ, q = r % I_SQ, nb = q % 32, kb = q / 32;
            const float* src = F.in[w == 0 ? I_WGLU : w == 1 ? I_WBS : w == 2 ? I_WBA : I_WOUT];
            unsigned char* dst = (unsigned char*)(F.ws + (w == 0 ? WS_WGLU : w == 1 ? WS_WBS : w == 2 ? WS_WBS + 1024 : WS_WOUT));
            p0_transpose_item8(src, 1024, (w == 1 || w == 2) ? 2048 : 1024, dst, nb * 32, kb * 64, nb * 32, 2, scr, F.lane); continue; }
        r -= 4 * I_SQ;
        { const int nb = r % 8, kb = r / 8; p0_transpose_item(F.in[I_WR], 256, 1024, (bf16_t*)(F.ws + WS_WR), nb * 32, kb * 64, nb * 32, 1, scr, F.lane); }
    }
}
__device__ __forceinline__ T8Item p9_item(Frame& F, int it) {
    constexpr int PER_E = 128 + 128 + 128;
    const int e = it / PER_E, r = it % PER_E;
    if (r < 256) { const int up = r >> 7, q = r & 127, nb = q & 7, kb = q >> 3;
        const float* src = e < NEXP ? F.in[up ? I_WEU : I_WEG] + (size_t)e * 1024 * 256 : F.in[up ? I_WSU : I_WSG];
        const int h0 = nb * 32, pr = (h0 >> 7) * 256 + up * 128 + (h0 & 127);
        return T8Item{src, 256, 1024, (unsigned char*)(F.ws + WS_WGU) + (size_t)e * 512 * 1024, h0, kb * 64, pr, 1}; }
    const int q = r - 256, nb = q & 31, kb = q >> 5;
    const float* src = e < NEXP ? F.in[I_WED] + (size_t)e * 256 * 1024 : F.in[I_WSD];
    return T8Item{src, 1024, 256, (unsigned char*)(F.ws + WS_WD) + (size_t)e * 1024 * 256, nb * 32, kb * 64, nb * 32, 2};
}
__device__ __forceinline__ void p9_expert_weights(Frame& F) {
    LAS float* scr = (LAS float*)(F.lds + F.wave * 16384);
    constexpr int NIT = NEXPS * 384;
    const int st = F.NGW; int it = F.gw; if (it >= NIT) return;
    T8Item d0 = p9_item(F, it), d1 = d0, d2 = d0, d3 = d0; f32x4 q0[8], q1[8], q2[8], q3[8];
#define P9_LD(d, q, idx) do { if ((idx) < NIT) { d = p9_item(F, (idx)); t8_load(d, F.lane, q); } } while (0)
#define P9_FIN(d, q, idx) do { if ((idx) < NIT) t8_finish(d, F.lane, q, scr); } while (0)
    t8_load(d0, F.lane, q0); P9_LD(d1, q1, it + st); P9_LD(d2, q2, it + 2 * st);
#pragma unroll 1
    for (; it < NIT; it += 4 * st) {
        P9_LD(d3, q3, it + 3 * st); P9_FIN(d0, q0, it);
        P9_LD(d0, q0, it + 4 * st); P9_FIN(d1, q1, it + st);
        P9_LD(d1, q1, it + 5 * st); P9_FIN(d2, q2, it + 2 * st);
        P9_LD(d2, q2, it + 6 * st); P9_FIN(d3, q3, it + 3 * st);
    }
#undef P9_LD
#undef P9_FIN
}
__device__ __forceinline__ void p0_mod_item(Frame& F, int item) {
    const int n0 = item * 64, w = F.wave, lane = F.lane;
    LAS float* sbuf = (LAS float*)F.lds + w * (33 * 64);
    const float* cin = F.in[I_C]; const float* cctx = F.in[I_CCTX]; const float* wm = F.in[I_WMOD];
    float acc[33];
#pragma unroll
    for (int r = 0; r < 33; ++r) acc[r] = 0.f;
    for (int pass = 0; pass < 2; ++pass) {
        const int k0 = w * 128 + pass * 64;
#pragma unroll
        for (int r = 0; r < 33; ++r) { const float cv = r < 32 ? cin[r * 1024 + k0 + lane] : cctx[k0 + lane]; sbuf[r * 64 + lane] = silu_(cv); }
        LDS_WAIT(); asm volatile("" ::: "memory");
#pragma unroll 4
        for (int kk = 0; kk < 64; ++kk) { const float wv = wm[(size_t)(k0 + kk) * 6144 + n0 + lane];
#pragma unroll
            for (int r = 0; r < 33; ++r) acc[r] += sbuf[r * 64 + kk] * wv; }
        LDS_WAIT(); asm volatile("" ::: "memory");
    }
    __syncthreads();
    LAS float* red = (LAS float*)F.lds;
#pragma unroll
    for (int r = 0; r < 33; ++r) red[(w * 33 + r) * 64 + lane] = acc[r];
    __syncthreads();
    float* mod = (float*)(F.ws + WS_MOD);
    for (int o = F.tid; o < 33 * 64; o += NTHR) { const int r = o >> 6, l = o & 63; float s = F.in[I_BMOD][n0 + l];
#pragma unroll
        for (int w2 = 0; w2 < 8; ++w2) s += red[(w2 * 33 + r) * 64 + l];
        mod[r * 6144 + n0 + l] = s; }
    __syncthreads();
}
__device__ __forceinline__ void p0_s5_tables(Frame& F, int g) {
    LAS f32x2* pw = (LAS f32x2*)F.lds;
    LAS f32x2* bb = (LAS f32x2*)(F.lds + 33792);
    LAS f32x2* cc = (LAS f32x2*)(F.lds + 33792 + 16384);
    LAS float* ktab = (LAS float*)(F.lds + 33792 + 32768);
    const int tid = F.tid;
    if (tid < 128) {
        const int d = tid >> 6, p = tid & 63, base = (d * 64 + g) * 64 + p;
        const double lr = fmin((double)F.in[I_LAMRE][base], -1e-4), li = (double)F.in[I_LAMIM][base], dt = exp((double)F.in[I_LOGDT][d * 64 + g]);
        for (int k = 0; k <= 32; ++k) { const double mag = exp(k * lr * dt), ang = k * li * dt; pw[(d * 33 + k) * 64 + p] = (f32x2){(float)(mag * cos(ang)), (float)(mag * sin(ang))}; }
        { const double mag = exp(32 * lr * dt), ang = 32 * li * dt; float* laml = (float*)(F.ws + WS_LAML) + (size_t)base * 2; laml[0] = (float)(mag * cos(ang)); laml[1] = (float)(mag * sin(ang)); }
        const double m1 = exp(lr * dt), nr = m1 * cos(li * dt) - 1.0, ni = m1 * sin(li * dt), den = lr * lr + li * li;
        const double qr = (nr * lr + ni * li) / den, qi = (ni * lr - nr * li) / den;
        for (int c = 0; c < 16; ++c) { const double br = F.in[I_BRE][(size_t)base * 16 + c], bi = F.in[I_BIM][(size_t)base * 16 + c];
            bb[(d * 64 + p) * 16 + c] = (f32x2){(float)(qr * br - qi * bi), (float)(qr * bi + qi * br)}; }
    }
    for (int e = tid; e < 2048; e += NTHR) { const int d = e >> 10, c = (e >> 6) & 15, p = e & 63; const size_t gi = ((size_t)(d * 64 + g) * 16 + c) * 64 + p;
        cc[e] = (f32x2){F.in[I_CRE][gi], F.in[I_CIM][gi]}; }
    __syncthreads();
    for (int e = tid; e < 2 * 32 * 256; e += NTHR) {
        const int d = e >> 13, k = (e >> 8) & 31, c = (e >> 4) & 15, c2 = e & 15; float s = 0.f;
        for (int p = 0; p < 64; ++p) { const f32x2 C = cc[(d * 16 + c) * 64 + p], P = pw[(d * 33 + k) * 64 + p], B = bb[(d * 64 + p) * 16 + c2];
            const float tr = C.x * P.x - C.y * P.y, ti = C.x * P.y + C.y * P.x; s += tr * B.x - ti * B.y; }
        ktab[e] = s;
    }
    __syncthreads();
    const float* dsk = F.in[I_SD] + g * 16;
    unsigned char* tm = (unsigned char*)(F.ws + WS_TMAT) + (size_t)g * NS5 * KAUG;
    for (int ch = tid; ch < NS5 * (KAUG / 8); ch += NTHR) {
        const int rho = ch / (KAUG / 8), kc = ch % (KAUG / 8), rr_ = rho & 255;
        const int n = (rho & ~255) + 64 * ((rr_ >> 5) & 3) + 16 * ((rr_ >> 2) & 3) + 8 * (rr_ >> 7) + 4 * ((rr_ >> 4) & 1) + (rr_ & 3), t = n >> 4, c = n & 15;
        float v[8];
#pragma unroll
        for (int i = 0; i < 8; ++i) { const int kk = kc * 8 + i;
            if (kk < NS5) { const int s = kk >> 4, c2 = kk & 15;
                v[i] = t > s ? ktab[(t - s) * 256 + c * 16 + c2] : s > t ? ktab[8192 + (s - t) * 256 + c * 16 + c2] : ktab[c * 16 + c2] + ktab[8192 + c * 16 + c2] + (c == c2 ? dsk[c] : 0.f);
            } else { const int j = kk - NS5, d = j >> 7, p = (j & 127) >> 1, ri = j & 1, e = d == 0 ? t + 1 : LC5 - t;
                const f32x2 C = cc[(d * 16 + c) * 64 + p], P = pw[(d * 33 + e) * 64 + p];
                v[i] = (ri == 0 ? C.x * P.x - C.y * P.y : -(C.x * P.y + C.y * P.x)) * (1.0f / CARRY_SCALE); } }
        const float ts = (float)(1 << TMAT_SHIFT); u32x2 o; o.x = pk4_fp8(v[0] * ts, v[1] * ts, v[2] * ts, v[3] * ts); o.y = pk4_fp8(v[4] * ts, v[5] * ts, v[6] * ts, v[7] * ts);
        *(u32x2*)(tm + (size_t)rho * KAUG + kc * 8) = o;
    }
    unsigned char* wh = (unsigned char*)(F.ws + WS_WH) + (size_t)g * 256 * NS5;
    for (int ch = tid; ch < 256 * (NS5 / 8); ch += NTHR) {
        const int rho = ch / (NS5 / 8), kc = ch % (NS5 / 8), n = (rho & ~31) + pg8::perm32(rho & 31), d = n >> 7, p = (n & 127) >> 1, ri = n & 1;
        float v[8];
#pragma unroll
        for (int i = 0; i < 8; ++i) { const int kk = kc * 8 + i, s = kk >> 4, c2 = kk & 15, e = d == 0 ? LC5 - 1 - s : s;
            const f32x2 P = pw[(d * 33 + e) * 64 + p], B = bb[(d * 64 + p) * 16 + c2];
            v[i] = ri == 0 ? P.x * B.x - P.y * B.y : P.x * B.y + P.y * B.x; }
        const float hs = (float)(1 << WH_SHIFT); u32x2 o; o.x = pk4_fp8(v[0] * hs, v[1] * hs, v[2] * hs, v[3] * hs); o.y = pk4_fp8(v[4] * hs, v[5] * hs, v[6] * hs, v[7] * hs);
        *(u32x2*)(wh + (size_t)rho * NS5 + kc * 8) = o;
    }
    __syncthreads();
}
__device__ __forceinline__ void p0_rope(Frame& F) {
    float* rope = (float*)(F.ws + WS_ROPE);
    for (int idx = F.lane; idx < 64 * 16; idx += 64) { const int pos = idx >> 4, i = idx & 15;
        const double inv = exp(-9.210340371976184 * (double)i / 16.0), ang = (double)pos * inv; rope[idx * 2] = (float)cos(ang); rope[idx * 2 + 1] = (float)sin(ang); }
}

__device__ __forceinline__ void row_stats(const float (&v)[16], float eps, float& mean, float& rstd) {
    float s = 0.f;
#pragma unroll
    for (int i = 0; i < 16; ++i) s += v[i];
    mean = wave_sum(s) * (1.f / 1024.f); float q = 0.f;
#pragma unroll
    for (int i = 0; i < 16; ++i) { const float d = v[i] - mean; q += d * d; }
    rstd = 1.0f / sqrtf(wave_sum(q) * (1.f / 1024.f) + eps);
}
__device__ __forceinline__ void load16f(const float* row, int lane, float (&v)[16]) {
#pragma unroll
    for (int h = 0; h < 2; ++h) { const f32x4 a = *(const f32x4*)(row + h * 512 + lane * 8), b = *(const f32x4*)(row + h * 512 + lane * 8 + 4);
#pragma unroll
        for (int j = 0; j < 4; ++j) { v[h * 8 + j] = a[j]; v[h * 8 + 4 + j] = b[j]; } }
}
__device__ __forceinline__ void load16b(const bf16_t* row, int lane, float (&v)[16]) {
#pragma unroll
    for (int h = 0; h < 2; ++h) { const u32x4 w = *(const u32x4*)(row + h * 512 + lane * 8);
        v[h * 8 + 0] = bflo(w.x); v[h * 8 + 1] = bfhi(w.x); v[h * 8 + 2] = bflo(w.y); v[h * 8 + 3] = bfhi(w.y); v[h * 8 + 4] = bflo(w.z); v[h * 8 + 5] = bfhi(w.z); v[h * 8 + 6] = bflo(w.w); v[h * 8 + 7] = bfhi(w.w); }
}
__device__ __forceinline__ void store16b(bf16_t* row, int lane, const float (&v)[16]) {
#pragma unroll
    for (int h = 0; h < 2; ++h) { u32x4 w; w.x = cvt_pk_bf16(v[h * 8 + 0], v[h * 8 + 1]); w.y = cvt_pk_bf16(v[h * 8 + 2], v[h * 8 + 3]); w.z = cvt_pk_bf16(v[h * 8 + 4], v[h * 8 + 5]); w.w = cvt_pk_bf16(v[h * 8 + 6], v[h * 8 + 7]);
        *(u32x4*)(row + h * 512 + lane * 8) = w; }
}
__device__ __forceinline__ void load16f_nt(const float* row, int lane, float (&v)[16]) {
#pragma unroll
    for (int q = 0; q < 4; ++q) { const f32x4 a = __builtin_nontemporal_load((const f32x4*)(row + lane * 16 + q * 4));
#pragma unroll
        for (int j = 0; j < 4; ++j) v[q * 4 + j] = a[j]; }
}
__device__ __forceinline__ void load16f_c(const float* row, int lane, float (&v)[16]) {
#pragma unroll
    for (int q = 0; q < 4; ++q) { const f32x4 a = *(const f32x4*)(row + lane * 16 + q * 4);
#pragma unroll
        for (int j = 0; j < 4; ++j) v[q * 4 + j] = a[j]; }
}
__device__ __forceinline__ void store16_fp8(unsigned char* row, int lane, const float (&v)[16]) {
    u32x4 w;
#pragma unroll
    for (int q = 0; q < 4; ++q) w[q] = pk4_fp8(v[q * 4], v[q * 4 + 1], v[q * 4 + 2], v[q * 4 + 3]);
    *(u32x4*)(row + lane * 16) = w;
}
__device__ __forceinline__ void load16f_q(const float* row, int lane, float (&v)[16]) {
#pragma unroll
    for (int q = 0; q < 4; ++q) { const f32x4 a = *(const f32x4*)(row + q * 256 + lane * 4);
#pragma unroll
        for (int j = 0; j < 4; ++j) v[q * 4 + j] = a[j]; }
}
__device__ __forceinline__ void p1_rows(Frame& F, const float* src, unsigned char* dst, int r0, int r1, const float* modrow) {
    float sh[16], sc[16]; load16f_q(modrow, F.lane, sh); load16f_q(modrow + 1024, F.lane, sc);
    for (int r = r0; r < r1; r += 4) {
        float v[4][16];
#pragma unroll
        for (int i = 0; i < 4; ++i) if (r + i < r1) load16f_q(src + (size_t)(r + i) * 1024, F.lane, v[i]);
#pragma unroll
        for (int i = 0; i < 4; ++i) if (r + i < r1) {
            float mean, rstd; row_stats(v[i], 1e-6f, mean, rstd);
#pragma unroll
            for (int e = 0; e < 16; ++e) v[i][e] = (v[i][e] - mean) * rstd * (1.f + sc[e]) + sh[e];
#pragma unroll
            for (int q = 0; q < 4; ++q) *(unsigned*)(dst + (size_t)(r + i) * 1024 + q * 256 + F.lane * 4) = pk4_fp8(v[i][q * 4], v[i][q * 4 + 1], v[i][q * 4 + 2], v[i][q * 4 + 3]); }
    }
}
__device__ __forceinline__ void p1_modulate(Frame& F, int lo, int hi, bool with_ctx) {
    const float* mod = (const float*)(F.ws + WS_MOD);
    const int RPW = (hi - lo) / 2048; constexpr int CPW = TC / 2048;
    for (int w = F.gw; w < 2048; w += F.NGW) {
        const int r0 = lo + w * RPW; p1_rows(F, F.in[I_X], (unsigned char*)(F.ws + WS_A), r0, r0 + RPW, mod + (size_t)(r0 >> 11) * 6144);
        if (with_ctx) { const int c0 = w * CPW; p1_rows(F, F.in[I_CTX], (unsigned char*)(F.ws + WS_UC), c0, c0 + CPW, mod + (size_t)32 * 6144); }
    }
}
__device__ __forceinline__ void load16b_c(const bf16_t* row, int lane, float (&v)[16]) {
    const u32x4 a = *(const u32x4*)(row + lane * 16), b = *(const u32x4*)(row + lane * 16 + 8);
    v[0] = bflo(a.x); v[1] = bfhi(a.x); v[2] = bflo(a.y); v[3] = bfhi(a.y); v[4] = bflo(a.z); v[5] = bfhi(a.z); v[6] = bflo(a.w); v[7] = bfhi(a.w);
    v[8] = bflo(b.x); v[9] = bfhi(b.x); v[10] = bflo(b.y); v[11] = bfhi(b.y); v[12] = bflo(b.z); v[13] = bfhi(b.z); v[14] = bflo(b.w); v[15] = bfhi(b.w);
}
__device__ __forceinline__ void store16b_c(bf16_t* row, int lane, const float (&v)[16]) {
    u32x4 a, b; a.x = cvt_pk_bf16(v[0], v[1]); a.y = cvt_pk_bf16(v[2], v[3]); a.z = cvt_pk_bf16(v[4], v[5]); a.w = cvt_pk_bf16(v[6], v[7]);
    b.x = cvt_pk_bf16(v[8], v[9]); b.y = cvt_pk_bf16(v[10], v[11]); b.z = cvt_pk_bf16(v[12], v[13]); b.w = cvt_pk_bf16(v[14], v[15]);
    *(u32x4*)(row + lane * 16) = a; *(u32x4*)(row + lane * 16 + 8) = b;
}
__device__ __forceinline__ void store16_fp8_h(unsigned char* row, int lane, const float (&v)[16]) {
#pragma unroll
    for (int h = 0; h < 2; ++h) { u32x2 w; w.x = pk4_fp8(v[h * 8], v[h * 8 + 1], v[h * 8 + 2], v[h * 8 + 3]); w.y = pk4_fp8(v[h * 8 + 4], v[h * 8 + 5], v[h * 8 + 6], v[h * 8 + 7]); *(u32x2*)(row + h * 512 + lane * 8) = w; }
}
__device__ __forceinline__ void p9_router_weights(Frame& F) {
    const float* mod = (const float*)(F.ws + WS_MOD); const bf16_t* wr = (const bf16_t*)(F.ws + WS_WR); bf16_t* wrb = (bf16_t*)(F.ws + WS_WRB); float* rvb = (float*)(F.ws + WS_RVB);
    for (int row = F.gw; row < NB * 256; row += F.NGW) {
        const int b = row >> 8, p = row & 255;
        float w[16], sh[16], sc[16]; load16b(wr + (size_t)p * 1024, F.lane, w); load16f(mod + (size_t)b * 6144 + 3072, F.lane, sh); load16f(mod + (size_t)b * 6144 + 4096, F.lane, sc);
        float av = 0.f, aw = 0.f, o[16];
#pragma unroll
        for (int e = 0; e < 16; ++e) { const float x = w[e] * (1.f + sc[e]); const float xr = __uint_as_float(cvt_pk_bf16(x, x) << 16); o[e] = xr; av += xr; aw += w[e] * sh[e]; }
        store16b(wrb + (size_t)row * 1024, F.lane, o);
        av = wave_sum(av); aw = wave_sum(aw);
        if (F.lane == 0) { const int e = (p & ~31) + pg8::perm32(p & 31); rvb[b * 512 + e] = av; rvb[b * 512 + 256 + e] = aw; }
    }
}
__device__ __forceinline__ void p9_ln1(Frame& F) {
    const float* mod = (const float*)(F.ws + WS_MOD);
    float g[16], bta[16]; load16f(F.in[I_LN1G], F.lane, g); load16f(F.in[I_LN1B], F.lane, bta);
    constexpr int RPW = T / 2048;
    for (int w = F.gw; w < 2048; w += F.NGW) {
        const int r0 = w * RPW, b = r0 >> 11;
        float sh[16], sc[16]; load16f(mod + (size_t)b * 6144 + 3072, F.lane, sh); load16f(mod + (size_t)b * 6144 + 4096, F.lane, sc);
        for (int r = r0; r < r0 + RPW; r += 4) {
            float v[4][16];
#pragma unroll
            for (int i = 0; i < 4; ++i) load16b((const bf16_t*)(F.ws + WS_X1) + (size_t)(r + i) * 1024, F.lane, v[i]);
#pragma unroll
            for (int i = 0; i < 4; ++i) {
                float mean, rstd; row_stats(v[i], 1e-5f, mean, rstd);
#pragma unroll
                for (int e = 0; e < 16; ++e) v[i][e] = (v[i][e] - mean) * rstd * g[e] + bta[e];
                store16b((bf16_t*)(F.ws + WS_X1) + (size_t)(r + i) * 1024, F.lane, v[i]);
                row_stats(v[i], 1e-6f, mean, rstd);
#pragma unroll
                for (int e = 0; e < 16; ++e) v[i][e] = (v[i][e] - mean) * rstd * (1.f + sc[e]) + sh[e];
                if (F.lane == 0) *(f32x2*)((float*)(F.ws + WS_STAT) + (size_t)(r + i) * 2) = (f32x2){mean, rstd};
                store16_fp8_h((unsigned char*)(F.ws + WS_U2) + (size_t)(r + i) * 1024, F.lane, v[i]); }
        }
    }
}
__device__ __forceinline__ void p4_carry_scan(Frame& F) {
    const unsigned* hfin = (const unsigned*)(F.ws + WS_HFIN);        const float* laml = (const float*)(F.ws + WS_LAML); unsigned char* saug = (unsigned char*)(F.ws + WS_SAUG);
    for (int item = F.gw; item < NB * 64 * 2; item += F.NGW) {
        const int d = item & 1, g = (item >> 1) & 63, b = item >> 7, p = F.lane;
        const f32x2 lam = *(const f32x2*)(laml + ((size_t)(d * 64 + g) * 64 + p) * 2);
        float cr = 0.f, ci = 0.f;
        const size_t gbase = (size_t)g * ROWS_G;
        unsigned hv[8];
#pragma unroll
        for (int j = 0; j < 8; ++j) { const int jj = d == 0 ? j : 7 - j; hv[j] = hfin[((gbase + 2048 + b * 8 + jj) * 256 + d * 128) / 2 + p]; }
#pragma unroll
        for (int j = 0; j < 8; ++j) { const float nr = lam.x * cr - lam.y * ci + bflo(hv[j]), ni = lam.x * ci + lam.y * cr + bfhi(hv[j]); cr = nr; ci = ni; }
        for (int j0 = 0; j0 < 64; j0 += 8) {
#pragma unroll
            for (int j = 0; j < 8; ++j) { const int jj = d == 0 ? j0 + j : 63 - (j0 + j); hv[j] = hfin[((gbase + b * 64 + jj) * 256 + d * 128) / 2 + p]; }
#pragma unroll
            for (int j = 0; j < 8; ++j) { const int jj = d == 0 ? j0 + j : 63 - (j0 + j);
                *(unsigned short*)(saug + (gbase + b * 64 + jj) * KAUG + NS5 + d * 128 + p * 2) = (unsigned short)__builtin_amdgcn_cvt_pk_fp8_f32(cr * CARRY_SCALE, ci * CARRY_SCALE, 0, false);
                const float nr = lam.x * cr - lam.y * ci + bflo(hv[j]), ni = lam.x * ci + lam.y * cr + bfhi(hv[j]); cr = nr; ci = ni; }
        }
    }
}
__device__ __forceinline__ void p11_routing(Frame& F, int tile) {
    const float* logits = (const float*)(F.ws + WS_LOGIT); const float* rb = F.in[I_RB];
    int* eidx = (int*)(F.ws + WS_EIDX); float* gate = (float*)(F.ws + WS_GATE); int* slot = (int*)(F.ws + WS_SLOT); int* wgh = (int*)(F.ws + WS_WGH);
    LAS int* hist = (LAS int*)F.lds;
    for (int i = F.tid; i < 256; i += NTHR) hist[i] = 0;
    __syncthreads();
    const int g8 = F.lane & 7, sub = F.lane >> 3;
    float bias[32], vb[32], wb[32]; const float* rvb = (const float*)(F.ws + WS_RVB) + (tile >> 3) * 512; const float* stat = (const float*)(F.ws + WS_STAT);
#pragma unroll
    for (int j = 0; j < 8; ++j) { const f32x4 t = *(const f32x4*)(rb + g8 * 32 + j * 4); bias[j * 4] = t[0]; bias[j * 4 + 1] = t[1]; bias[j * 4 + 2] = t[2]; bias[j * 4 + 3] = t[3];
        const f32x4 a = *(const f32x4*)(rvb + g8 * 32 + j * 4), c = *(const f32x4*)(rvb + 256 + g8 * 32 + j * 4);
#pragma unroll
        for (int q = 0; q < 4; ++q) { vb[j * 4 + q] = a[q]; wb[j * 4 + q] = c[q]; } }
    for (int it = 0; it < 4; ++it) {
        const int token = tile * 256 + (it * 8 + F.wave) * 8 + sub; const float NEG = -INFINITY;
        float sc[32], bs[32]; const f32x2 ms = *(const f32x2*)(stat + (size_t)token * 2);
#pragma unroll
        for (int j = 0; j < 8; ++j) { const f32x4 t = *(const f32x4*)(logits + (size_t)token * 256 + g8 * 32 + j * 4);
#pragma unroll
            for (int q = 0; q < 4; ++q) { const float lg = ms[1] * (t[q] - ms[0] * vb[j * 4 + q]) + wb[j * 4 + q]; sc[j * 4 + q] = 1.0f / (1.0f + __expf(-lg)); bs[j * 4 + q] = sc[j * 4 + q] + bias[j * 4 + q]; } }
        float m1 = NEG, m2 = NEG;
#pragma unroll
        for (int j = 0; j < 32; ++j) { const float v = bs[j]; if (v > m1) { m2 = m1; m1 = v; } else if (v > m2) m2 = v; }
        const float gsc = m1 + m2; int rank = 0;
#pragma unroll
        for (int o = 1; o < 8; ++o) { const int og = (g8 + o) & 7; const float other = __shfl(gsc, (F.lane & ~7) | og); rank += (other > gsc || (other == gsc && og < g8)) ? 1 : 0; }
        if (rank >= 4) {
#pragma unroll
            for (int j = 0; j < 32; ++j) bs[j] = NEG; }
        int my_e = 0; float my_s = 0.f;
#pragma unroll 1
        for (int r = 0; r < 8; ++r) {
            float bv = NEG; int bi = 0;
#pragma unroll
            for (int j = 0; j < 32; ++j) if (bs[j] > bv) { bv = bs[j]; bi = j; }
            int gi = g8 * 32 + bi;
#pragma unroll
            for (int o = 1; o < 8; o <<= 1) { const float ov = __shfl_xor(bv, o); const int oi = __shfl_xor(gi, o); if (ov > bv || (ov == bv && oi < gi)) { bv = ov; gi = oi; } }
            float sw = 0.f; const bool mine = (gi >> 5) == g8;
#pragma unroll
            for (int j = 0; j < 32; ++j) if (mine && j == (gi & 31)) { sw = sc[j]; bs[j] = NEG; }
            sw = __shfl(sw, (F.lane & ~7) | (gi >> 5));
            if (g8 == r) { my_e = gi; my_s = sw; }
        }
        float ssum = my_s;
#pragma unroll
        for (int o = 1; o < 8; o <<= 1) ssum += __shfl_xor(ssum, o);
        const int pos = __hip_atomic_fetch_add(hist + my_e, 1, __ATOMIC_RELAXED, __HIP_MEMORY_SCOPE_WORKGROUP);
        eidx[(size_t)token * 8 + g8] = my_e; gate[(size_t)token * 8 + g8] = my_s / ssum * 2.5f; slot[(size_t)token * 8 + g8] = pos;
    }
    __syncthreads();
    for (int i = F.tid; i < 256; i += NTHR) wgh[tile * 256 + i] = hist[i];
    __syncthreads();
}
__device__ __forceinline__ void p12_dispatch(Frame& F) {
    constexpr int WPC = TCH / 256;
    LAS int* tot = (LAS int*)F.lds; LAS int* base = tot + 256; LAS int* off = tot + 512;
    const int w = (int)blockIdx.x, c = w / WPC; const int* wgh = (const int*)(F.ws + WS_WGH);
    if (F.tid < 256) { int t_ = 0, b_ = 0;
        for (int j = 0; j < WPC; ++j) { const int v = wgh[(c * WPC + j) * 256 + F.tid]; t_ += v; if (c * WPC + j < w) b_ += v; }
        tot[F.tid] = t_; base[F.tid] = b_; }
    __syncthreads();
    if (F.tid == 0) { int run = 0; for (int e = 0; e < 256; ++e) { off[e] = run; run += tot[e]; } }
    __syncthreads();
    const int* eidx = (const int*)(F.ws + WS_EIDX); int* slot = (int*)(F.ws + WS_SLOT); int* stok = (int*)(F.ws + WS_STOK) + (size_t)c * (SLOTS_CH + 256);
    for (int i = F.tid; i < 2048; i += NTHR) { const int a = w * 2048 + i, e = eidx[a], s = off[e] + base[e] + slot[a]; stok[s] = a >> 3; slot[a] = s; }
    for (int i = F.tid; i < 256; i += NTHR) { const int token = w * 256 + i; stok[TCH * 8 + (token - c * TCH)] = token; }
    if (w % WPC == 0 && F.tid == 0) {
        int* tiles = (int*)(F.ws + WS_TILES) + c * TILE_INTS; int nt_ = 0;
        for (int e = 0; e <= 256; ++e) { const int n = e < 256 ? tot[e] : TCH, o = e < 256 ? off[e] : TCH * 8;
            for (int r0 = 0; r0 < n; r0 += 256) { tiles[4 + nt_ * 4 + 0] = e; tiles[4 + nt_ * 4 + 1] = o + r0; tiles[4 + nt_ * 4 + 2] = (n - r0) < 256 ? (n - r0) : 256; tiles[4 + nt_ * 4 + 3] = 0; ++nt_; } }
        tiles[0] = nt_;
    }
    __syncthreads();
}
__device__ __forceinline__ void y16_fma(const u32x4& w, float s, float (&f)[16]) {
#pragma unroll
    for (int q = 0; q < 4; ++q) { const f32x2 a = __builtin_amdgcn_cvt_pk_f32_fp8((int)w[q], false), b = __builtin_amdgcn_cvt_pk_f32_fp8((int)w[q], true);
        f[q * 4 + 0] += s * a[0]; f[q * 4 + 1] += s * a[1]; f[q * 4 + 2] += s * b[0]; f[q * 4 + 3] += s * b[1]; }
}
template <int TIF> __device__ __forceinline__ void p15_combine(Frame& F, int c) {
    const float* mod = (const float*)(F.ws + WS_MOD); const unsigned char* Y = (const unsigned char*)(F.ws + WS_Y); const bf16_t* X1 = (const bf16_t*)(F.ws + WS_X1);
    const int* slot = (const int*)(F.ws + WS_SLOT); const float* gate = (const float*)(F.ws + WS_GATE);
    int lane_ = F.lane; asm volatile("" : "+v"(lane_));
    const float* gp_ = F.in[I_LN2G]; const float* bp_ = F.in[I_LN2B]; asm volatile("" : "+s"(gp_), "+s"(bp_));
    float g[16], bta[16]; load16f_c(gp_, lane_, g); load16f_c(bp_, lane_, bta);
    constexpr int TPW = TCH / 2048;
    for (int w = F.gw; w < 2048; w += F.NGW) {
        const int t0 = w * TPW, b = (c * TCH + t0) >> 11;
        float g2[16]; load16f_c(mod + (size_t)b * 6144 + 5120, lane_, g2);
        for (int tt = t0; tt < t0 + TPW; tt += TIF) {
            u32x4 yw[TIF][9], xa[TIF], xb[TIF]; float gt[TIF];
#pragma unroll
            for (int i = 0; i < TIF; ++i) { const int token = c * TCH + tt + i;
                int s = 0; gt[i] = 0.f; if (lane_ < 8) { s = slot[(size_t)token * 8 + lane_]; gt[i] = gate[(size_t)token * 8 + lane_]; }
                yw[i][8] = *(const u32x4*)(Y + (size_t)(TCH * 8 + tt + i) * 1024 + lane_ * 16);
#pragma unroll
                for (int k = 0; k < 8; ++k) { const int sk = __shfl(s, k); yw[i][k] = *(const u32x4*)(Y + (size_t)sk * 1024 + lane_ * 16); }
                xa[i] = *(const u32x4*)(X1 + (size_t)token * 1024 + lane_ * 16); xb[i] = *(const u32x4*)(X1 + (size_t)token * 1024 + lane_ * 16 + 8); }
#pragma unroll
            for (int i = 0; i < TIF; ++i) { const int token = c * TCH + tt + i;
                float f[16];
#pragma unroll
                for (int e = 0; e < 16; ++e) f[e] = 0.f;
                y16_fma(yw[i][8], 1.0f / YSCALE, f);
#pragma unroll
                for (int k = 0; k < 8; ++k) y16_fma(yw[i][k], __shfl(gt[i], k) * (1.0f / YSCALE), f);
                float x1[16];
                x1[0] = bflo(xa[i].x); x1[1] = bfhi(xa[i].x); x1[2] = bflo(xa[i].y); x1[3] = bfhi(xa[i].y); x1[4] = bflo(xa[i].z); x1[5] = bfhi(xa[i].z); x1[6] = bflo(xa[i].w); x1[7] = bfhi(xa[i].w);
                x1[8] = bflo(xb[i].x); x1[9] = bfhi(xb[i].x); x1[10] = bflo(xb[i].y); x1[11] = bfhi(xb[i].y); x1[12] = bflo(xb[i].z); x1[13] = bfhi(xb[i].z); x1[14] = bflo(xb[i].w); x1[15] = bfhi(xb[i].w);
#pragma unroll
                for (int e = 0; e < 16; ++e) f[e] = ALPHA * x1[e] + g2[e] * f[e];
                float mean, rstd; row_stats(f, 1e-5f, mean, rstd);
                LAS float* lrow = (LAS float*)(F.lds + F.wave * 4096);
#pragma unroll
                for (int q = 0; q < 4; ++q) { f32x4 o;
#pragma unroll
                    for (int j = 0; j < 4; ++j) o[j] = (f[q * 4 + j] - mean) * rstd * g[q * 4 + j] + bta[q * 4 + j];
                    *(LAS f32x4*)(lrow + lane_ * 16 + q * 4) = o; }
                LDS_WAIT(); asm volatile("" ::: "memory");
                float* orow = F.out + (size_t)token * 1024;
#pragma unroll
                for (int q = 0; q < 4; ++q) *(f32x4*)(orow + q * 256 + lane_ * 4) = *(const LAS f32x4*)(lrow + q * 256 + lane_ * 4);
                LDS_WAIT(); asm volatile("" ::: "memory");
            }
        }
    }
}
#if MK_DIAG
__device__ __forceinline__ unsigned dhash(unsigned i) { unsigned h = (i + 1u) * 2654435761u; h ^= h >> 15; h *= 2246822519u; h ^= h >> 13; return h; }
__device__ __forceinline__ void dreport(Frame& F, int k, float err) { atomicMax(F.ctl + CW_CHK + k, __float_as_uint(err)); }
__device__ __forceinline__ float relerr(float got, float exp_, float floor_) { return fabsf(got - exp_) / (fabsf(exp_) + floor_); }
__device__ __forceinline__ float ddot_b(const bf16_t* arow, int K, const float* W, int ldw, int col) { float s = 0.f; for (int k = 0; k < K; ++k) s += bf2f(arow[k]) * W[(size_t)k * ldw + col]; return s; }
__device__ __forceinline__ float dqk_ref(const bf16_t* urow, const float* win, int colbase, const float* gvec, bool rope, int l, int lane, int& spos) {
    const float d = ddot_b(urow, 1024, win, NIN, colbase + lane);
    const float ss = wave_sum(d * d), y = d * (1.0f / sqrtf(ss / 64.f + 1e-6f)) * gvec[lane];
    const float yp = __shfl(y, lane ^ 16);
    const int axis = lane >> 5, hd = lane & 31, i = hd & 15;
    float o = y;
    if (rope) { const float pos = axis == 0 ? (float)(l >> 6) : (float)(l & 63); const float ang = pos * powf(10000.f, -(float)i / 16.f); const float cs = cosf(ang), sn = sinf(ang);
        o = hd < 16 ? y * cs - yp * sn : yp * sn + y * cs; }
    const int bj = lane >> 5, n = (lane >> 4) & 1, fq = (lane >> 2) & 3, j = lane & 3; spos = 16 * fq + 8 * bj + 4 * n + j;
    return o;
}
#ifndef MK_DIAG_MASK
#define MK_DIAG_MASK 0xffffffffu
#endif
#define DCHK(k) (((MK_DIAG_MASK) >> (k)) & 1u)
template <int k> __device__ __forceinline__ void diag_checks(Frame& F) {
    unsigned char* ws = F.ws; const int lane = F.lane;
    if constexpr (k == 0) {
        const float* mod = (const float*)(ws + WS_MOD);
        for (int s = F.gw; s < 512; s += F.NGW) { const unsigned h = dhash(s); const int r = h % 33, n = (h >> 8) % 6144; float a = 0.f;
            for (int kk = lane; kk < 1024; kk += 64) { const float cv = r < 32 ? F.in[I_C][r * 1024 + kk] : F.in[I_CCTX][kk]; a += cv / (1.f + expf(-cv)) * F.in[I_WMOD][(size_t)kk * 6144 + n]; }
            a = wave_sum(a) + F.in[I_BMOD][n]; dreport(F, 0, relerr(mod[r * 6144 + n], a, 0.05f)); }
        const bf16_t* wt = (const bf16_t*)(ws + WS_WIN);
        for (int s = F.gw * 64 + lane; s < 65536; s += F.NGW * 64) { const unsigned h = dhash(s + 777); const int n = h % NIN, kk = (h >> 13) % 1024; bool gen; const int base = win_phys_base(n & ~31, gen);
            const int pr = base + (gen ? pg8::invperm32(n & 31) : (n & 31)); dreport(F, 1, relerr(bf2f(wt[(size_t)pr * 1024 + kk]), F.in[I_WIN][(size_t)kk * NIN + n], 0.02f)); }
    } else if constexpr (k == 1) {
        const float* mod = (const float*)(ws + WS_MOD);
        for (int s = F.gw; s < 512; s += F.NGW) { const unsigned h = dhash(s + 31); const bool isc = (s & 7) == 7; const int r = isc ? h % TC : h % T, b = isc ? 32 : r >> 11;
            const float* xr = (isc ? F.in[I_CTX] : F.in[I_X]) + (size_t)r * 1024; float a = 0.f, q = 0.f;
            for (int c = lane; c < 1024; c += 64) a += xr[c];
            const float mean = wave_sum(a) / 1024.f;
            for (int c = lane; c < 1024; c += 64) q += (xr[c] - mean) * (xr[c] - mean);
            const float rstd = 1.f / sqrtf(wave_sum(q) / 1024.f + 1e-6f);
            const bf16_t* ur = (const bf16_t*)(ws + (isc ? WS_UC : WS_A)) + (size_t)r * 1024;
            for (int c = lane; c < 1024; c += 64) { const float e = (xr[c] - mean) * rstd * (1.f + mod[b * 6144 + 1024 + c]) + mod[b * 6144 + c]; dreport(F, 2, relerr(bf2f(ur[c]), e, 0.05f)); } }
    } else if constexpr (k == 2) {
        const bf16_t* U = (const bf16_t*)(ws + WS_A); const bf16_t* UC = (const bf16_t*)(ws + WS_UC); const float* win = F.in[I_WIN];
        for (int s = F.gw; s < 1024; s += F.NGW) {
            const unsigned h = dhash(s + 99); const bool isc = (s & 3) == 3; const int r = isc ? h % TC : h % T, b = isc ? r >> 8 : r >> 11, l = isc ? r & 255 : r & 2047;
            const bf16_t* ur = (isc ? UC : U) + (size_t)r * 1024; const int kind = (h >> 20) % 6;
            const int cb = (h >> 24) & 15;
            if (kind == 0) { const int n = (cb * 64 + lane), g = n >> 4, c = n & 15; const float d = ddot_b(ur, 1024, win, NIN, n);
                const int grow = isc ? 2048 + b * 8 + (l >> 5) : b * 64 + (l >> 5); const float got = bf2f(((const bf16_t*)(ws + WS_SAUG))[((size_t)g * ROWS_G + grow) * KAUG + (l & 31) * 16 + c]); dreport(F, 3, relerr(got, d, 0.5f)); }
            else if (kind == 1 && !isc) { const int head = cb; int sp; const float e = dqk_ref(ur, win, 1024 + head * 64, F.in[I_QG], true, l, lane, sp) * C2Q;
                dreport(F, 4, relerr(bf2f(((const bf16_t*)(ws + WS_Q))[(size_t)r * 1024 + head * 64 + sp]), e, 0.1f)); }
            else if (kind == 2) { const int head = cb & 3; int sp; const float e = dqk_ref(ur, win, 2048 + head * 64, F.in[I_KG], !isc, l, lane, sp);
                dreport(F, 5, relerr(bf2f(((const bf16_t*)(ws + WS_K))[((size_t)b * SKV + (isc ? l : CTX + l)) * 256 + head * 64 + sp]), e, 0.5f)); }
            else if (kind == 3) { const int n = (cb & 3) * 64 + lane; const float d = ddot_b(ur, 1024, win, NIN, 2304 + n);
                dreport(F, 6, relerr(bf2f(((const bf16_t*)(ws + WS_V))[((size_t)b * SKV + (isc ? l : CTX + l)) * 256 + n]), d, 0.5f)); }
            else if (kind >= 4 && !isc) { const int n = cb * 64 + lane; const float d = ddot_b(ur, 1024, win, NIN, (kind == 4 ? 2560 : 3584) + n);
                dreport(F, 7, relerr(bf2f(((const bf16_t*)(ws + (kind == 4 ? WS_GS : WS_GA)))[(size_t)r * 1024 + n]), 1.f / (1.f + expf(-d)), 0.2f)); }
        }
    } else if constexpr (k == 4) {
        const bf16_t* U = (const bf16_t*)(ws + WS_A); const float* win = F.in[I_WIN]; const bf16_t* Kb = (const bf16_t*)(ws + WS_K); const bf16_t* Vb = (const bf16_t*)(ws + WS_V); const bf16_t* O = (const bf16_t*)(ws + WS_Q);
        LAS float* sp_ = (LAS float*)(F.lds) + F.wave * 4096;
        for (int s = F.gw; s < 512; s += F.NGW) {
            const unsigned h = dhash(s + 4242); const int r = h % T, b = r >> 11, l = r & 2047, head = (h >> 20) & 15, kvh = head >> 2;
            int spos; const float qv = dqk_ref(U + (size_t)r * 1024, win, 1024 + head * 64, F.in[I_QG], true, l, lane, spos) * C2Q;
            sp_[spos] = bf2f(f2bf(qv)); LDS_WAIT();
            float mx = -1e30f;
            for (int j = lane; j < SKV; j += 64) { const bf16_t* kr = Kb + ((size_t)b * SKV + j) * 256 + kvh * 64; float d = 0.f; for (int e = 0; e < 64; ++e) d += sp_[e] * bf2f(kr[e]); sp_[64 + j] = d; mx = fmaxf(mx, d); }
#pragma unroll
            for (int o = 1; o < 64; o <<= 1) mx = fmaxf(mx, __shfl_xor(mx, o));
            float sm = 0.f;
            for (int j = lane; j < SKV; j += 64) { const float p = exp2f(sp_[64 + j] - mx); sp_[64 + j] = p; sm += p; }
            sm = wave_sum(sm); LDS_WAIT();
            float o = 0.f;
            for (int j = 0; j < SKV; ++j) o += sp_[64 + j] * bf2f(Vb[((size_t)b * SKV + j) * 256 + kvh * 64 + lane]);
            o /= sm;
            dreport(F, 8, relerr(bf2f(O[(size_t)r * 1024 + head * 64 + lane]), o, 0.05f));
            LDS_WAIT();
        }
    } else if constexpr (k == 5) {
        const bf16_t* SA = (const bf16_t*)(ws + WS_SAUG); const bf16_t* Z = (const bf16_t*)(ws + WS_A);
        for (int s = F.gw; s < 256; s += F.NGW) {
            const unsigned h = dhash(s + 555); const int b = h & 31, l = (h >> 5) & 2047, g = (h >> 16) & 63, p = lane;
            float y[16];
#pragma unroll
            for (int c = 0; c < 16; ++c) y[c] = 0.f;
            for (int d = 0; d < 2; ++d) {
                const int base = (d * 64 + g) * 64 + p;
                const float lr = fminf(F.in[I_LAMRE][base], -1e-4f), li = F.in[I_LAMIM][base], dt = expf(F.in[I_LOGDT][d * 64 + g]);
                const float mg = expf(lr * dt), lbr = mg * cosf(li * dt), lbi = mg * sinf(li * dt), nr = lbr - 1.f, ni = lbi, den = lr * lr + li * li, qr = (nr * lr + ni * li) / den, qi = (ni * lr - nr * li) / den;
                float Br[16], Bi[16];
#pragma unroll
                for (int c = 0; c < 16; ++c) { const float br = F.in[I_BRE][(size_t)base * 16 + c], bi = F.in[I_BIM][(size_t)base * 16 + c]; Br[c] = qr * br - qi * bi; Bi[c] = qr * bi + qi * br; }
                float hr = 0.f, hi = 0.f;
                const int nlat = d == 0 ? l + 1 : SEQ - l;
                for (int st = 0; st < CTX + nlat; ++st) {
                    int grow, t;
                    if (st < CTX) { const int lc = d == 0 ? st : CTX - 1 - st; grow = 2048 + b * 8 + (lc >> 5); t = lc & 31; }
                    else { const int ll = d == 0 ? st - CTX : SEQ - 1 - (st - CTX); grow = b * 64 + (ll >> 5); t = ll & 31; }
                    const bf16_t* up = SA + ((size_t)g * ROWS_G + grow) * KAUG + t * 16;
                    float ur = 0.f, ui = 0.f;
#pragma unroll
                    for (int c = 0; c < 16; ++c) { const float u = bf2f(up[c]); ur += Br[c] * u; ui += Bi[c] * u; }
                    const float n1 = lbr * hr - lbi * hi + ur, n2 = lbr * hi + lbi * hr + ui; hr = n1; hi = n2;
                }
#pragma unroll
                for (int c = 0; c < 16; ++c) { const size_t ci = ((size_t)(d * 64 + g) * 16 + c) * 64 + p; y[c] += F.in[I_CRE][ci] * hr - F.in[I_CIM][ci] * hi; }
            }
            const bf16_t* ul = SA + ((size_t)g * ROWS_G + b * 64 + (l >> 5)) * KAUG + (l & 31) * 16;
#pragma unroll
            for (int c = 0; c < 16; ++c) { float v = wave_sum(y[c]) + F.in[I_SD][g * 16 + c] * bf2f(ul[c]); const float u0 = 0.7978845608f * (v + 0.044715f * v * v * v); v = 0.5f * v * (1.f + tanhf(u0));
                if (lane == c) dreport(F, 9, relerr(bf2f(Z[((size_t)g * T + b * 2048 + l) * 16 + c]), v, 0.3f)); }
        }

    } else if constexpr (k == 6) {
        const bf16_t* Z = (const bf16_t*)(ws + WS_A); const bf16_t* SSM = (const bf16_t*)(ws + WS_SAUG);
        for (int s = F.gw; s < 512; s += F.NGW) { const unsigned h = dhash(s + 66); const int r = h % T, col = ((h >> 20) & 15) * 64 + lane; float d = 0.f;
            for (int kk = 0; kk < 1024; ++kk) d += bf2f(Z[((size_t)(kk >> 4) * T + r) * 16 + (kk & 15)]) * F.in[I_WGLU][(size_t)kk * 1024 + col];
            const float z = bf2f(Z[((size_t)(col >> 4) * T + r) * 16 + (col & 15)]); dreport(F, 10, relerr(bf2f(SSM[(size_t)r * 1024 + col]), z / (1.f + expf(-d)), 0.2f)); }
    } else if constexpr (k == 7) {
        const bf16_t* SSM = (const bf16_t*)(ws + WS_SAUG); const bf16_t* O = (const bf16_t*)(ws + WS_Q); const bf16_t* MG = (const bf16_t*)(ws + WS_A);
        for (int s = F.gw; s < 512; s += F.NGW) { const unsigned h = dhash(s + 77); const int r = h % T, col = ((h >> 20) & 15) * 64 + lane;
            const float d1 = ddot_b(SSM + (size_t)r * 1024, 1024, F.in[I_WBS], 1024, col), d2 = ddot_b(O + (size_t)r * 1024, 1024, F.in[I_WBA], 1024, col);
            const float e = bf2f(((const bf16_t*)(ws + WS_GS))[(size_t)r * 1024 + col]) * d1 + bf2f(((const bf16_t*)(ws + WS_GA))[(size_t)r * 1024 + col]) * d2;
            dreport(F, 11, relerr(bf2f(MG[(size_t)r * 1024 + col]), e, 0.3f)); }
    } else if constexpr (k == 8) {
        const bf16_t* MG = (const bf16_t*)(ws + WS_A); const float* mod = (const float*)(ws + WS_MOD);
        for (int s = F.gw; s < 512; s += F.NGW) { const unsigned h = dhash(s + 88); const int r = h % T, col = ((h >> 20) & 15) * 64 + lane;
            const float d = ddot_b(MG + (size_t)r * 1024, 1024, F.in[I_WOUT], 1024, col), e = ALPHA * F.in[I_X][(size_t)r * 1024 + col] + mod[(size_t)(r >> 11) * 6144 + 2048 + col] * d;
            dreport(F, 12, relerr(bf2f(((const bf16_t*)(ws + WS_X1))[(size_t)r * 1024 + col]), e, 0.5f)); }
    } else if constexpr (k == 9) {
        const bf16_t* X1 = (const bf16_t*)(ws + WS_X1); const bf16_t* U2 = (const bf16_t*)(ws + WS_U2); const float* mod = (const float*)(ws + WS_MOD);
        for (int s = F.gw; s < 512; s += F.NGW) { const unsigned h = dhash(s + 909); const int r = h % T, b = r >> 11; const bf16_t* xr = X1 + (size_t)r * 1024; float a = 0.f, q = 0.f, a2 = 0.f, q2 = 0.f;
            for (int c = lane; c < 1024; c += 64) { const float v = bf2f(xr[c]), w = (v - F.in[I_LN1B][c]) / F.in[I_LN1G][c]; a += v; a2 += w; }
            const float mean = wave_sum(a) / 1024.f, mean2 = wave_sum(a2) / 1024.f;
            for (int c = lane; c < 1024; c += 64) { const float v = bf2f(xr[c]), w = (v - F.in[I_LN1B][c]) / F.in[I_LN1G][c]; q += (v - mean) * (v - mean); q2 += (w - mean2) * (w - mean2); }
            const float rstd = 1.f / sqrtf(wave_sum(q) / 1024.f + 1e-6f), var2 = wave_sum(q2) / 1024.f;
            if (lane == 0) dreport(F, 13, fabsf(mean2) * 3.f + fabsf(var2 - 1.f) * 3.f);
            for (int c = lane; c < 1024; c += 64) { const float e = (bf2f(xr[c]) - mean) * rstd * (1.f + mod[b * 6144 + 4096 + c]) + mod[b * 6144 + 3072 + c]; dreport(F, 14, relerr(bf2f(U2[(size_t)r * 1024 + c]), e, 0.5f)); } }
        const bf16_t* wgu = (const bf16_t*)(ws + WS_WGU); const bf16_t* wd = (const bf16_t*)(ws + WS_WD);
        for (int s = F.gw * 64 + lane; s < 65536; s += F.NGW * 64) { const unsigned h = dhash(s + 1234); const int e = h % NEXPS, kk = (h >> 9) & 1023, hid = (h >> 19) & 255, up = (h >> 27) & 1;
            const float* src = e < NEXP ? F.in[up ? I_WEU : I_WEG] + (size_t)e * 1024 * 256 : F.in[up ? I_WSU : I_WSG];
            const int pr = (hid >> 7) * 256 + up * 128 + (hid & 96) + pg8::invperm32(hid & 31);
            dreport(F, 15, relerr(bf2f(wgu[((size_t)e * 512 + pr) * 1024 + kk]), src[(size_t)kk * 256 + hid], 0.02f));
            const float* sd = e < NEXP ? F.in[I_WED] + (size_t)e * 256 * 1024 : F.in[I_WSD]; const int col = kk, k2 = hid;
            dreport(F, 16, relerr(bf2f(wd[((size_t)e * 1024 + (col & ~31) + pg8::invperm32(col & 31)) * 256 + k2]), sd[(size_t)k2 * 1024 + col], 0.02f)); }
    } else if constexpr (k == 10) {
        const bf16_t* U2 = (const bf16_t*)(ws + WS_U2); const float* lg = (const float*)(ws + WS_LOGIT);
        for (int s = F.gw; s < 512; s += F.NGW) { const unsigned h = dhash(s + 1010); const int r = h % T, col = ((h >> 20) & 3) * 64 + lane;
            dreport(F, 17, relerr(lg[(size_t)r * 256 + col], ddot_b(U2 + (size_t)r * 1024, 1024, F.in[I_WR], 256, col), 0.5f)); }
    } else if constexpr (k == 11) {
        const float* lg = (const float*)(ws + WS_LOGIT); const int* eidx = (const int*)(ws + WS_EIDX); const float* gate = (const float*)(ws + WS_GATE);
        LAS float* sc = (LAS float*)(F.lds) + F.wave * 1024; LAS float* bs = sc + 256; LAS float* gsc = sc + 512;
        for (int s = F.gw; s < 2048; s += F.NGW) { const unsigned h = dhash(s + 1111); const int tok = h % T;
            for (int e = lane; e < 256; e += 64) { const float v = 1.f / (1.f + expf(-lg[(size_t)tok * 256 + e])); sc[e] = v; bs[e] = v + F.in[I_RB][e]; }
            LDS_WAIT();
            if (lane == 0) {
                for (int g = 0; g < 8; ++g) { float m1 = -1e30f, m2 = -1e30f; for (int j = 0; j < 32; ++j) { const float v = bs[g * 32 + j]; if (v > m1) { m2 = m1; m1 = v; } else if (v > m2) m2 = v; } gsc[g] = m1 + m2; }
                for (int g = 0; g < 8; ++g) { int rank = 0; for (int o = 0; o < 8; ++o) if (gsc[o] > gsc[g] || (gsc[o] == gsc[g] && o < g)) ++rank; if (rank >= 4) for (int j = 0; j < 32; ++j) bs[g * 32 + j] = -1e30f; }
                float sel[8]; int se[8]; float ssum = 0.f; float err = 0.f;
#pragma unroll
                for (int r = 0; r < 8; ++r) { float bv = -1e31f; int bi = 0; for (int e = 0; e < 256; ++e) if (bs[e] > bv) { bv = bs[e]; bi = e; } bs[bi] = -1e31f; se[r] = bi; sel[r] = sc[bi]; ssum += sc[bi]; }
#pragma unroll
                for (int r = 0; r < 8; ++r) { if (eidx[(size_t)tok * 8 + r] != se[r]) err = 1.f; err = fmaxf(err, relerr(gate[(size_t)tok * 8 + r], sel[r] / ssum * 2.5f, 0.1f)); }
                dreport(F, 18, err);
            }
            LDS_WAIT();
        }
    } else if constexpr (k == 12) {
        const int* eidx = (const int*)(ws + WS_EIDX); const int* slot = (const int*)(ws + WS_SLOT); const int* stok = (const int*)(ws + WS_STOK);
        for (int s = F.gw * 64 + lane; s < 65536; s += F.NGW * 64) { const unsigned h = dhash(s + 1212); const int a = h % (T * 8), tok = a >> 3, c = tok / TCH; const int sl = slot[a];
            float err = 0.f; if (sl < 0 || sl >= TCH * 8) err = 1.f; else if (stok[(size_t)c * (SLOTS_CH + 256) + sl] != tok) err = 2.f;
            if (stok[(size_t)c * (SLOTS_CH + 256) + TCH * 8 + (tok - c * TCH)] != tok) err = 3.f;
            dreport(F, 19, err); }
        if (F.gw < NCHUNK && lane == 0) { int sum = 0; for (int e = 0; e < 256; ++e) sum += (int)__hip_atomic_load(F.ctl + CW_CNT + F.gw * 256 + e, RLX_AGENT); dreport(F, 20, sum == TCH * 8 ? 0.f : 1.f);
            const int* tiles = (const int*)(ws + WS_TILES) + F.gw * TILE_INTS; const int ntl = tiles[0]; int rows = 0; float err = (ntl < 64 || ntl > 1000) ? 1.f : 0.f;
            for (int i = 0; i < ntl && i < 1000; ++i) { if (tiles[4 + i * 4 + 1] != rows) err = 2.f; rows += tiles[4 + i * 4 + 2]; }
            if (rows != SLOTS_CH) err = 3.f; dreport(F, 21, err); }
    } else if constexpr (k == 20 || k == 21) {
        const int* eidx = (const int*)(ws + WS_EIDX); const int* slot = (const int*)(ws + WS_SLOT); const int* stok = (const int*)(ws + WS_STOK);
        const bf16_t* U2 = (const bf16_t*)(ws + WS_U2); const bf16_t* H = (const bf16_t*)(ws + WS_H); const bf16_t* Y = (const bf16_t*)(ws + WS_Y);
        for (int s = F.gw; s < 768; s += F.NGW) { const unsigned h = dhash(s + 2020 + k); const int sl = (s & 7) == 7 ? TCH * 8 + (h % TCH) : h % (TCH * 8); const int tok = stok[sl]; int e = 256;
            if (sl < TCH * 8) { e = -1; for (int kk = 0; kk < 8; ++kk) if (slot[(size_t)tok * 8 + kk] == sl) e = eidx[(size_t)tok * 8 + kk]; }
            if (e < 0 || tok < 0 || tok >= TCH) { dreport(F, 22, 5.f); continue; }
            if (k == 20) { const int hid = ((h >> 20) & 3) * 64 + lane;
                const float* wg = e < NEXP ? F.in[I_WEG] + (size_t)e * 1024 * 256 : F.in[I_WSG]; const float* wu = e < NEXP ? F.in[I_WEU] + (size_t)e * 1024 * 256 : F.in[I_WSU];
                const float g = ddot_b(U2 + (size_t)tok * 1024, 1024, wg, 256, hid), u = ddot_b(U2 + (size_t)tok * 1024, 1024, wu, 256, hid);
                dreport(F, 22, relerr(bf2f(H[(size_t)sl * 256 + hid]), g / (1.f + expf(-g)) * u, 0.3f));
            } else { const int col = ((h >> 20) & 15) * 64 + lane; const float* wdn = e < NEXP ? F.in[I_WED] + (size_t)e * 256 * 1024 : F.in[I_WSD];
                dreport(F, 23, relerr(bf2f(Y[(size_t)sl * 1024 + col]), ddot_b(H + (size_t)sl * 256, 256, wdn, 1024, col), 0.2f)); }
        }
    }
}
__device__ __forceinline__ void diag_finish(Frame& F, const XcdBarrier& bar, const Params& P) {
    xcd_barrier(bar);
    int code = 0;
    for (int j = 63; j >= 0; --j) { const float e = __uint_as_float(__hip_atomic_load(F.ctl + CW_CHK + j, RLX_AGENT)); if (!(e < 0.06f)) code = j + 1; }
#if MK_DIAG == 3
    code = 0; for (int j = 0; j < 6; ++j) { const float e = __uint_as_float(__hip_atomic_load(F.ctl + CW_CHK + MK_DIAG_BASE + j, RLX_AGENT)); if (!(e < 0.06f)) code |= 1 << j; }
#endif
#if MK_DIAG == 4
    code = (int)__hip_atomic_load(F.ctl + CW_CHK + 40, RLX_AGENT) / 4;
#endif
#if MK_DIAG == 5
    { const unsigned cyc = __hip_atomic_load(F.ctl + CW_CHK + 41, RLX_AGENT), rt_ = __hip_atomic_load(F.ctl + CW_CHK + 42, RLX_AGENT); const float ghz = rt_ ? (float)cyc / (float)rt_ : 0.f; code = ghz < 1.25f ? 1 : ghz < 1.75f ? 2 : ghz < 2.25f ? 3 : 4; }
#endif
#if MK_DIAG == 2
    code = (int)((P.ws_size - 1100000000ull) / 10000000ull); if (code < 0) code = 0; if (code > 80) code = 80;
#endif
    if (__hip_atomic_load(F.ctl + CW_BAR + XB_TMO, RLX_AGENT) != 0u) code = 90;
    const float v = sqrtf(10.f * (float)(code + 1));
    for (size_t i = (size_t)F.vcu * NTHR + F.tid; i < (size_t)T * DM / 4; i += (size_t)F.G * NTHR) ((f32x4*)F.out)[i] = (f32x4){v, v, v, v};
}
#endif
constexpr int N_PHASES = 16;
__global__ void __launch_bounds__(NTHR, 2) mk_fwd(Params P) {
    extern __shared__ __attribute__((aligned(16))) unsigned char lds_raw[];
    Frame F;
    F.lds = (LAS unsigned char*)lds_raw;
    F.MISC = (volatile LAS unsigned*)(F.lds + LDSCTL_OFF);
    F.tid = threadIdx.x; F.lane = F.tid & 63; F.wave = __builtin_amdgcn_readfirstlane(F.tid >> 6);
    F.G = gridDim.x; { const int bx = blockIdx.x; F.vcu = (F.G % 8 == 0) ? (bx % 8) * (F.G / 8) + bx / 8 : bx; }
    F.gw = F.vcu * NWAVES + F.wave; F.NGW = F.G * NWAVES;
    F.in = P.in; F.out = P.out; F.ws = P.ws; F.ctl = (unsigned*)(P.ws + WS_CTL);
    for (int u = F.tid; u < 128; u += NTHR) ((LAS unsigned*)(F.lds + LDSCTL_OFF))[u] = 0u;
    __syncthreads();
#if MK_DIAG == 4
    if (F.tid == 0 && (xb_xcc_id() != (blockIdx.x & 7u))) atomicAdd(F.ctl + CW_CHK + 40, 1u);
#endif
    XcdBarrier bar = xcd_barrier_post(F.ctl + CW_BAR + P.li * XCD_BAR_WORDS, F.MISC + 8);
    const int lo = P.ph_lo, hi = P.ph_hi;
    unsigned char* ws = P.ws;
    const int blk = (int)blockIdx.x;
#ifndef MK_DUP
#define MK_DUP 0u
#endif
#define REPS(k) ((((MK_DUP) >> (k)) & 1u) ? 2 : 1)
#define DUPBAR(k) do { if (REPS(k) == 2 && rep == 0) xcd_barrier(bar); } while (0)
#ifndef MK_PHMASK
#define MK_PHMASK 0xffffffffu
#endif
#define IN(k) (((MK_PHMASK >> (k)) & 1u) && lo <= (k) && (k) < hi)
#if MK_DIAG
#define SEAM(k) do { if (IN(k)) { xcd_barrier(bar); if constexpr (DCHK(k) != 0) { diag_checks<k>(F); xcd_barrier(bar); } } } while (0)
#else
#define SEAM(k) do { if (IN(k) && IN((k) + 1)) xcd_barrier(bar); } while (0)
#endif

    if (IN(0)) {
        if (blk < 96) p0_mod_item(F, blk);
    }
    SEAM(0);
#ifdef MK_XBAR
    for (int xb = 0; xb < MK_XBAR; ++xb) xcd_barrier(bar);
#endif
    if (IN(1)) {
        if (blk >= 192) p0_s5_tables(F, blk - 192);
        else { if (blk == 0 && F.wave == 0) p0_rope(F); p0_mixer_weights(F, 192); }
        p1_modulate(F, 0, T, true);
    }
    SEAM(1);
    if (IN(2)) {
        pg8::SchedInProj S{(unsigned)WS_A, (unsigned)WS_UC, (unsigned)WS_WIN, 8, F.G, blk, 0, 256, 32 * 6};
        pg8::EpiInProj E{(bf16_t*)(ws + WS_SAUG), (bf16_t*)(ws + WS_Q), (bf16_t*)(ws + WS_K), (bf16_t*)(ws + WS_V), (bf16_t*)(ws + WS_GS), (bf16_t*)(ws + WS_GA),
                         (const float*)(ws + WS_ROPE), F.in[I_QG], F.in[I_KG]};
#ifdef MK_DUPNULL
        if (REPS(2) == 2) { pg8::EpiNull E0{(float*)(ws + WS_ROPE + 32768)}; pg8::gemm_phase(F.lds, ws, S, E0); xcd_barrier(bar); }
#else
        if (REPS(2) == 2) { pg8::gemm_phase(F.lds, ws, S, E); xcd_barrier(bar); }
#endif
        pg8::gemm_phase(F.lds, ws, S, E);
    }
    SEAM(2);
    if (IN(3)) for (int rep = 0; rep < REPS(3); ++rep) {
        pg8::SchedGroupT<WH_SHIFT> S{(unsigned)WS_SAUG, (unsigned)WS_WH, KAUG, NS5, (unsigned)ROWS_G * KAUG, 256u * NS5, NS5 / 128, ROWS_G / 256, 1, F.G, blk};
        pg8::EpiBf16<0> E{(bf16_t*)(ws + WS_HFIN), 256, (size_t)ROWS_G * 256};
        pg8::gemm_phase(F.lds, ws, S, E);
        DUPBAR(3);
    }
    SEAM(3);
    if (IN(4)) {
        p4_carry_scan(F);
        VM_WAIT(); __syncthreads();
        for (int rep = 0; rep < REPS(4); ++rep) {
        const attn_body::AttnTensors AT{(const attn_body::bf16*)(ws + WS_Q), (const attn_body::bf16*)(ws + WS_K), (const attn_body::bf16*)(ws + WS_V), (attn_body::bf16*)(ws + WS_O8)};
        const attn_body::StaticOrder S((int)F.G, blk);
        { attn_body::AttnUnit u;
          for (int i = 0; S.next(i, u); ++i) {

#ifdef MK_ATTN_ABL
              if (REPS(4) == 2 && rep == 0) attn_body::attn_unit<MK_ATTN_ABL>(u.bh / attn_body::NHEAD, u.bh % attn_body::NHEAD, u.qb, AT.Q, AT.K, AT.V, AT.O, (char*)lds_raw); else
#endif
              attn_body::attn_unit<8>(u.bh / attn_body::NHEAD, u.bh % attn_body::NHEAD, u.qb, AT.Q, AT.K, AT.V, AT.O, (char*)lds_raw);

#ifdef MK_CONV2
              if (i == (F.vcu & 15))
#else
              if (rep == REPS(4) - 1 && i == (F.vcu & 15))
#endif
               { p9_expert_weights(F); asm volatile("s_waitcnt vmcnt(0) lgkmcnt(0)\n\ts_barrier" ::: "memory"); }
          } }
        DUPBAR(4);
        }
    }
    SEAM(4);
    if (IN(5)) for (int rep = 0; rep < REPS(5); ++rep) {
        pg8::SchedGroupT<TMAT_SHIFT> S{(unsigned)WS_SAUG, (unsigned)WS_TMAT, KAUG, KAUG, (unsigned)ROWS_G * KAUG, (unsigned)NS5 * KAUG, KAUG / 128, 2048 / 256, 2, F.G, blk};
        pg8::EpiZ8 E{(unsigned char*)(ws + WS_Z8), (size_t)T * 16};
        pg8::gemm_phase(F.lds, ws, S, E);
        DUPBAR(5);
    }
    SEAM(5);
    if (IN(6)) for (int rep = 0; rep < REPS(6); ++rep) {
        pg8::SchedDenseT<true, true> S{(unsigned)WS_Z8, (unsigned)WS_WGLU, 16u, (unsigned)T * 16u, 1024u, 8u * T * 16u, 256u * 16u, 256u * 1024u, 8, 256, 4, F.G, blk};
        pg8::EpiGate8<0> E{(const unsigned char*)(ws + WS_Z8), nullptr, (unsigned char*)(ws + WS_CAT), 2048};
        pg8::gemm_phase(F.lds, ws, S, E);
        DUPBAR(6);
    }
    SEAM(6);
    if (IN(7)) for (int rep = 0; rep < REPS(7); ++rep) {
        { pg8::SchedDenseT<true, false> S{(unsigned)WS_CAT, (unsigned)WS_WBS, 2048u, 0u, 2048u, 128u, 256u * 2048u, 256u * 2048u, 16, 256, 4, F.G, blk};
          pg8::EpiMerge8 E{(const unsigned char*)(ws + WS_GS), (const unsigned char*)(ws + WS_GA), (unsigned char*)(ws + WS_MG8)};
          pg8::gemm_phase(F.lds, ws, S, E); }
        DUPBAR(7);
    }
    SEAM(7);
#if MK_DIAG == 5
    unsigned long long c0_ = clock64(), r0_ = __builtin_amdgcn_s_memrealtime();
#endif
    if (IN(8)) for (int rep = 0; rep < REPS(8); ++rep) {
        pg8::SchedOutRow S{(unsigned)WS_MG8, (unsigned)WS_WOUT, 8, F.vcu};
#ifdef MK_DUPNULL
        if (REPS(8) == 2 && rep == 0) { pg8::EpiNull E0{(float*)(ws + WS_ROPE + 32768)}; pg8::gemm_phase(F.lds, ws, S, E0); } else
#endif
        { pg8::EpiOut16 E{F.in[I_X], (const float*)(ws + WS_MOD), (bf16_t*)(ws + WS_X1)};
        pg8::gemm_phase(F.lds, ws, S, E); }
        DUPBAR(8);
    }
#if MK_DIAG == 5
    if (blockIdx.x == 0 && F.tid == 0) { const unsigned long long c1_ = clock64(), r1_ = __builtin_amdgcn_s_memrealtime(); F.ctl[CW_CHK + 41] = (unsigned)((c1_ - c0_) / 10); F.ctl[CW_CHK + 42] = (unsigned)(r1_ - r0_); }
#endif
    if (IN(9)) { p9_router_weights(F); asm volatile("s_waitcnt vmcnt(0)" ::: "memory"); __syncthreads(); p9_ln1(F); }
    SEAM(9);
    if (IN(10)) {
        pg8::SchedRouter S{(unsigned)WS_X1, (unsigned)WS_WRB, 16, F.G, blk};
        pg8::EpiF32 E{(float*)(ws + WS_LOGIT), 256, 0};
        pg8::gemm_phase(F.lds, ws, S, E);
        pg8::Unit u0; u0.pm = 0; S.next(0, u0);
        asm volatile("s_waitcnt vmcnt(0)" ::: "memory"); __syncthreads();
        p11_routing(F, u0.pm);
    }
    SEAM(11);
    if (IN(12)) { p12_dispatch(F); }
    SEAM(12);
    if (IN(13)) {
        for (int c = 0; c < NCHUNK; ++c) {
            const int* tiles = (const int*)(ws + WS_TILES) + c * TILE_INTS;
            const int ntiles = __builtin_amdgcn_readfirstlane(__hip_atomic_load(tiles, RLX_AGENT));
            LAS unsigned* tt = (LAS unsigned*)(F.lds + RING_BYTES);
            __syncthreads();
            int tid_l = F.tid; asm volatile("" : "+v"(tid_l));
            for (int i = tid_l; i < ntiles && i < 1536; i += NTHR) { const int e_ = __hip_atomic_load(tiles + 4 + i * 4, RLX_AGENT), r0_ = __hip_atomic_load(tiles + 4 + i * 4 + 1, RLX_AGENT), nr_ = __hip_atomic_load(tiles + 4 + i * 4 + 2, RLX_AGENT);
                tt[i * 2] = (unsigned)r0_ | ((unsigned)(nr_ - 1) << 20); tt[i * 2 + 1] = (unsigned)e_; }
            __syncthreads();
#if !defined(MK_T13) || MK_T13 == 1
            for (int rep = 0; rep < REPS(13); ++rep)
            { pg8::SchedMoe<true> S{tt, ntiles, (unsigned)WS_U2, (unsigned)WS_WGU, (const int*)(ws + WS_STOK) + (size_t)c * (SLOTS_CH + 256), F.G, blk, 8};
              pg8::EpiMoe<true> E{(void*)(ws + WS_H)};
              pg8::gemm_phase(F.lds, ws, S, E); DUPBAR(13); }
#endif
            xcd_barrier(bar);
#if MK_DIAG
            if constexpr (DCHK(20) != 0) { if (c == 0) { diag_checks<20>(F); xcd_barrier(bar); } }
#endif
#if !defined(MK_T13) || MK_T13 == 2
            for (int rep = 0; rep < REPS(14); ++rep)
            { pg8::SchedMoe<false> S{tt, ntiles, (unsigned)WS_H, (unsigned)WS_WD, nullptr, F.G, blk, 2};
#ifdef MK_DUPNULL
              if (REPS(14) == 2 && rep == 0) { pg8::EpiNull E0{(float*)(ws + WS_ROPE + 32768)}; pg8::gemm_phase(F.lds, ws, S, E0); } else
#endif
              { pg8::EpiMoe<false> E{(void*)(ws + WS_Y)};
              pg8::gemm_phase(F.lds, ws, S, E); } DUPBAR(14); }
#endif
            xcd_barrier(bar);
#if MK_DIAG
            if constexpr (DCHK(21) != 0) { if (c == 0) { diag_checks<21>(F); xcd_barrier(bar); } }
#endif
#if !defined(MK_T13) || MK_T13 == 3
            for (int rep = 0; rep < REPS(15); ++rep) { p15_combine<2>(F, c); DUPBAR(15); }
#endif
        }
    }
#if MK_DIAG
    diag_finish(F, bar, P);
#endif
#undef IN
#undef SEAM
}

extern "C" void kernel_launch(void* const* d_in, const int* in_sizes, int n_in, void* d_out, int out_size, void* d_ws, size_t ws_size, hipStream_t stream) {
    static int grid = 0;
    if (grid == 0) {
        if (n_in != 33 || in_sizes[0] != T * DM || out_size != T * DM || ws_size < WS_END) {
            fprintf(stderr, "kernel_launch: unexpected shapes or workspace (n_in %d, in0 %d, out %d, ws %zu, need %zu); nothing launched\n", n_in, n_in > 0 ? in_sizes[0] : -1, out_size, ws_size, (size_t)WS_END); grid = -1; return; }
        int dev = 0, cus = 0, per_cu = 0;
        if (hipGetDevice(&dev) != hipSuccess || hipDeviceGetAttribute(&cus, hipDeviceAttributeMultiprocessorCount, dev) != hipSuccess) { grid = -1; return; }
        if (hipFuncSetAttribute((const void*)mk_fwd, hipFuncAttributeMaxDynamicSharedMemorySize, LDS_BYTES) != hipSuccess) { fprintf(stderr, "kernel_launch: hipFuncSetAttribute failed\n"); grid = -1; return; }
        if (hipOccupancyMaxActiveBlocksPerMultiprocessor(&per_cu, (const void*)mk_fwd, NTHR, LDS_BYTES) != hipSuccess || per_cu < 1) { fprintf(stderr, "kernel_launch: occupancy query reports %d workgroups per CU\n", per_cu); }
        (void)hipGetLastError();
        if (cus < 256) { fprintf(stderr, "kernel_launch: built for a 256-CU device (token ownership in the routing phases is per workgroup of a 256-workgroup grid); found %d CUs; nothing launched\n", cus); grid = -1; return; }
        grid = 256;
    }
    if (grid < 0) return;
    if (hipMemsetAsync((char*)d_ws + WS_CTL, 0, CTL_ZERO_BYTES, stream) != hipSuccess) { fprintf(stderr, "kernel_launch: memset failed\n"); return; }
    Params p{};
    for (int i = 0; i < 33; ++i) p.in[i] = (const float*)d_in[i];
    p.out = (float*)d_out; p.ws = (unsigned char*)d_ws; p.ws_size = (unsigned long long)ws_size;
#ifndef MK_CUTS
#ifndef MK_PH_HI
#define MK_PH_HI N_PHASES
#endif
    p.ph_lo = 0; p.ph_hi = MK_PH_HI;
    hipLaunchKernelGGL(mk_fwd, dim3(grid), dim3(NTHR), LDS_BYTES, stream, p);
#else
    { const int cuts[] = {MK_CUTS}; const int nc = (int)(sizeof(cuts) / sizeof(cuts[0]));
      for (int i = 0; i + 1 < nc; ++i) { p.ph_lo = cuts[i]; p.ph_hi = cuts[i + 1]; p.li = i; hipLaunchKernelGGL(mk_fwd, dim3(grid), dim3(NTHR), LDS_BYTES, stream, p); } }
#endif
    const hipError_t le = hipPeekAtLastError();
    if (le != hipSuccess) fprintf(stderr, "kernel_launch: launch failed: %s\n", hipGetErrorName(le));
}
```

```cpp
#include <hip/hip_runtime.h>
#include <cstdio>
#include <cstdint>


#ifndef MK_DIAG
#define MK_DIAG 0
#endif

#define LAS __attribute__((address_space(3)))
#define GAS __attribute__((address_space(1)))
typedef unsigned short bf16_t;
typedef short bf16x8 __attribute__((ext_vector_type(8)));
typedef float f32x4 __attribute__((ext_vector_type(4)));
typedef float f32x2 __attribute__((ext_vector_type(2)));
typedef unsigned u32x4 __attribute__((ext_vector_type(4)));
typedef unsigned u32x2 __attribute__((ext_vector_type(2)));

constexpr int NB = 32, SEQ = 2048, CTX = 256, DM = 1024, T = NB * SEQ, TC = NB * CTX;
constexpr int NIN = 4608;
constexpr int SKV = CTX + SEQ;
constexpr int LC5 = 32;
constexpr int NCHL = SEQ / LC5, NCHC = CTX / LC5;
constexpr int ROWS_G = NB * (NCHL + NCHC);
constexpr int NS5 = LC5 * 16;
constexpr int KAUG = NS5 + 256;
constexpr int NEXP = 256, NEXPS = 257, EH = 256, TOPK = 8;
constexpr int NCHUNK = 2, TCH = T / NCHUNK;
constexpr int SLOTS_CH = TCH * (TOPK + 1);
constexpr int TILE_INTS = 8192;
constexpr float CARRY_SCALE = 16.f;
constexpr int TMAT_SHIFT = 6, WH_SHIFT = 10;
constexpr float YSCALE = 16.f;
constexpr float ALPHA = 1.189207115002721f;
constexpr float C2Q = 0.125f * 1.4426950408889634f;

constexpr size_t MiB = 1u << 20;
constexpr size_t WS_CTL = 0, CTL_ZERO_BYTES = 1 * MiB;
constexpr size_t WS_MOD = 1 * MiB;
constexpr size_t WS_ROPE = 2 * MiB;
constexpr size_t WS_LAML = 2 * MiB + 65536;
constexpr size_t WS_TILES = 2 * MiB + 262144;
constexpr size_t WS_WGH = 2 * MiB + 524288;
constexpr size_t WS_EIDX = 3 * MiB;
constexpr size_t WS_GATE = 5 * MiB;
constexpr size_t WS_SLOT = 7 * MiB;
constexpr size_t WS_STOK = 9 * MiB;
constexpr size_t WS_WIN = 16 * MiB;
constexpr size_t WS_WGLU = 25 * MiB, WS_WBS = 27 * MiB, WS_WBA = 29 * MiB, WS_WOUT = 31 * MiB, WS_WR = 33 * MiB;
constexpr size_t WS_WGU = 34 * MiB;
constexpr size_t WS_WD = 163 * MiB;
constexpr size_t WS_X1 = 420 * MiB;
constexpr size_t WS_U2 = 548 * MiB;
constexpr size_t WS_WRB = 884 * MiB;
constexpr size_t WS_RVB = 900 * MiB;
constexpr size_t WS_STAT = 901 * MiB;
constexpr size_t WS_H = 676 * MiB;
constexpr size_t WS_Y = 820 * MiB;
constexpr size_t WS_LOGIT = 820 * MiB;
constexpr size_t WS_END_MOE = 1108 * MiB;
constexpr size_t WS_TMAT = 866 * MiB;
constexpr size_t WS_WH = 914 * MiB;
constexpr size_t WS_HFIN = 994 * MiB;
constexpr size_t WS_A = 242 * MiB;
constexpr size_t WS_CAT = 242 * MiB;
constexpr size_t WS_O8 = WS_CAT + 1024;
constexpr size_t WS_Z8 = 494 * MiB;
constexpr size_t WS_UC = 370 * MiB;
constexpr size_t WS_SAUG = 386 * MiB;
constexpr size_t WS_MG8 = 730 * MiB;
constexpr size_t WS_Q = 602 * MiB;
constexpr size_t WS_K = 730 * MiB;
constexpr size_t WS_V = 766 * MiB;
constexpr size_t WS_GS = 802 * MiB;
constexpr size_t WS_GA = 930 * MiB;
constexpr size_t WS_END = 1108 * MiB;
static_assert(WS_SAUG + (size_t)64 * ROWS_G * KAUG * 2 <= WS_Q && WS_HFIN + (size_t)64 * ROWS_G * 256 * 2 <= WS_END && WS_TMAT + (size_t)64 * NS5 * KAUG * 2 <= WS_WH && WS_WH + (size_t)64 * 256 * NS5 * 2 <= 930 * MiB, "ws map");
static_assert(WS_WGU + (size_t)NEXPS * 512 * 1024 <= WS_WD && WS_WD + (size_t)NEXPS * 1024 * 256 <= 242 * MiB && WS_H + (size_t)SLOTS_CH * 256 * 2 <= WS_Y && WS_Y + (size_t)SLOTS_CH * 1024 <= WS_END_MOE, "ws map moe");
constexpr int CW_TMO = 0, CW_CODE = 1;
constexpr int CW_CHK = 64;
constexpr int CW_BAR = 4096;
constexpr int CW_CNT = 65536;

constexpr int RING_BYTES = 131072;
constexpr int LDSCTL_OFF = 143360;
constexpr int IDX_OFF = LDSCTL_OFF + 512;
constexpr int LDS_BYTES = 147456;
constexpr int NWAVES = 8, NTHR = 512;

#define RLX_AGENT __ATOMIC_RELAXED, __HIP_MEMORY_SCOPE_AGENT
#define LDS_WAIT() asm volatile("s_waitcnt lgkmcnt(0)" ::: "memory")
#define VM_WAIT() asm volatile("s_waitcnt vmcnt(0)" ::: "memory")
__device__ __forceinline__ unsigned cvt_pk_bf16(float lo, float hi) { unsigned r; asm volatile("v_cvt_pk_bf16_f32 %0, %1, %2" : "=v"(r) : "v"(lo), "v"(hi)); return r; }
__device__ __forceinline__ float bf2f(unsigned short b) { return __uint_as_float((unsigned)b << 16); }
__device__ __forceinline__ float bflo(unsigned w) { return __uint_as_float(w << 16); }
__device__ __forceinline__ float bfhi(unsigned w) { return __uint_as_float(w & 0xffff0000u); }
__device__ __forceinline__ unsigned short f2bf(float f) { return (unsigned short)(cvt_pk_bf16(f, 0.f) & 0xffffu); }
__device__ __forceinline__ float sigmoidf_(float v) { return __builtin_amdgcn_rcpf(1.f + __builtin_amdgcn_exp2f(-1.4426950408889634f * v)); }
__device__ __forceinline__ float wave_sum(float v) {
#pragma unroll
    for (int o = 1; o < 64; o <<= 1) v += __shfl_xor(v, o);
    return v;
}
__device__ __forceinline__ float gelu_tanh(float x) { const float u = 0.7978845608028654f * (x + 0.044715f * x * x * x); return x * __builtin_amdgcn_rcpf(1.f + __builtin_amdgcn_exp2f(-2.885390081777927f * u)); }
__device__ __forceinline__ float silu_(float x) { return x * sigmoidf_(x); }

#define XB_TMO      128
#define XB_XCNT(j)  (256  + 64 * (j))
#define XB_XSUB(j)  (1280 + 64 * (j))
#define XB_XGEN(j)  (2304 + 64 * (j))
#define XB_TOP      3328
#define XB_TOPGEN   3392
#define XCD_BAR_WORDS 3456
#define XB_SPIN_CAP (1u << 18)
__device__ __forceinline__ unsigned xb_ld(unsigned* p)              { return __hip_atomic_load(p, __ATOMIC_RELAXED, __HIP_MEMORY_SCOPE_AGENT); }
__device__ __forceinline__ unsigned xb_add(unsigned* p, unsigned v) { return __hip_atomic_fetch_add(p, v, __ATOMIC_RELAXED, __HIP_MEMORY_SCOPE_AGENT); }
__device__ __forceinline__ unsigned xb_xcc_id() { return (unsigned)__builtin_amdgcn_s_getreg((3 << 11) | 20) & 0xFu; }
#define XB_SPIN(cond, bar) do { unsigned _sp = 0; while (cond) { __builtin_amdgcn_s_sleep(1); \
    if ((++_sp & 255u) == 0u) { if (xb_ld(&(bar)[XB_TMO])) break; if (_sp > XB_SPIN_CAP) { atomicAdd(&(bar)[XB_TMO], 1u); break; } } } } while (0)
struct XcdBarrier { unsigned* bar; unsigned x; volatile LAS unsigned* st; };
__device__ __forceinline__ XcdBarrier xcd_barrier_post(unsigned* bar, volatile LAS unsigned* st) {
    XcdBarrier b; b.bar = bar; b.x = xb_xcc_id(); b.st = st;
    if (threadIdx.x == 0) (void)xb_add(&bar[XB_XCNT(b.x)], 1u);
    return b;
}
__device__ __forceinline__ void xcd_barrier_complete(unsigned* bar, unsigned x, unsigned& nloc, unsigned& nx) {
    const unsigned G = gridDim.x * gridDim.y * gridDim.z;
    unsigned sum, cnt, sp = 0u;
    for (;;) {
        sum = 0u; cnt = 0u;
#pragma unroll 1
        for (unsigned j = 0; j < 16; ++j) { const unsigned c = xb_ld(&bar[XB_XCNT(j)]); sum += c; cnt += (c > 0u) ? 1u : 0u; }
        if (sum == G) break;
        __builtin_amdgcn_s_sleep(1);
        if ((++sp & 255u) == 0u) { if (xb_ld(&bar[XB_TMO])) break; if (sp > XB_SPIN_CAP) { atomicAdd(&bar[XB_TMO], 1u); break; } }
    }
    const unsigned mine = xb_ld(&bar[XB_XCNT(x)]);
    nloc = mine > 0u ? mine : 1u; nx = cnt > 0u ? cnt : 1u;
}
__device__ __forceinline__ void xcd_barrier(const XcdBarrier& b) {
    asm volatile("s_waitcnt vmcnt(0)" ::: "memory");
    __syncthreads();
    if (threadIdx.x == 0) {
        unsigned* bar = b.bar;
        __builtin_amdgcn_s_waitcnt(0);
        unsigned nloc = b.st[0], nx = b.st[1];
        if (nloc == 0u) { xcd_barrier_complete(bar, b.x, nloc, nx); b.st[0] = nloc; b.st[1] = nx; }
        const unsigned old = xb_add(&bar[XB_XSUB(b.x)], 1u);
        const unsigned gen = old / nloc;
        if (old + 1u == (gen + 1u) * nloc) {
            __builtin_amdgcn_fence(__ATOMIC_RELEASE, "agent");
            asm volatile("s_waitcnt vmcnt(0)" ::: "memory");
            const unsigned og = xb_add(&bar[XB_TOP], 1u);
            const unsigned tg = og / nx;
            if (og + 1u == (tg + 1u) * nx) xb_add(&bar[XB_TOPGEN], 1u);
            else XB_SPIN(xb_ld(&bar[XB_TOPGEN]) == tg, bar);
            __builtin_amdgcn_fence(__ATOMIC_ACQUIRE, "agent");
            xb_add(&bar[XB_XGEN(b.x)], 1u);
            asm volatile("s_waitcnt vmcnt(0)" ::: "memory");
        } else {
            XB_SPIN(xb_ld(&bar[XB_XGEN(b.x)]) == gen, bar);
            __builtin_amdgcn_fence(__ATOMIC_ACQUIRE, "agent");
            asm volatile("s_waitcnt vmcnt(0)" ::: "memory");
        }
    }
    __syncthreads();
}
namespace pg8 {
constexpr int BM = 256, BK = 64, HALF = 128, HTB = HALF * BK * 2, STAGE_BYTES = 8 * HTB;
__host__ __device__ __forceinline__ int lds_byte(int r, int c) { const int st = (r >> 4) * 2 + (c >> 5), rr = r & 15, cc = c & 31, ob = rr * 64 + cc * 2; return st * 1024 + (ob ^ (((ob >> 9) & 1) << 5)); }
__host__ __device__ __forceinline__ void stage_rc(int b, int& R, int& C) { const int st = b / 1024, sb = b % 1024, swz = sb ^ (((sb >> 9) & 1) << 5); R = (st >> 1) * 16 + swz / 64; C = (st & 1) * 32 + (swz % 64) / 2; }
__host__ __device__ __forceinline__ int perm32(int rho) { const int n = rho >> 4, i = rho & 15; return 8 * (i >> 2) + 4 * n + (i & 3); }
__host__ __device__ __forceinline__ int invperm32(int l) { return 16 * ((l >> 2) & 1) + 4 * (l >> 3) + (l & 3); }

struct Unit { unsigned A, B; int pm, pn, x0, x1; };
typedef f32x4 Acc[2][2][4][2];
typedef int v4i32 __attribute__((ext_vector_type(4)));
typedef int v8i32 __attribute__((ext_vector_type(8)));
constexpr int W8_SHIFT = 6;

struct NoHook { __device__ __forceinline__ void operator()(int) const {} };
template <class Epi, class Sched, class Hook = NoHook>
__device__ __forceinline__ void gemm_phase(LAS unsigned char* lds, const unsigned char* wsb, const Sched& S, const Epi& E, const Hook& H = Hook()) {
    int tid_ = threadIdx.x; asm volatile("" : "+v"(tid_));
    const int tid = tid_, wid = __builtin_amdgcn_readfirstlane(tid >> 6), lane = tid & 63, wr = wid >> 2, wc = wid & 3, fr = lane & 15, fq = lane >> 4;
    int nt_ = S.nt; asm volatile("" : "+s"(nt_)); const int nt = nt_;
    const unsigned kstepA = S.kstepA; constexpr unsigned kstepB = 128u;
    int sR[2], sC[2];
#pragma unroll
    for (int i = 0; i < 2; ++i) stage_rc(tid * 16 + i * 8192, sR[i], sC[i]);
    unsigned voffB[2], voC[2];
#pragma unroll
    for (int i = 0; i < 2; ++i) { voffB[i] = S.boff(sR[i], sC[i]); voC[i] = Sched::GATHER ? 0u : S.aoff(sR[i], sC[i]); }
    const unsigned hstepA = Sched::GATHER ? 0u : S.aoff(HALF, 0) - S.aoff(0, 0), hstepB = S.boff(HALF, 0) - S.boff(0, 0);
    int sclA = 0x7f7f7f7f, sclB = 0x7f7f7f7f - 0x01010101 * Sched::BSHIFT; asm volatile("" : "+v"(sclA), "+v"(sclB));
    const unsigned ldsw = (unsigned)wid * 1024u;
    const int aoff = lds_byte(wr * 64 + fr, fq * 8), boff = lds_byte(wc * 32 + fr, fq * 8);
#define PG8_SA(b, h) (((b) * 2 + (h)) * HTB)
#define PG8_SB(b, h) ((4 + (b) * 2 + (h)) * HTB)
#define PG8_STG(bufoff, gbase, v0, v1) do { \
        __builtin_amdgcn_global_load_lds((const unsigned*)(wsb + ((gbase) + (v0))), (LAS unsigned*)(lds + (bufoff) + ldsw), 16, 0, 0); \
        __builtin_amdgcn_global_load_lds((const unsigned*)(wsb + ((gbase) + (v1))), (LAS unsigned*)(lds + (bufoff) + ldsw + 8192), 16, 0, 0); } while (0)
#define PG8_STG_A(b, h, gbase, NR, IB) do { if constexpr (Sched::GATHER) { const unsigned v0_ = S.goff(NR, IB, lds, (h) * HALF + sR[0], sC[0]), v1_ = S.goff(NR, IB, lds, (h) * HALF + sR[1], sC[1]); PG8_STG(PG8_SA(b, h), gbase, v0_, v1_); } \
        else PG8_STG(PG8_SA(b, h), (gbase) + (h) * hstepA, voC[0], voC[1]); } while (0)
#define PG8_STG_B(b, h, gbase) PG8_STG(PG8_SB(b, h), (gbase) + (h) * hstepB, voffB[0], voffB[1])
#define PG8_LD32(p) __builtin_shufflevector(*(const LAS v4i32*)(p), *(const LAS v4i32*)((p) + 1024), 0, 1, 2, 3, 4, 5, 6, 7)
#define PG8_LDA(dst, b, h) do { _Pragma("unroll") for (int m = 0; m < 4; ++m) dst[m] = PG8_LD32(lds + PG8_SA(b, h) + aoff + m * 2048); } while (0)
#define PG8_LDB(dst, b, h) do { _Pragma("unroll") for (int n = 0; n < 2; ++n) dst[n] = PG8_LD32(lds + PG8_SB(b, h) + boff + n * 2048); } while (0)
#define PG8_MMA(ai, bj, At, Bt) do { __builtin_amdgcn_s_setprio(1); _Pragma("unroll") for (int m = 0; m < 4; ++m) _Pragma("unroll") for (int n = 0; n < 2; ++n) { \
        if constexpr (Sched::FP8) asm volatile("v_mfma_scale_f32_16x16x128_f8f6f4 %0, %1, %2, %0, %3, %4 op_sel_hi:[0,0,0]" : "+v"(acc[ai][bj][m][n]) : "v"(Bt[n]), "v"(At[m]), "v"(sclB), "v"(sclA)); \
        else { acc[ai][bj][m][n] = __builtin_amdgcn_mfma_f32_16x16x32_bf16(__builtin_bit_cast(bf16x8, __builtin_shufflevector(Bt[n], Bt[n], 0, 1, 2, 3)), __builtin_bit_cast(bf16x8, __builtin_shufflevector(At[m], At[m], 0, 1, 2, 3)), acc[ai][bj][m][n], 0, 0, 0); \
               acc[ai][bj][m][n] = __builtin_amdgcn_mfma_f32_16x16x32_bf16(__builtin_bit_cast(bf16x8, __builtin_shufflevector(Bt[n], Bt[n], 4, 5, 6, 7)), __builtin_bit_cast(bf16x8, __builtin_shufflevector(At[m], At[m], 4, 5, 6, 7)), acc[ai][bj][m][n], 0, 0, 0); } } \
        __builtin_amdgcn_s_setprio(0); } while (0)
#define PG8_WAIT_V(n) asm volatile("s_waitcnt vmcnt(" #n ")" ::: "memory")
#define PG8_WAIT_VN(n) do { const int n_ = (n); if (n_ == 4) asm volatile("s_waitcnt vmcnt(4)" ::: "memory"); else if (n_ == 6) asm volatile("s_waitcnt vmcnt(6)" ::: "memory"); else asm volatile("s_waitcnt vmcnt(8)" ::: "memory"); } while (0)
#define PG8_WAIT_V8X(fresh) do { if ((fresh) && Epi::NSTORE > 0) asm volatile("s_waitcnt vmcnt(%0)" :: "n"(8 + Epi::NSTORE) : "memory"); else asm volatile("s_waitcnt vmcnt(8)" ::: "memory"); } while (0)
#define PG8_WAIT_L(n) asm volatile("s_waitcnt lgkmcnt(" #n ")" ::: "memory")
#define PG8_BAR __builtin_amdgcn_s_barrier()
#define PG8_SCHED __builtin_amdgcn_sched_barrier(0)
    Unit cur, nxt; int ui = 0; bool ra = false;
    if (!S.next(0, cur)) return;
    if constexpr (Sched::STAGGER > 0) {
        const unsigned long long t0 = __builtin_amdgcn_s_memrealtime(), dt = (unsigned long long)((blockIdx.x >> 3) & 3) * Sched::STAGGER;
        while (__builtin_amdgcn_s_memrealtime() - t0 < dt) __builtin_amdgcn_s_sleep(8);
    }
    Acc acc;
#pragma unroll
    for (int a = 0; a < 2; ++a)
#pragma unroll
        for (int b = 0; b < 2; ++b)
#pragma unroll
            for (int m = 0; m < 4; ++m)
#pragma unroll
                for (int n = 0; n < 2; ++n) acc[a][b][m][n] = (f32x4){0.f, 0.f, 0.f, 0.f};
    v8i32 At[4], B0[2], B1[2];
    unsigned cA = cur.A, cB = cur.B;
    if constexpr (Sched::GATHER) { S.fetch(cur, 0, lds, wid, lane); PG8_WAIT_V(0); PG8_BAR; asm volatile("" ::: "memory"); }
    PG8_STG_B(0, 0, cB); PG8_STG_B(0, 1, cB); PG8_STG_A(0, 0, cA, cur.x1, 0); PG8_STG_A(0, 1, cA, cur.x1, 0);
    if (wr == 1) PG8_BAR;
    PG8_WAIT_V(2); PG8_BAR;
    PG8_STG_B(1, 0, cB + kstepB); PG8_STG_A(1, 0, cA + kstepA, cur.x1, 0); PG8_STG_B(1, 1, cB + kstepB);
    PG8_WAIT_V(6); PG8_BAR;
    for (;;) {
        const bool has_next = S.next(ui + 1, nxt);
        const unsigned nA = has_next ? nxt.A : cA, nB = has_next ? nxt.B : cB;
        bool rb = false; if constexpr (Sched::ARES) rb = has_next && (nxt.A == cA);
        if constexpr (Sched::GATHER) { if (has_next) S.fetch(nxt, (ui + 1) & 1, lds, wid, lane); }
#pragma unroll 1
        for (int t = 0; t < nt; t += 2) {
            const bool last = (t == nt - 2);
            const unsigned a1 = cA + (unsigned)(t + 1) * kstepA;
            const unsigned a2 = last ? nA : cA + (unsigned)(t + 2) * kstepA, b2 = last ? nB : cB + (unsigned)(t + 2) * kstepB;
            const unsigned a3 = a2 + kstepA, b3 = b2 + kstepB;
            if constexpr (Epi::MIDK > 0) { if (t == Epi::MIDK) { if constexpr (Sched::FP8) asm volatile("s_nop 15\n\ts_nop 15" ::: "memory"); E.mid(acc, cur, wr, wc, fr, fq); } }
            const bool fresh = (t == 0) && (ui > 0);
            const bool swn = last && has_next; const int nr1 = cur.x1, ib1 = ui & 1, nr2 = swn ? nxt.x1 : cur.x1, ib2 = swn ? ((ui + 1) & 1) : (ui & 1);
            PG8_LDB(B0, 0, 0); PG8_LDB(B1, 0, 1); PG8_SCHED; PG8_LDA(At, 0, 0); if (!(Sched::ARES && ra)) PG8_STG_A(1, 1, a1, nr1, ib1);
            if constexpr (Sched::ARES) PG8_WAIT_VN(ra ? 4 : 8); else PG8_WAIT_V8X(fresh); PG8_WAIT_L(0); PG8_BAR; PG8_MMA(0, 0, At, B0); PG8_MMA(0, 1, At, B1); PG8_BAR; PG8_SCHED;
            PG8_LDA(At, 0, 1); PG8_STG_B(0, 0, b2); PG8_STG_B(0, 1, b2); if (!(Sched::ARES && rb)) PG8_STG_A(0, 0, a2, nr2, ib2);
            if constexpr (Sched::ARES) PG8_WAIT_VN(4 + (ra ? 0 : 2) + (rb ? 0 : 2)); else PG8_WAIT_V8X(fresh); PG8_WAIT_L(0); PG8_BAR; PG8_MMA(1, 0, At, B0); PG8_MMA(1, 1, At, B1); PG8_BAR; PG8_SCHED;
            PG8_LDB(B0, 1, 0); PG8_LDB(B1, 1, 1); PG8_SCHED; PG8_LDA(At, 1, 0); if (!(Sched::ARES && rb)) PG8_STG_A(0, 1, a2, nr2, ib2);
            if constexpr (Sched::ARES) PG8_WAIT_VN(rb ? 4 : 8); else PG8_WAIT_V(8); PG8_WAIT_L(0); PG8_BAR; PG8_MMA(0, 0, At, B0); PG8_MMA(0, 1, At, B1); PG8_BAR; PG8_SCHED;
            PG8_LDA(At, 1, 1); PG8_STG_B(1, 0, b3); PG8_STG_B(1, 1, b3); if (!(Sched::ARES && rb)) PG8_STG_A(1, 0, a3, nr2, ib2);
            if constexpr (Sched::ARES) PG8_WAIT_VN(rb ? 4 : 8); else PG8_WAIT_V(8); PG8_WAIT_L(0); PG8_BAR; PG8_MMA(1, 0, At, B0); PG8_MMA(1, 1, At, B1); PG8_BAR; PG8_SCHED;
        }
        if (wr == 0) PG8_BAR;
        if constexpr (Sched::FP8) asm volatile("s_nop 15\n\ts_nop 15" ::: "memory");
        E(acc, cur, wr, wc, fr, fq);
        H(ui);
        if (!has_next) break;
#pragma unroll
        for (int a = 0; a < 2; ++a)
#pragma unroll
            for (int b = 0; b < 2; ++b)
#pragma unroll
                for (int m = 0; m < 4; ++m)
#pragma unroll
                    for (int n = 0; n < 2; ++n) acc[a][b][m][n] = (f32x4){0.f, 0.f, 0.f, 0.f};
        cur = nxt; cA = nA; cB = nB; ++ui; ra = rb;
        if (wr == 1) PG8_BAR;
    }
    PG8_WAIT_V(0);
    PG8_BAR;
#undef PG8_SA
#undef PG8_SB
#undef PG8_STG
#undef PG8_STG_A
#undef PG8_STG_B
#undef PG8_LDA
#undef PG8_LDB
#undef PG8_MMA
#undef PG8_WAIT_V
#undef PG8_WAIT_VN
#undef PG8_WAIT_L
#undef PG8_BAR
#undef PG8_SCHED
}

__device__ __forceinline__ int xcd_remap(int L, int nwg) { const int q = nwg / 8, r = nwg % 8, xcd = L % 8, off = L / 8; return (xcd < r ? xcd * (q + 1) : r * (q + 1) + (xcd - r) * q) + off; }
__device__ __forceinline__ void tile_of(int wgid, int nM, int nN, int& pm, int& pn) { const int WGM = 8; const int nig = WGM * nN, gid = wgid / nig, fm = gid * WGM, gsz = (nM - fm) < WGM ? (nM - fm) : WGM; pm = fm + ((wgid % nig) % gsz); pn = (wgid % nig) / gsz; }
}
namespace pg8 {
template <bool F8, bool GM> struct SchedDenseT {
    static constexpr bool GATHER = false; static constexpr int STAGGER = 0; static constexpr bool FP8 = F8; static constexpr int BSHIFT = W8_SHIFT; static constexpr bool ARES = false;
    unsigned A, B, rsA, gsA, rsB, kstepA, tileA, tileB; int nt, nM, nN, G, c;
    __device__ __forceinline__ unsigned aoff(int row, int C) const { return GM ? (unsigned)row * 16u + (unsigned)(C >> 3) * gsA + (unsigned)(C & 7) * 2u : (unsigned)row * rsA + (unsigned)C * 2u; }
    __device__ __forceinline__ unsigned boff(int row, int C) const { return (unsigned)row * rsB + (unsigned)C * 2u; }
    __device__ __forceinline__ bool next(int i, Unit& u) const {
        const int nwg = nM * nN; const long L = (long)i * G + c; if (L >= nwg) return false;
        int pm, pn; tile_of(xcd_remap((int)L, nwg), nM, nN, pm, pn);
        u.A = A + (unsigned)pm * tileA; u.B = B + (unsigned)pn * tileB; u.pm = pm; u.pn = pn; u.x0 = 0; u.x1 = 0; return true;
    }
};
typedef SchedDenseT<false, false> SchedDense;
struct SchedOutRow {
    static constexpr bool GATHER = false; static constexpr int STAGGER = 0; static constexpr bool FP8 = true; static constexpr int BSHIFT = W8_SHIFT; static constexpr bool ARES = false;
    unsigned A, B; int nt, pm; static constexpr unsigned kstepA = 128u;
    __device__ __forceinline__ unsigned aoff(int row, int C) const { return (unsigned)row * 1024u + (unsigned)C * 2u; }
    __device__ __forceinline__ unsigned boff(int row, int C) const { return (unsigned)row * 1024u + (unsigned)C * 2u; }
    __device__ __forceinline__ bool next(int i, Unit& u) const {
        if (i >= 4) return false;
        const int pn = (i + pm) & 3;
        u.A = A + (unsigned)pm * (256u * 1024u); u.B = B + (unsigned)pn * (256u * 1024u); u.pm = pm; u.pn = pn; u.x0 = 0; u.x1 = 0; return true;
    }
};
struct SchedRouter {
    static constexpr bool GATHER = false; static constexpr int STAGGER = 0; static constexpr bool FP8 = false; static constexpr int BSHIFT = W8_SHIFT; static constexpr bool ARES = false;
    unsigned A, B; int nt, G, c; static constexpr unsigned kstepA = 128u;
    __device__ __forceinline__ unsigned aoff(int row, int C) const { return (unsigned)row * 2048u + (unsigned)C * 2u; }
    __device__ __forceinline__ unsigned boff(int row, int C) const { return (unsigned)row * 2048u + (unsigned)C * 2u; }
    __device__ __forceinline__ bool next(int i, Unit& u) const {
        const long L = (long)i * G + c; if (L >= 256) return false;
        int pm, pn; tile_of(xcd_remap((int)L, 256), 256, 1, pm, pn);
        u.A = A + (unsigned)pm * (256u * 2048u); u.B = B + (unsigned)(pm >> 3) * (256u * 2048u); u.pm = pm; u.pn = 0; u.x0 = 0; u.x1 = 0; return true;
    }
};
struct SchedInProj {
    static constexpr bool GATHER = false; static constexpr int STAGGER = 0; static constexpr bool FP8 = true; static constexpr int BSHIFT = W8_SHIFT; static constexpr bool ARES = false;
    unsigned U, Uc, W; int nt, G, c, pm0, nMh, nctx; static constexpr unsigned kstepA = 128u;
    __device__ __forceinline__ unsigned aoff(int row, int C) const { return (unsigned)row * 1024u + (unsigned)C * 2u; }
    __device__ __forceinline__ unsigned boff(int row, int C) const { return (unsigned)row * 1024u + (unsigned)C * 2u; }
    __device__ __forceinline__ bool next(int i, Unit& u) const {
        const long L = (long)i * G + c; const int NL = nMh * 18;
        if (L < NL) { int pm, pn; tile_of(xcd_remap((int)L, NL), nMh, 18, pm, pn); pm += pm0; u.A = U + (unsigned)pm * 256u * 1024u; u.B = W + (unsigned)pn * 256u * 1024u; if (pn == 9) { const unsigned t_ = u.A; u.A = u.B; u.B = t_; } u.pm = pm; u.pn = pn; u.x0 = 0; u.x1 = 0; return true; }
        const int j = (int)(L - NL); if (j >= nctx) return false;
        const int pm = j / 6, q = j % 6, pn = q < 4 ? q : q + 4;
        u.A = Uc + (unsigned)pm * 256u * 1024u; u.B = W + (unsigned)pn * 256u * 1024u; if (pn == 9) { const unsigned t_ = u.A; u.A = u.B; u.B = t_; } u.pm = pm; u.pn = pn; u.x0 = 1; u.x1 = 0; return true;
    }
};
template <int BS> struct SchedGroupT {
    static constexpr bool GATHER = false; static constexpr int STAGGER = 0; static constexpr bool FP8 = true; static constexpr int BSHIFT = BS; static constexpr bool ARES = false;
    unsigned A, B, rsA, rsB, grpA, grpB; int nt, mt, ntn, G, c; static constexpr unsigned kstepA = 128u;
    __device__ __forceinline__ unsigned aoff(int row, int C) const { return (unsigned)row * rsA + (unsigned)C * 2u; }
    __device__ __forceinline__ unsigned boff(int row, int C) const { return (unsigned)row * rsB + (unsigned)C * 2u; }
    __device__ __forceinline__ bool next(int i, Unit& u) const {
        const int per = mt * ntn, nwg = 64 * per; const long L = (long)i * G + c; if (L >= nwg) return false;
        const int w = xcd_remap((int)L, nwg), g = w / per, r = w % per, pm = r / ntn, pn = r % ntn;
        u.A = A + (unsigned)g * grpA + (unsigned)pm * 256u * rsA; u.B = B + (unsigned)g * grpB + (unsigned)pn * 256u * rsB; u.pm = pm; u.pn = pn; u.x0 = g; u.x1 = 0; return true;
    }
};
#ifndef MK_STAG_DOWN
#define MK_STAG_DOWN 0
#endif
#ifndef MK_STAG_UP
#define MK_STAG_UP 0
#endif
template <bool UP> struct SchedMoe {
    static constexpr bool GATHER = true; static constexpr int STAGGER = UP ? MK_STAG_UP : MK_STAG_DOWN; static constexpr bool FP8 = true; static constexpr int BSHIFT = W8_SHIFT; static constexpr bool ARES = !UP;
    const LAS unsigned* tt; int ntiles; unsigned A, B; const int* stok; int G, c; static constexpr unsigned kstepA = 128u; int nt;
    __device__ __forceinline__ unsigned aoff(int, int) const { return 0u; }
    __device__ __forceinline__ unsigned boff(int row, int C) const { return (unsigned)row * (UP ? 1024u : 256u) + (unsigned)C * 2u; }
    __device__ __forceinline__ bool next(int i, Unit& u) const {
        int tile, pn;
        if (UP) { const int nwg = ntiles * 2; const long L = (long)i * G + c; if (L >= nwg) return false; const int w = xcd_remap((int)L, nwg); tile = w >> 1; pn = w & 1; }
        else {
            const int nfull = ntiles / G;
            if (i < 4 * nfull) { tile = xcd_remap((i >> 2) * G + c, ntiles); pn = i & 3; }
            else { const long q = (long)(i - 4 * nfull) * G + c; const int rem = ntiles - nfull * G; if (q >= 4L * rem) return false; tile = xcd_remap(nfull * G + (int)(q >> 2), ntiles); pn = (int)(q & 3); }
        }
        const unsigned w0 = __builtin_amdgcn_readfirstlane(tt[tile * 2]), w1 = __builtin_amdgcn_readfirstlane(tt[tile * 2 + 1]);
        const int e = (int)w1, row0 = (int)(w0 & 0xfffffu), nrows = (int)(w0 >> 20) + 1;
        if (UP) { u.A = A; u.B = B + ((unsigned)e * 512u + (unsigned)pn * 256u) * 1024u; }
        else    { u.A = A + (unsigned)row0 * 256u; u.B = B + ((unsigned)e * 1024u + (unsigned)pn * 256u) * 256u; }
        u.pm = row0; u.pn = pn; u.x0 = e; u.x1 = nrows; return true;
    }
    __device__ __forceinline__ void fetch(const Unit& u, int buf, LAS unsigned char* lds, int wid, int lane) const {
        if (UP) { if (wid < 4) __builtin_amdgcn_global_load_lds((const unsigned*)(stok + u.pm + wid * 64 + lane), (LAS unsigned*)(lds + IDX_OFF + buf * 1024 + wid * 256), 4, 0, 0); }
    }
    __device__ __forceinline__ unsigned goff(int nrows, int buf, LAS unsigned char* lds, int row, int C) const {
        const int r = row < nrows ? row : nrows - 1;
        if (UP) { const int tok = *(const LAS int*)(lds + IDX_OFF + buf * 1024 + r * 4); return (unsigned)tok * 1024u + (unsigned)C * 2u; }
        return (unsigned)r * 256u + (unsigned)C * 2u;
    }
};

__device__ __forceinline__ u32x4 pack8(const f32x4& a, const f32x4& b) { u32x4 w; w.x = cvt_pk_bf16(a[0], a[1]); w.y = cvt_pk_bf16(a[2], a[3]); w.z = cvt_pk_bf16(b[0], b[1]); w.w = cvt_pk_bf16(b[2], b[3]); return w; }
__device__ __forceinline__ void unpack8(const u32x4& w, f32x4& a, f32x4& b) { a = (f32x4){bflo(w.x), bfhi(w.x), bflo(w.y), bfhi(w.y)}; b = (f32x4){bflo(w.z), bfhi(w.z), bflo(w.w), bfhi(w.w)}; }

struct EpiInProj {
    static constexpr int NSTORE = 8; static constexpr int MIDK = 0;
    bf16_t *saug, *q, *k, *v, *gs, *ga; const float *rope, *qg, *kg;
    __device__ __forceinline__ void operator()(const Acc& acc, const Unit& u, int wr, int wc, int fr, int fq) const {
        const int pn = u.pn; const bool ctx = u.x0 != 0;
        if (pn < 4) {
            const int g = (pn * 256 + wc * 64 + fq * 16) >> 4;
#pragma unroll
            for (int ai = 0; ai < 2; ++ai)
#pragma unroll
                for (int m = 0; m < 4; ++m) {
                    const int r = u.pm * 256 + ai * 128 + wr * 64 + m * 16 + fr;
                    int b, l; if (!ctx) { b = r >> 11; l = r & 2047; } else { b = r >> 8; l = r & 255; }
                    const int grow = ctx ? 2048 + b * 8 + (l >> 5) : b * 64 + (l >> 5), t = l & 31; u32x4 w;
#pragma unroll
                    for (int bj = 0; bj < 2; ++bj)
#pragma unroll
                        for (int n = 0; n < 2; ++n) { const f32x4 x = acc[ai][bj][m][n]; int p = __builtin_amdgcn_cvt_pk_fp8_f32(x[0], x[1], 0, false); p = __builtin_amdgcn_cvt_pk_fp8_f32(x[2], x[3], p, true); w[bj * 2 + n] = (unsigned)p; }
                    *(u32x4*)((unsigned char*)saug + ((size_t)(g * ROWS_G + grow) * KAUG + t * 16)) = w;
                }
        } else if (pn < 9) {
            const bool isq = pn < 8; const float* gv = isq ? qg : kg;
            f32x4 g4[2][2];
#pragma unroll
            for (int bj = 0; bj < 2; ++bj)
#pragma unroll
                for (int n = 0; n < 2; ++n) g4[bj][n] = *(const f32x4*)(gv + bj * 32 + n * 16 + fq * 4);
            const float osc = isq ? 1.4426950408889634f : 1.f;
            f32x4 invf;
#pragma unroll
            for (int j = 0; j < 4; ++j) invf[j] = __builtin_amdgcn_exp2f(-0.8304820237218406f * (float)(fq * 4 + j)) * 0.15915494309189535f;
#pragma unroll
            for (int ai = 0; ai < 2; ++ai)
#pragma unroll
                for (int m = 0; m < 4; ++m) {
                    const int r = u.pm * 256 + ai * 128 + wr * 64 + m * 16 + fr;
                    int b, l; if (!ctx) { b = r >> 11; l = r & 2047; } else { b = r >> 8; l = r & 255; }
                    float ss = 0.f;
#pragma unroll
                    for (int bj = 0; bj < 2; ++bj)
#pragma unroll
                        for (int n = 0; n < 2; ++n) { const f32x4 x = acc[ai][bj][m][n]; ss += (x[0] * x[0] + x[1] * x[1]) + (x[2] * x[2] + x[3] * x[3]); }
                    ss += __shfl_xor(ss, 16); ss += __shfl_xor(ss, 32);
                    const float rstd = 1.0f / sqrtf(ss * (1.0f / 64.0f) + 1e-6f) * osc;
                    const int tt = l & 255, kslot = (l & ~255) + 64 * ((tt >> 5) & 3) + 32 * ((tt >> 2) & 1) + 16 * (tt >> 7) + 8 * ((tt >> 4) & 1) + 4 * ((tt >> 3) & 1) + (tt & 3);
                    unsigned char* dst = isq ? (unsigned char*)q + ((size_t)r * 1024 + (4 * (pn - 4) + wc) * 64 + fq * 16)
                                             : (unsigned char*)k + ((size_t)(b * 4 + wc) * (SKV * 64) + (size_t)((ctx ? kslot : CTX + kslot) >> 6) * 4096 + fq * 1024 + ((ctx ? kslot : CTX + kslot) & 63) * 16);
                    u32x4 w8;
#pragma unroll
                    for (int bj = 0; bj < 2; ++bj) {
                        f32x4 a = acc[ai][bj][m][0] * g4[bj][0] * rstd, bb = acc[ai][bj][m][1] * g4[bj][1] * rstd;
                        if (!ctx) {
                            const float pos = (float)(bj == 0 ? (l >> 6) : (l & 63)); f32x4 cs, sn;
#pragma unroll
                            for (int j = 0; j < 4; ++j) { const float rev = pos * invf[j]; cs[j] = __builtin_amdgcn_cosf(rev); sn[j] = __builtin_amdgcn_sinf(rev); }
                            const f32x4 o1 = a * cs - bb * sn, o2 = a * sn + bb * cs; a = o1; bb = o2;
                        }
                        int p0 = __builtin_amdgcn_cvt_pk_fp8_f32(a[0], a[1], 0, false); p0 = __builtin_amdgcn_cvt_pk_fp8_f32(a[2], a[3], p0, true);
                        int p1 = __builtin_amdgcn_cvt_pk_fp8_f32(bb[0], bb[1], 0, false); p1 = __builtin_amdgcn_cvt_pk_fp8_f32(bb[2], bb[3], p1, true);
                        w8[bj * 2] = (unsigned)p0; w8[bj * 2 + 1] = (unsigned)p1;
                    }
                    *(u32x4*)dst = w8;
                }
        } else if (pn == 9) {
            const int r0 = u.pm * 256; int b, kb; if (!ctx) { b = r0 >> 11; kb = CTX + (r0 & 2047); } else { b = u.pm; kb = 0; }
            unsigned char* base = (unsigned char*)v + (size_t)b * 4 * (SKV * 64) + (size_t)((kb >> 6) + wc) * 4096 + fq * 1024;
#pragma unroll
            for (int ai = 0; ai < 2; ++ai)
#pragma unroll
                for (int m = 0; m < 4; ++m) {
                    const int d = ai * 128 + wr * 64 + m * 16 + fr; u32x4 w;
#pragma unroll
                    for (int bj = 0; bj < 2; ++bj)
#pragma unroll
                        for (int n = 0; n < 2; ++n) { const f32x4 x = acc[ai][bj][m][n]; int p = __builtin_amdgcn_cvt_pk_fp8_f32(x[0], x[1], 0, false); p = __builtin_amdgcn_cvt_pk_fp8_f32(x[2], x[3], p, true); w[bj * 2 + n] = (unsigned)p; }
                    *(u32x4*)(base + (size_t)(d >> 6) * (SKV * 64) + (d & 63) * 16) = w;
                }
        } else {
            unsigned char* base = (unsigned char*)(pn < 14 ? gs : ga) + (pn < 14 ? pn - 10 : pn - 14) * 256 + wc * 64 + fq * 16;
#pragma unroll
            for (int ai = 0; ai < 2; ++ai)
#pragma unroll
                for (int m = 0; m < 4; ++m) {
                    const int r = u.pm * 256 + ai * 128 + wr * 64 + m * 16 + fr; u32x4 w;
#pragma unroll
                    for (int bj = 0; bj < 2; ++bj)
#pragma unroll
                        for (int n = 0; n < 2; ++n) { f32x4 a = acc[ai][bj][m][n];
#pragma unroll
                            for (int j = 0; j < 4; ++j) a[j] = sigmoidf_(a[j]);
                            int p = __builtin_amdgcn_cvt_pk_fp8_f32(a[0], a[1], 0, false); p = __builtin_amdgcn_cvt_pk_fp8_f32(a[2], a[3], p, true); w[bj * 2 + n] = (unsigned)p; }
                    *(u32x4*)(base + (size_t)r * 1024) = w;
                }
        }
    }
};
struct EpiF32 {
    static constexpr int NSTORE = 32; static constexpr int MIDK = 0;
    float* C; int ldc; size_t grp;
    __device__ __forceinline__ void operator()(const Acc& acc, const Unit& u, int wr, int wc, int fr, int fq) const {
        float* base = C + (size_t)u.x0 * grp + (size_t)(u.pm * 256 + wr * 64 + fr) * ldc + u.pn * 256 + wc * 32 + fq * 8;
#pragma unroll
        for (int ai = 0; ai < 2; ++ai)
#pragma unroll
            for (int m = 0; m < 4; ++m)
#pragma unroll
                for (int bj = 0; bj < 2; ++bj) { float* p = base + (size_t)(ai * 128 + m * 16) * ldc + bj * 128; *(f32x4*)p = acc[ai][bj][m][0]; *(f32x4*)(p + 4) = acc[ai][bj][m][1]; }
    }
};
template <int ACT> struct EpiBf16 {
    static constexpr int NSTORE = 16; static constexpr int MIDK = 0;
    bf16_t* O; int ldc; size_t grp;
    __device__ __forceinline__ void operator()(const Acc& acc, const Unit& u, int wr, int wc, int fr, int fq) const {
        bf16_t* base = O + (size_t)u.x0 * grp + (size_t)(u.pm * 256 + wr * 64 + fr) * ldc + u.pn * 256 + wc * 32 + fq * 8;
#pragma unroll
        for (int ai = 0; ai < 2; ++ai)
#pragma unroll
            for (int m = 0; m < 4; ++m)
#pragma unroll
                for (int bj = 0; bj < 2; ++bj) { f32x4 a = acc[ai][bj][m][0], b = acc[ai][bj][m][1];
                    if (ACT == 1) {
#pragma unroll
                        for (int j = 0; j < 4; ++j) { a[j] = gelu_tanh(a[j]); b[j] = gelu_tanh(b[j]); } }
                    *(u32x4*)(base + (size_t)(ai * 128 + m * 16) * ldc + bj * 128) = pack8(a, b); }
    }
};
template <int MODE> struct EpiGate {
    static constexpr int NSTORE = 16; static constexpr int MIDK = 0;
    const bf16_t* G; bf16_t* O;
    __device__ __forceinline__ void operator()(const Acc& acc, const Unit& u, int wr, int wc, int fr, int fq) const {
#pragma unroll
        for (int ai = 0; ai < 2; ++ai) {
            u32x4 gw[4][2], pw[4][2];
#pragma unroll
            for (int m = 0; m < 4; ++m) { const int r = u.pm * 256 + ai * 128 + wr * 64 + m * 16 + fr;
#pragma unroll
                for (int bj = 0; bj < 2; ++bj) { const int col = u.pn * 256 + bj * 128 + wc * 32 + fq * 8;
                    gw[m][bj] = MODE == 0 ? *(const u32x4*)(G + ((size_t)(col >> 4) * T + r) * 16 + (col & 15)) : *(const u32x4*)(G + (size_t)r * 1024 + col);
                    if (MODE == 2) pw[m][bj] = *(const u32x4*)(O + (size_t)r * 1024 + col); } }
#pragma unroll
            for (int m = 0; m < 4; ++m) { const int r = u.pm * 256 + ai * 128 + wr * 64 + m * 16 + fr;
#pragma unroll
                for (int bj = 0; bj < 2; ++bj) { const int col = u.pn * 256 + bj * 128 + wc * 32 + fq * 8;
                    f32x4 a = acc[ai][bj][m][0], b = acc[ai][bj][m][1], ga, gb; unpack8(gw[m][bj], ga, gb);
                    if (MODE == 0) {
#pragma unroll
                        for (int j = 0; j < 4; ++j) { a[j] = ga[j] * sigmoidf_(a[j]); b[j] = gb[j] * sigmoidf_(b[j]); } }
                    else { a = a * ga; b = b * gb; if (MODE == 2) { f32x4 pa, pb; unpack8(pw[m][bj], pa, pb); a = a + pa; b = b + pb; } }
                    *(u32x4*)(O + (size_t)r * 1024 + col) = pack8(a, b); } }
        }
    }
};
__device__ __forceinline__ unsigned pk4f8(const f32x4& x) { int p = __builtin_amdgcn_cvt_pk_fp8_f32(x[0], x[1], 0, false); p = __builtin_amdgcn_cvt_pk_fp8_f32(x[2], x[3], p, true); return (unsigned)p; }
__device__ __forceinline__ f32x4 up4f8(unsigned w) { const f32x2 a = __builtin_amdgcn_cvt_pk_f32_fp8((int)w, false), b = __builtin_amdgcn_cvt_pk_f32_fp8((int)w, true); return (f32x4){a[0], a[1], b[0], b[1]}; }
struct EpiZ8 {
    static constexpr int NSTORE = 8; static constexpr int MIDK = 0;
    unsigned char* O; size_t grp;
    __device__ __forceinline__ void operator()(const Acc& acc, const Unit& u, int wr, int wc, int fr, int fq) const {
        unsigned char* base = O + (size_t)u.x0 * grp + (size_t)(u.pm * 256 + wr * 64 + fr) * NS5 + u.pn * 256 + wc * 64 + fq * 16;
#pragma unroll
        for (int ai = 0; ai < 2; ++ai)
#pragma unroll
            for (int m = 0; m < 4; ++m) { u32x4 w;
#pragma unroll
                for (int bj = 0; bj < 2; ++bj)
#pragma unroll
                    for (int n = 0; n < 2; ++n) { f32x4 x = acc[ai][bj][m][n];
#pragma unroll
                        for (int j = 0; j < 4; ++j) x[j] = gelu_tanh(x[j]);
                        w[bj * 2 + n] = pk4f8(x); }
                *(u32x4*)(base + (size_t)(ai * 128 + m * 16) * NS5) = w; }
    }
};
template <int MODE> struct EpiGate8 {
    static constexpr int NSTORE = 8; static constexpr int MIDK = 0;
    const unsigned char* G; const unsigned char* P; unsigned char* O; int ldo;
    __device__ __forceinline__ void operator()(const Acc& acc, const Unit& u, int wr, int wc, int fr, int fq) const {
        const int col = u.pn * 256 + wc * 64 + fq * 16;
#pragma unroll
        for (int ai = 0; ai < 2; ++ai) {
            u32x4 gw[4], pw[4];
#pragma unroll
            for (int m = 0; m < 4; ++m) { const int r = u.pm * 256 + ai * 128 + wr * 64 + m * 16 + fr;
                gw[m] = MODE == 0 ? *(const u32x4*)(G + ((size_t)(col >> 4) * T + r) * 16) : *(const u32x4*)(G + (size_t)r * 1024 + col);
                if (MODE == 2) pw[m] = *(const u32x4*)(P + (size_t)r * 1024 + col); }
#pragma unroll
            for (int m = 0; m < 4; ++m) { const int r = u.pm * 256 + ai * 128 + wr * 64 + m * 16 + fr; u32x4 w8;
#pragma unroll
                for (int bj = 0; bj < 2; ++bj)
#pragma unroll
                    for (int n = 0; n < 2; ++n) { f32x4 a = acc[ai][bj][m][n]; const f32x4 g = up4f8(gw[m][bj * 2 + n]);
                        if (MODE == 0) {
#pragma unroll
                            for (int j = 0; j < 4; ++j) a[j] = g[j] * sigmoidf_(a[j]); }
                        else { a = a * g; if (MODE == 2) a = a + up4f8(pw[m][bj * 2 + n]); }
                        w8[bj * 2 + n] = pk4f8(a); }
                *(u32x4*)(O + (size_t)r * ldo + col) = w8; }
        }
    }
};
struct EpiMerge8 {
    static constexpr int NSTORE = 8; static constexpr int MIDK = 8;
    const unsigned char* GS; const unsigned char* GA; unsigned char* O;
    __device__ __forceinline__ static f32x4 gate4(unsigned w) { f32x4 g = up4f8(w);
#pragma unroll
        for (int j = 0; j < 4; ++j) g[j] = fmaxf(g[j], 0.001953125f); return g; }
    __device__ __forceinline__ void mid(Acc& acc, const Unit& u, int wr, int wc, int fr, int fq) const {
        const int col = u.pn * 256 + wc * 64 + fq * 16;
#pragma unroll
        for (int ai = 0; ai < 2; ++ai) {
            u32x4 sw[4], aw[4];
#pragma unroll
            for (int m = 0; m < 4; ++m) { const size_t o = (size_t)(u.pm * 256 + ai * 128 + wr * 64 + m * 16 + fr) * 1024 + col; sw[m] = *(const u32x4*)(GS + o); aw[m] = *(const u32x4*)(GA + o); }
#pragma unroll
            for (int m = 0; m < 4; ++m)
#pragma unroll
                for (int bj = 0; bj < 2; ++bj)
#pragma unroll
                    for (int n = 0; n < 2; ++n) { const f32x4 gs = up4f8(sw[m][bj * 2 + n]), ga = gate4(aw[m][bj * 2 + n]); f32x4 rho;
#pragma unroll
                        for (int j = 0; j < 4; ++j) rho[j] = gs[j] * __builtin_amdgcn_rcpf(ga[j]);
                        acc[ai][bj][m][n] = acc[ai][bj][m][n] * rho; }
        }
    }
    __device__ __forceinline__ void operator()(const Acc& acc, const Unit& u, int wr, int wc, int fr, int fq) const {
        const int col = u.pn * 256 + wc * 64 + fq * 16;
#pragma unroll
        for (int ai = 0; ai < 2; ++ai) {
            u32x4 aw[4];
#pragma unroll
            for (int m = 0; m < 4; ++m) aw[m] = *(const u32x4*)(GA + (size_t)(u.pm * 256 + ai * 128 + wr * 64 + m * 16 + fr) * 1024 + col);
#pragma unroll
            for (int m = 0; m < 4; ++m) { u32x4 w8;
#pragma unroll
                for (int bj = 0; bj < 2; ++bj)
#pragma unroll
                    for (int n = 0; n < 2; ++n) w8[bj * 2 + n] = pk4f8(acc[ai][bj][m][n] * gate4(aw[m][bj * 2 + n]));
                *(u32x4*)(O + (size_t)(u.pm * 256 + ai * 128 + wr * 64 + m * 16 + fr) * 1024 + col) = w8; }
        }
    }
};
struct EpiOut16 {
    static constexpr int NSTORE = 16; static constexpr int MIDK = 0;
    const float* x; const float* mod; bf16_t* O;
    __device__ __forceinline__ void operator()(const Acc& acc, const Unit& u, int wr, int wc, int fr, int fq) const {
        const int col = u.pn * 256 + wc * 64 + fq * 16;
        const float* g1 = mod + (size_t)((u.pm * 256) >> 11) * 6144 + 2048 + col;
        f32x4 gv[4];
#pragma unroll
        for (int q = 0; q < 4; ++q) gv[q] = *(const f32x4*)(g1 + q * 4);
#pragma unroll
        for (int ai = 0; ai < 2; ++ai) {
            f32x4 xv[4][4];
#pragma unroll
            for (int m = 0; m < 4; ++m) { const float* xr = x + (size_t)(u.pm * 256 + ai * 128 + wr * 64 + m * 16 + fr) * 1024 + col;
#pragma unroll
                for (int q = 0; q < 4; ++q) xv[m][q] = *(const f32x4*)(xr + q * 4); }
#pragma unroll
            for (int m = 0; m < 4; ++m) { bf16_t* orow = O + (size_t)(u.pm * 256 + ai * 128 + wr * 64 + m * 16 + fr) * 1024 + col;
#pragma unroll
                for (int bj = 0; bj < 2; ++bj) *(u32x4*)(orow + bj * 8) = pack8(xv[m][bj * 2] * ALPHA + gv[bj * 2] * acc[ai][bj][m][0], xv[m][bj * 2 + 1] * ALPHA + gv[bj * 2 + 1] * acc[ai][bj][m][1]); }
        }
    }
};
struct EpiOut {
    static constexpr int NSTORE = 16; static constexpr int MIDK = 0;
    const float* x; const float* mod; bf16_t* O;
    __device__ __forceinline__ void operator()(const Acc& acc, const Unit& u, int wr, int wc, int fr, int fq) const {
        const float* g1 = mod + (size_t)((u.pm * 256) >> 11) * 6144 + 2048 + u.pn * 256 + wc * 32 + fq * 8;
        f32x4 gv[2][2];
#pragma unroll
        for (int bj = 0; bj < 2; ++bj) { gv[bj][0] = *(const f32x4*)(g1 + bj * 128); gv[bj][1] = *(const f32x4*)(g1 + bj * 128 + 4); }
#pragma unroll
        for (int ai = 0; ai < 2; ++ai) {
            f32x4 xv[4][2][2];
#pragma unroll
            for (int m = 0; m < 4; ++m) { const float* xr = x + (size_t)(u.pm * 256 + ai * 128 + wr * 64 + m * 16 + fr) * 1024 + u.pn * 256 + wc * 32 + fq * 8;
#pragma unroll
                for (int bj = 0; bj < 2; ++bj) { xv[m][bj][0] = *(const f32x4*)(xr + bj * 128); xv[m][bj][1] = *(const f32x4*)(xr + bj * 128 + 4); } }
#pragma unroll
            for (int m = 0; m < 4; ++m) { bf16_t* orow = O + (size_t)(u.pm * 256 + ai * 128 + wr * 64 + m * 16 + fr) * 1024 + u.pn * 256 + wc * 32 + fq * 8;
#pragma unroll
                for (int bj = 0; bj < 2; ++bj) *(u32x4*)(orow + bj * 128) = pack8(xv[m][bj][0] * ALPHA + gv[bj][0] * acc[ai][bj][m][0], xv[m][bj][1] * ALPHA + gv[bj][1] * acc[ai][bj][m][1]); }
        }
    }
};
template <bool UP> struct EpiMoe {
    static constexpr int NSTORE = 0; static constexpr int MIDK = 0;
    void* O;
    __device__ __forceinline__ void operator()(const Acc& acc, const Unit& u, int wr, int wc, int fr, int fq) const {
#pragma unroll
        for (int ai = 0; ai < 2; ++ai)
#pragma unroll
            for (int m = 0; m < 4; ++m) {
                const int r = ai * 128 + wr * 64 + m * 16 + fr;
                if (r < u.x1) {
                    if (UP) { f32x4 a = acc[ai][0][m][0], b = acc[ai][0][m][1];
#pragma unroll
                        for (int j = 0; j < 4; ++j) { a[j] = silu_(a[j]) * acc[ai][1][m][0][j]; b[j] = silu_(b[j]) * acc[ai][1][m][1][j]; }
                        u32x2 w; w.x = pk4f8(a); w.y = pk4f8(b);
                        *(u32x2*)((unsigned char*)O + (size_t)(u.pm + r) * 256 + u.pn * 128 + wc * 32 + fq * 8) = w;
                    } else { u32x4 w;
#pragma unroll
                        for (int bj = 0; bj < 2; ++bj)
#pragma unroll
                            for (int n = 0; n < 2; ++n) { const f32x4 x = acc[ai][bj][m][n] * YSCALE; int p = __builtin_amdgcn_cvt_pk_fp8_f32(x[0], x[1], 0, false); p = __builtin_amdgcn_cvt_pk_fp8_f32(x[2], x[3], p, true); w[bj * 2 + n] = (unsigned)p; }
                        *(u32x4*)((unsigned char*)O + (size_t)(u.pm + r) * 1024 + u.pn * 256 + wc * 64 + fq * 16) = w;
                    }
                }
            }
    }
};
struct EpiNull { static constexpr int NSTORE = 0; static constexpr int MIDK = 0; float* sink;
    __device__ __forceinline__ void operator()(const Acc& acc, const Unit& u, int, int, int, int) const { f32x4 s = (f32x4){0.f, 0.f, 0.f, 0.f};
#pragma unroll
        for (int a = 0; a < 2; ++a)
#pragma unroll
            for (int b = 0; b < 2; ++b)
#pragma unroll
                for (int m = 0; m < 4; ++m)
#pragma unroll
                    for (int n = 0; n < 2; ++n) s += acc[a][b][m][n];
        const float t = (s[0] + s[1]) + (s[2] + s[3]); if (t == 12345.678f) sink[threadIdx.x] = t; } };
}
#include <hip/hip_bf16.h>
#include <cmath>
namespace attn_body {
using bf16=__hip_bfloat16;
using bf16x8=__attribute__((ext_vector_type(8)))short;
using s16x4=__attribute__((ext_vector_type(4)))short;
using f32x16=__attribute__((ext_vector_type(16)))float;
using u32x4=__attribute__((ext_vector_type(4)))unsigned;
typedef int v8i32_t __attribute__((ext_vector_type(8))); typedef int v4i32_t __attribute__((ext_vector_type(4)));
constexpr int NHEAD=16,SEQ=2048,SKVA=2304,D=64,DM=NHEAD*D,DKV=256;
constexpr int NW=8,QBLK=32,QB=QBLK*NW,KVBLK=64,NQB=SEQ/QB;
constexpr int ATTN_PITCH=DM, ATTN_UNIT_ROWS=QB, DMO=2048;
__device__ __forceinline__ int crow(int r,int hi){return (r&3)+8*(r>>2)+4*hi;}
#define SBAR() __builtin_amdgcn_sched_barrier(0)
__device__ __forceinline__ void cmask(f32x16&p0,f32x16&p1,int jb,int qrel,int hi){
  const float NEG=-INFINITY; int kb=64*jb+4*hi;
  #pragma unroll
  for(int r=0;r<16;++r){int kv=kb+(r&3)+8*(r>>2); if(kv>qrel)p0[r]=NEG; if(kv+32>qrel)p1[r]=NEG;}
}

constexpr int NSLOT=5, SLOTB=4096;
constexpr int LDS_K=0, LDS_V=NSLOT*SLOTB, LDS_WS=2*NSLOT*SLOTB, LDS_OST=LDS_WS+NW*64*4, LDS_BYTES=LDS_OST+NW*4096;
constexpr float C2=0.125f*1.4426950408889634f;
__device__ __forceinline__ void glds16(const void*gsrc,unsigned lds_dst){unsigned keep;
  asm volatile("s_mov_b32 %0, m0\n\ts_mov_b32 m0, %2\n\ts_nop 0\n\tglobal_load_lds_dwordx4 %1, off\n\ts_mov_b32 m0, %0":"=&s"(keep):"v"(gsrc),"s"(lds_dst):"memory");}
__device__ __forceinline__ float max3f(float a,float b,float c){float r;asm("v_max3_f32 %0, %1, %2, %3":"=v"(r):"v"(a),"v"(b),"v"(c));return r;}
__device__ __forceinline__ float max2f(float a,float b){float r;asm("v_max_f32_e32 %0, %1, %2":"=v"(r):"v"(a),"v"(b));return r;}
__device__ __forceinline__ float fadd_s(float a,float b){float r;asm("v_add_f32_e32 %0, %1, %2":"=v"(r):"v"(a),"v"(b));return r;}
__device__ __forceinline__ float fsub_s(float a,float b){float r;asm("v_sub_f32_e32 %0, %1, %2":"=v"(r):"v"(a),"v"(b));return r;}
typedef float f32x2_t __attribute__((ext_vector_type(2))); typedef __bf16 bf16x2_t __attribute__((ext_vector_type(2)));
__device__ __forceinline__ unsigned cvtpk_s(float lo,float hi){f32x2_t v={lo,hi};bf16x2_t b=__builtin_convertvector(v,bf16x2_t);return __builtin_bit_cast(unsigned,b);}
#define WAIT_BAR(N) asm volatile("s_waitcnt vmcnt(" #N ") lgkmcnt(0)\n\ts_barrier":::"memory")

__device__ __forceinline__ void qkt(f32x16&p0,f32x16&p1,const char*Kslot,const bf16x8*qr,const f32x16&negm,int r32,int hi){
  const char*kb=Kslot+hi*1024+r32*16;
  #pragma unroll
  for(int d0=0;d0<4;++d0){
    const bf16x8 b0=*reinterpret_cast<const bf16x8*>(kb+d0*2048);
    const bf16x8 b1=*reinterpret_cast<const bf16x8*>(kb+d0*2048+512);
    if(d0==0){p0=__builtin_amdgcn_mfma_f32_32x32x16_bf16(b0,qr[0],negm,0,0,0);p1=__builtin_amdgcn_mfma_f32_32x32x16_bf16(b1,qr[0],negm,0,0,0);}
    else{p0=__builtin_amdgcn_mfma_f32_32x32x16_bf16(b0,qr[d0],p0,0,0,0);p1=__builtin_amdgcn_mfma_f32_32x32x16_bf16(b1,qr[d0],p1,0,0,0);}}
}
typedef __attribute__((address_space(3))) const char* lds_cptr;
typedef short v4i16_t __attribute__((ext_vector_type(4)));
__device__ __forceinline__ void kload8(bf16x8*kf,lds_cptr kp){
  kf[0]=*(const __attribute__((address_space(3))) bf16x8*)(kp);      kf[1]=*(const __attribute__((address_space(3))) bf16x8*)(kp+512);
  kf[2]=*(const __attribute__((address_space(3))) bf16x8*)(kp+2048); kf[3]=*(const __attribute__((address_space(3))) bf16x8*)(kp+2560);
  kf[4]=*(const __attribute__((address_space(3))) bf16x8*)(kp+4096); kf[5]=*(const __attribute__((address_space(3))) bf16x8*)(kp+4608);
  kf[6]=*(const __attribute__((address_space(3))) bf16x8*)(kp+6144); kf[7]=*(const __attribute__((address_space(3))) bf16x8*)(kp+6656);
}
__device__ __forceinline__ void kload2(bf16x8*kf,lds_cptr kp,int j){ kf[2*j]=*(const __attribute__((address_space(3))) bf16x8*)(kp+j*2048); kf[2*j+1]=*(const __attribute__((address_space(3))) bf16x8*)(kp+j*2048+512); }
__device__ __forceinline__ void kload8f(v8i32_t*kf,lds_cptr kp,int mb){ kf[mb].lo=*(const __attribute__((address_space(3))) v4i32_t*)(kp+mb*512); kf[mb].hi=*(const __attribute__((address_space(3))) v4i32_t*)(kp+mb*512+1024); }
__device__ __forceinline__ f32x16 qk8(v8i32_t k,v8i32_t q,const f32x16&c){ return __builtin_amdgcn_mfma_scale_f32_32x32x64_f8f6f4(k,q,c,0,0,0,0x7c,0,0x7f); }
__device__ __forceinline__ s16x4 vtr(lds_cptr p){ return __builtin_bit_cast(s16x4,__builtin_amdgcn_ds_read_tr16_b64_v4i16((__attribute__((address_space(3))) v4i16_t*)p)); }
__device__ __forceinline__ float rowmax(const f32x16&p0,const f32x16&p1){
  float a=max3f(p0[0],p0[1],p1[0]),b=max3f(p0[2],p0[3],p1[1]);a=max3f(a,p1[2],p1[3]);
  #pragma unroll
  for(int r=4;r<16;r+=4){a=max3f(a,p0[r],p0[r+1]);b=max3f(b,p0[r+2],p0[r+3]);a=max3f(a,p1[r],p1[r+1]);b=max3f(b,p1[r+2],p1[r+3]);}
  const float m=max2f(a,b);
  auto rr=__builtin_amdgcn_permlane32_swap(__float_as_uint(m),__float_as_uint(m),false,false);
  return max2f(__uint_as_float(rr[0]),__uint_as_float(rr[1]));
}
__device__ __forceinline__ void pv(f32x16*o,int vb,bf16x8 pa0,bf16x8 pa1,bf16x8 pa2,bf16x8 pa3){
  #pragma unroll
  for(int d0=0;d0<2;++d0){s16x4 lo[4],hi[4];
    #pragma unroll
    for(int ks=0;ks<4;++ks){
      asm volatile("ds_read_b64_tr_b16 %0,%1 offset:%c2":"=&v"(lo[ks]):"v"(vb),"i"(d0*4096+ks*1024):"memory");
      asm volatile("ds_read_b64_tr_b16 %0,%1 offset:%c2":"=&v"(hi[ks]):"v"(vb),"i"(d0*4096+ks*1024+512):"memory");}
    asm volatile("s_waitcnt lgkmcnt(0)":::"memory");SBAR();
    #define PK(k) (bf16x8){lo[k][0],lo[k][1],lo[k][2],lo[k][3],hi[k][0],hi[k][1],hi[k][2],hi[k][3]}
    o[d0]=__builtin_amdgcn_mfma_f32_32x32x16_bf16(pa0,PK(0),o[d0],0,0,0);
    o[d0]=__builtin_amdgcn_mfma_f32_32x32x16_bf16(pa1,PK(1),o[d0],0,0,0);
    o[d0]=__builtin_amdgcn_mfma_f32_32x32x16_bf16(pa2,PK(2),o[d0],0,0,0);
    o[d0]=__builtin_amdgcn_mfma_f32_32x32x16_bf16(pa3,PK(3),o[d0],0,0,0);
    #undef PK
  }
}

#ifndef ATTN_STORE16
#define ATTN_STORE16(p,v) (*(u32x4*)(p)=(v))
#endif
template<int THRL> __device__ __forceinline__ void attn_unit(int b,int h,int qb,const bf16*Q,const bf16*__restrict__ K,const bf16*__restrict__ V,bf16*O,char*shm){
  int tid_=threadIdx.x; asm volatile("":"+v"(tid_)); const int tid=tid_,lane=tid&63,r32=lane&31,hi=lane>>5; const int wid=__builtin_amdgcn_readfirstlane(tid>>6);
  const long rowbase=(long)b*SEQ; const long kvbase=(long)b*SKVA; const int q0=qb*QB;
  const unsigned char*Qw=(const unsigned char*)Q+(rowbase+q0+wid*QBLK)*DM+h*D;
  const unsigned char*Kh=(const unsigned char*)K+((long)b*4+(h>>2))*(long)(SKVA*D);
  const unsigned char*Vh=(const unsigned char*)V+((long)b*4+(h>>2))*(long)(SKVA*D);
  const unsigned lds0=(unsigned)(uintptr_t)shm;
  const bool kw=wid<4;
  const unsigned char*ksrc=Kh+(wid&3)*1024+lane*16;
  const unsigned char*vsrc=Vh+(wid&3)*1024+lane*16;
  const unsigned kdst=lds0+LDS_K+(wid&3)*1024, vdst=lds0+LDS_V+(wid&3)*1024;
  #define DMA_K(t,slot) do{ if(kw) glds16(ksrc+(long)(t)*4096,(unsigned)__builtin_amdgcn_readfirstlane(kdst+(slot))); }while(0)
  #define DMA_V(t,slot) do{ if(!kw) glds16(vsrc+(long)(t)*4096,(unsigned)__builtin_amdgcn_readfirstlane(vdst+(slot))); }while(0)
  const unsigned char*rsrc=kw?ksrc+5l*4096:vsrc+3l*4096; const long rstep=4096; const unsigned rdst=kw?kdst:vdst;
  #define DMA_R(t) glds16(rsrc+(long)(t)*rstep,(unsigned)__builtin_amdgcn_readfirstlane(rdst+(kw?sl_cur:sl_m2)))
  v8i32_t kf[2],vf[2];
  const lds_cptr shm3=(lds_cptr)shm; const lds_cptr kp0=shm3+LDS_K+hi*2048+r32*16; const lds_cptr vp0=shm3+LDS_V+hi*2048+r32*16;
  const int NT=SKVA/KVBLK;
  DMA_K(0,0);DMA_V(0,0);
  const v8i32_t qr=*reinterpret_cast<const v8i32_t*>(Qw+(long)r32*DM+hi*32);
  int scl1=0x7f7f7f7f, sclq=0x7c7c7c7c; asm volatile("":"+v"(scl1),"+v"(sclq));
  #define QKA(C,k) asm volatile("v_mfma_scale_f32_32x32x64_f8f6f4 %0, %1, %2, %3, %4, %5 op_sel_hi:[0,0,0]":"=&v"(C):"v"(kf[k]),"v"(qr),"v"(negm),"v"(sclq),"v"(scl1))
  f32x16 o[2];o[0]=f32x16{};o[1]=f32x16{}; f32x16 lacc=f32x16{};
  v8i32_t ones; _Pragma("unroll") for(int r=0;r<8;++r)ones[r]=0x38383838; asm volatile("":"+v"(ones));
  f32x16 negm; _Pragma("unroll") for(int r=0;r<16;++r)negm[r]=-4.0f; asm volatile("":"+v"(negm));
  f32x16 pA0,pA1,pB0,pB1;
  int sl_m2=3*SLOTB,sl_prev=4*SLOTB,sl_cur=0,sl_next=SLOTB;
  #define ROT() do{sl_m2=sl_prev;sl_prev=sl_cur;sl_cur=sl_next;sl_next=(sl_next==(NSLOT-1)*SLOTB)?0:sl_next+SLOTB;}while(0)
  DMA_K(1,SLOTB);DMA_K(2,2*SLOTB);DMA_K(3,3*SLOTB);DMA_K(4,4*SLOTB);DMA_V(1,SLOTB);DMA_V(2,2*SLOTB);
  WAIT_BAR(4);
  #define EX(v) __builtin_amdgcn_exp2f(v)
  kload8f(kf,kp0,0);kload8f(kf,kp0,1);QKA(pA0,0);QKA(pA1,1);asm volatile("s_nop 15\n\ts_nop 15\n\ts_nop 15\n\ts_nop 15\n\ts_nop 15\n\ts_nop 15\n\ts_nop 15\n\ts_nop 15\n\ts_nop 15\n\ts_nop 15":"+v"(pA0),"+v"(pA1));
  _Pragma("unroll") for(int r=0;r<16;++r)pA0[r]=EX(pA0[r]);
  _Pragma("unroll") for(int r=0;r<16;++r)pA1[r]=EX(pA1[r]);
  WAIT_BAR(2);
  DMA_K(5,0);DMA_V(3,3*SLOTB);
  ROT();
  kload8f(kf,kp0+sl_cur,0);kload8f(kf,kp0+sl_cur,1);
  WAIT_BAR(3);
  v8i32_t pw=v8i32_t{};
  #define PK8(I,P,B) do{ int p_=__builtin_amdgcn_cvt_pk_fp8_f32(P[B],P[B+1],pw[I],false); pw[I]=__builtin_amdgcn_cvt_pk_fp8_f32(P[B+2],P[B+3],p_,true); }while(0)
  #define PIN(x) asm volatile("":"+v"(x))
  #define GAPB(X,B) do{ X[B]=EX(X[B]); X[B+1]=EX(X[B+1]); X[B+2]=EX(X[B+2]); X[B+3]=EX(X[B+3]); PIN(X); SBAR(); }while(0)
  #define LSM() asm volatile("v_mfma_scale_f32_32x32x64_f8f6f4 %0, %1, %2, %0, %3, %3 op_sel_hi:[0,0,0]":"+v"(lacc):"v"(ones),"v"(pw),"v"(scl1))
  #define PVM(d) asm volatile("v_mfma_scale_f32_32x32x64_f8f6f4 %0, %1, %2, %0, %3, %3 op_sel_hi:[0,0,0]":"+v"(o[d]):"v"(vf[d]),"v"(pw),"v"(scl1))
  #define EX8(X,B) do{ if(!(THRL&64)){ _Pragma("unroll") for(int e_=0;e_<8;++e_) X[(B)+e_]=EX(X[(B)+e_]); } PIN(X); SBAR(); }while(0)
  #define STEP(C0,C1,P0,P1,t,GK,GV,GL) do{ SBAR(); \
    kload8f(vf,vp0+sl_prev,0); kload8f(vf,vp0+sl_prev,1); SBAR(); \
    if(!(THRL&32)){QKA(C0,0);} SBAR(); \
    if(!(THRL&128)){PK8(0,P0,0); PK8(1,P0,4); PK8(2,P0,8); PK8(3,P0,12); PK8(4,P1,0); PK8(5,P1,4); PK8(6,P1,8); PK8(7,P1,12);} PIN(pw); SBAR(); \
    if(!(THRL&32)){QKA(C1,1);} SBAR(); \
    if((GK)&&(GV)){DMA_R(t);} else { if(GK){DMA_K((t)+5,sl_cur);} if(GV){DMA_V((t)+3,sl_m2);} } \
    asm volatile("s_nop 7":::"memory"); SBAR(); \
    EX8(C0,0); \
    if(!(THRL&16)){PVM(0);} EX8(C0,8); \
    if(!(THRL&16)){PVM(1);} if(GL){ kload8f(kf,kp0+sl_next,0); kload8f(kf,kp0+sl_next,1); SBAR(); } EX8(C1,0); \
    if(!(THRL&16)){LSM();} EX8(C1,8); \
    }while(0)
  int t=1;
  for(;t+6<NT;t+=2){
    STEP(pB0,pB1,pA0,pA1,t,true,true,true);     WAIT_BAR(3); ROT();
    STEP(pA0,pA1,pB0,pB1,t+1,true,true,true);   WAIT_BAR(3); ROT();
  }
  #define ENDW(tt) do{ if((tt)+5<NT){WAIT_BAR(3);} else if((tt)+4<NT){WAIT_BAR(2);} else if((tt)+3<NT){WAIT_BAR(1);} else {WAIT_BAR(0);} }while(0)
  for(;t+1<NT;t+=2){
    STEP(pB0,pB1,pA0,pA1,t,(t+5<NT),(t+3<NT),(t+1<NT));       ENDW(t);   ROT();
    STEP(pA0,pA1,pB0,pB1,t+1,(t+6<NT),(t+4<NT),(t+2<NT));     ENDW(t+1); ROT();
  }
  STEP(pB0,pB1,pA0,pA1,NT-1,false,false,false);
  { PK8(0,pB0,0);PK8(1,pB0,4);PK8(2,pB0,8);PK8(3,pB0,12);PK8(4,pB1,0);PK8(5,pB1,4);PK8(6,pB1,8);PK8(7,pB1,12); PIN(pw);
    kload8f(vf,vp0+sl_cur,0); kload8f(vf,vp0+sl_cur,1); SBAR();
    asm volatile("s_nop 7":::"memory"); LSM(); PVM(0); PVM(1); asm volatile("s_nop 15\n\ts_nop 15\n\ts_nop 15\n\ts_nop 15\n\ts_nop 15\n\ts_nop 15\n\ts_nop 15\n\ts_nop 15\n\ts_nop 15\n\ts_nop 15\n\ts_nop 15\n\ts_nop 15\n\ts_nop 15\n\ts_nop 15":"+v"(o[0]),"+v"(o[1]),"+v"(lacc)); }
  #undef PK8
  #undef PIN
  #undef GAPA
  #undef GAPB
  #undef EX8
  #undef EX
  #undef PVM
  #undef QKA
  #undef LSM
  #undef STEP
  #undef ENDW
  const float rli=__builtin_amdgcn_rcpf(lacc[0]);
  unsigned char*Ow=(unsigned char*)O+(rowbase+q0+wid*QBLK)*DMO+h*D;
  { unsigned char*stg=(unsigned char*)(shm+LDS_OST)+wid*4096;
    #pragma unroll
    for(int db=0;db<2;++db)
      #pragma unroll
      for(int g=0;g<4;++g){ int p_=__builtin_amdgcn_cvt_pk_fp8_f32(o[db][4*g]*rli,o[db][4*g+1]*rli,0,false); p_=__builtin_amdgcn_cvt_pk_fp8_f32(o[db][4*g+2]*rli,o[db][4*g+3]*rli,p_,true);
        *(int*)(stg+r32*64+db*32+8*g+4*hi)=p_; }
    asm volatile("s_waitcnt lgkmcnt(0)":::"memory");
    #pragma unroll
    for(int i=0;i<2;++i){const int p=lane+64*i,row=p>>2,ch=p&3; const u32x4 v=*(const u32x4*)(stg+row*64+ch*16); ATTN_STORE16(Ow+(long)row*DMO+ch*16,v);} }
  asm volatile("s_waitcnt lgkmcnt(0)\n\ts_barrier":::"memory");
  #undef DMA_K
  #undef DMA_V
  #undef DMA_R
  #undef ROT
}
constexpr int ATTN_LDS_BYTES=LDS_BYTES;
struct AttnTensors { const bf16* Q; const bf16* K; const bf16* V; bf16* O; };
struct AttnUnit { int bh; int qb; };
struct StaticOrder {
  int vcu,G;
  __device__ __forceinline__ explicit StaticOrder(int grid,int block):vcu((grid%8==0)?(block%8)*(grid/8)+block/8:block),G(grid){}
  __device__ __forceinline__ bool next(int i,AttnUnit&u)const{ const int L=i*G+vcu; if(L>=4096)return false; const int pair=L>>5,j=L&31; const int b=pair>>2,kvh=pair&3; u.bh=b*NHEAD+kvh*4+(j>>3); u.qb=j&7; return true; }
  __device__ __forceinline__ void a_ready(const AttnUnit&)const{}
  __device__ __forceinline__ void done(const AttnUnit&)const{}
};
template<class Sched,int THRL=8> __device__ __forceinline__ void attn_phase(char*lds,const AttnTensors&T,const Sched&S){
  AttnUnit u;
  for(int i=0;S.next(i,u);++i){ S.a_ready(u); attn_unit<THRL>(u.bh/NHEAD,u.bh%NHEAD,u.qb,T.Q,T.K,T.V,T.O,lds); S.done(u); }
}
#undef SBAR
#undef WAIT_BAR
}
typedef GAS unsigned gu32;
struct Params { const float* in[33]; float* out; unsigned char* ws; unsigned long long ws_size; int ph_lo, ph_hi, li, pad; };
struct Frame {
    LAS unsigned char* lds; volatile LAS unsigned* MISC; unsigned* ctl;
    int tid, lane, wave, vcu, G, gw, NGW;
    const float* const* in; float* out; unsigned char* ws;
};
enum { I_X = 0, I_C, I_CTX, I_CCTX, I_WMOD, I_BMOD, I_WIN, I_LAMRE, I_LAMIM, I_LOGDT, I_BRE, I_BIM, I_CRE, I_CIM, I_SD, I_WGLU, I_QG, I_KG, I_WBS, I_WBA, I_WOUT, I_LN1G, I_LN1B,
       I_WR, I_RB, I_WEG, I_WEU, I_WED, I_WSG, I_WSU, I_WSD, I_LN2G, I_LN2B };

__device__ __forceinline__ unsigned pk4_fp8(float a, float b, float c, float d);
__device__ __forceinline__ int down16_phys(int c) { return 128 * ((c >> 3) & 1) + 32 * (c >> 6) + 16 * ((c >> 2) & 1) + 4 * ((c >> 4) & 3) + (c & 3); }
__device__ __forceinline__ void p0_transpose_item(const float* W, int ldw, int K, bf16_t* WT, int n0, int k0, int drow, int gen, LAS float* scr, int lane) {
#pragma unroll 8
    for (int i = 0; i < 32; ++i) { const int kk = 2 * i + (lane >> 5); scr[kk * 33 + (lane & 31)] = W[(size_t)(k0 + kk) * ldw + n0 + (lane & 31)]; }
    LDS_WAIT(); asm volatile("" ::: "memory");
    const int c = lane & 7;
#pragma unroll
    for (int j = 0; j < 4; ++j) { const int n = (lane >> 3) + 8 * j; const LAS float* s = scr + (8 * c) * 33 + n;
        u32x4 o; o.x = cvt_pk_bf16(s[0 * 33], s[1 * 33]); o.y = cvt_pk_bf16(s[2 * 33], s[3 * 33]); o.z = cvt_pk_bf16(s[4 * 33], s[5 * 33]); o.w = cvt_pk_bf16(s[6 * 33], s[7 * 33]);
        const int pr = gen == 2 ? (drow & ~255) + down16_phys((drow & 255) + n) : drow + (gen ? pg8::invperm32(n) : n);
        *(GAS u32x4*)(WT + (size_t)pr * K + k0 + 8 * c) = o; }
    LDS_WAIT(); asm volatile("" ::: "memory");
}
__device__ __forceinline__ unsigned pk4_fp8(float a, float b, float c, float d) { int p = __builtin_amdgcn_cvt_pk_fp8_f32(a, b, 0, false); p = __builtin_amdgcn_cvt_pk_fp8_f32(c, d, p, true); return (unsigned)p; }
struct T8Item { const float* W; int ldw, K; unsigned char* WT; int n0, k0, drow, gen; };
__device__ __forceinline__ void t8_load(const T8Item& it, int lane, f32x4 (&v)[8]) {
    const int r8 = lane >> 3, c4 = (lane & 7) * 4;
#pragma unroll
    for (int i = 0; i < 8; ++i) v[i] = *(const f32x4*)(it.W + (size_t)(it.k0 + 8 * i + r8) * it.ldw + it.n0 + c4);
}
__device__ __forceinline__ void t8_finish(const T8Item& it, int lane, const f32x4 (&v)[8], LAS float* scr) {
    { const int r8 = lane >> 3, c4 = (lane & 7) * 4;
#pragma unroll
      for (int i = 0; i < 8; ++i) { LAS float* d = scr + (8 * i + r8) * 33 + c4; d[0] = v[i][0]; d[1] = v[i][1]; d[2] = v[i][2]; d[3] = v[i][3]; } }
    LDS_WAIT(); asm volatile("" ::: "memory");
    const int c = lane & 3; const float sc = (float)(1 << pg8::W8_SHIFT);
#pragma unroll
    for (int j = 0; j < 2; ++j) { const int n = (lane >> 2) + 16 * j; const LAS float* s = scr + (16 * c) * 33 + n;
        u32x4 o;
#pragma unroll
        for (int q = 0; q < 4; ++q) o[q] = pk4_fp8(s[(4 * q) * 33] * sc, s[(4 * q + 1) * 33] * sc, s[(4 * q + 2) * 33] * sc, s[(4 * q + 3) * 33] * sc);
        const int pr = it.gen == 2 ? (it.drow & ~255) + down16_phys((it.drow & 255) + n) : it.drow + (it.gen ? pg8::invperm32(n) : n);
        *(GAS u32x4*)(it.WT + (size_t)pr * it.K + it.k0 + 16 * c) = o; }
    LDS_WAIT(); asm volatile("" ::: "memory");
}
__device__ __forceinline__ void p0_transpose_item8(const float* W, int ldw, int K, unsigned char* WT, int n0, int k0, int drow, int gen, LAS float* scr, int lane) {
    const T8Item it{W, ldw, K, WT, n0, k0, drow, gen}; f32x4 v[8]; t8_load(it, lane, v); t8_finish(it, lane, v, scr);
}
__device__ __forceinline__ int win_phys_base(int n0, bool& gen) {
    if (n0 >= 1024 && n0 < 2304) {
        const int seg = n0 < 2048 ? 1024 : 2048, lq = n0 - seg, tile = lq >> 8, wc = (lq >> 6) & 3, bj = (lq >> 5) & 1;
        gen = false; return seg + tile * 256 + 128 * bj + 32 * wc;
    }
    if (n0 >= 2304 && n0 < 2560) { gen = false; return n0; }
    gen = true; return n0;
}
__device__ __forceinline__ int win_gen(int n0, bool gen) { return !gen ? 0 : ((n0 >= 2560 || n0 < 1024) ? 2 : 1); }
__device__ __forceinline__ void p0_mixer_weights(Frame& F, int nwg) {
    LAS float* scr = (LAS float*)(F.lds + F.wave * 16384);
    constexpr int I_IN = 16 * (NIN / 32), I_SQ = 16 * 32, I_R = 16 * 8;
    constexpr int NIT = I_IN + 4 * I_SQ + I_R;
    for (int it = (int)blockIdx.x * NWAVES + F.wave; it < NIT; it += nwg * NWAVES) {
        int r = it;
        if (r < I_IN) { const int nb = r % (NIN / 32), kb = r / (NIN / 32); bool gen; const int pr = win_phys_base(nb * 32, gen);
            p0_transpose_item8(F.in[I_WIN], NIN, 1024, (unsigned char*)(F.ws + WS_WIN), nb * 32, kb * 64, pr, win_gen(nb * 32, gen), scr, F.lane); continue; }
        r -= I_IN;
        if (r < 4 * I_SQ) { const int w = r / I_SQ, q = r % I_SQ, nb = q % 32, kb = q / 32;
            const float* src = F.in[w == 0 ? I_WGLU : w == 1 ? I_WBS : w == 2 ? I_WBA : I_WOUT];
            unsigned char* dst = (unsigned char*)(F.ws + (w == 0 ? WS_WGLU : w == 1 ? WS_WBS : w == 2 ? WS_WBS + 1024 : WS_WOUT));
            p0_transpose_item8(src, 1024, (w == 1 || w == 2) ? 2048 : 1024, dst, nb * 32, kb * 64, nb * 32, 2, scr, F.lane); continue; }
        r -= 4 * I_SQ;
        { const int nb = r % 8, kb = r / 8; p0_transpose_item(F.in[I_WR], 256, 1024, (bf16_t*)(F.ws + WS_WR), nb * 32, kb * 64, nb * 32, 1, scr, F.lane); }
    }
}
__device__ __forceinline__ T8Item p9_item(Frame& F, int it) {
    constexpr int PER_E = 128 + 128 + 128;
    const int e = it / PER_E, r = it % PER_E;
    if (r < 256) { const int up = r >> 7, q = r & 127, nb = q & 7, kb = q >> 3;
        const float* src = e < NEXP ? F.in[up ? I_WEU : I_WEG] + (size_t)e * 1024 * 256 : F.in[up ? I_WSU : I_WSG];
        const int h0 = nb * 32, pr = (h0 >> 7) * 256 + up * 128 + (h0 & 127);
        return T8Item{src, 256, 1024, (unsigned char*)(F.ws + WS_WGU) + (size_t)e * 512 * 1024, h0, kb * 64, pr, 1}; }
    const int q = r - 256, nb = q & 31, kb = q >> 5;
    const float* src = e < NEXP ? F.in[I_WED] + (size_t)e * 256 * 1024 : F.in[I_WSD];
    return T8Item{src, 1024, 256, (unsigned char*)(F.ws + WS_WD) + (size_t)e * 1024 * 256, nb * 32, kb * 64, nb * 32, 2};
}
__device__ __forceinline__ void p9_expert_weights(Frame& F) {
    LAS float* scr = (LAS float*)(F.lds + F.wave * 16384);
    constexpr int NIT = NEXPS * 384;
    const int st = F.NGW; int it = F.gw; if (it >= NIT) return;
    T8Item d0 = p9_item(F, it), d1 = d0, d2 = d0, d3 = d0; f32x4 q0[8], q1[8], q2[8], q3[8];
#define P9_LD(d, q, idx) do { if ((idx) < NIT) { d = p9_item(F, (idx)); t8_load(d, F.lane, q); } } while (0)
#define P9_FIN(d, q, idx) do { if ((idx) < NIT) t8_finish(d, F.lane, q, scr); } while (0)
    t8_load(d0, F.lane, q0); P9_LD(d1, q1, it + st); P9_LD(d2, q2, it + 2 * st);
#pragma unroll 1
    for (; it < NIT; it += 4 * st) {
        P9_LD(d3, q3, it + 3 * st); P9_FIN(d0, q0, it);
        P9_LD(d0, q0, it + 4 * st); P9_FIN(d1, q1, it + st);
        P9_LD(d1, q1, it + 5 * st); P9_FIN(d2, q2, it + 2 * st);
        P9_LD(d2, q2, it + 6 * st); P9_FIN(d3, q3, it + 3 * st);
    }
#undef P9_LD
#undef P9_FIN
}
__device__ __forceinline__ void p0_mod_item(Frame& F, int item) {
    const int n0 = item * 64, w = F.wave, lane = F.lane;
    LAS float* sbuf = (LAS float*)F.lds + w * (33 * 64);
    const float* cin = F.in[I_C]; const float* cctx = F.in[I_CCTX]; const float* wm = F.in[I_WMOD];
    float acc[33];
#pragma unroll
    for (int r = 0; r < 33; ++r) acc[r] = 0.f;
    for (int pass = 0; pass < 2; ++pass) {
        const int k0 = w * 128 + pass * 64;
#pragma unroll
        for (int r = 0; r < 33; ++r) { const float cv = r < 32 ? cin[r * 1024 + k0 + lane] : cctx[k0 + lane]; sbuf[r * 64 + lane] = silu_(cv); }
        LDS_WAIT(); asm volatile("" ::: "memory");
#pragma unroll 4
        for (int kk = 0; kk < 64; ++kk) { const float wv = wm[(size_t)(k0 + kk) * 6144 + n0 + lane];
#pragma unroll
            for (int r = 0; r < 33; ++r) acc[r] += sbuf[r * 64 + kk] * wv; }
        LDS_WAIT(); asm volatile("" ::: "memory");
    }
    __syncthreads();
    LAS float* red = (LAS float*)F.lds;
#pragma unroll
    for (int r = 0; r < 33; ++r) red[(w * 33 + r) * 64 + lane] = acc[r];
    __syncthreads();
    float* mod = (float*)(F.ws + WS_MOD);
    for (int o = F.tid; o < 33 * 64; o += NTHR) { const int r = o >> 6, l = o & 63; float s = F.in[I_BMOD][n0 + l];
#pragma unroll
        for (int w2 = 0; w2 < 8; ++w2) s += red[(w2 * 33 + r) * 64 + l];
        mod[r * 6144 + n0 + l] = s; }
    __syncthreads();
}
__device__ __forceinline__ void p0_s5_tables(Frame& F, int g) {
    LAS f32x2* pw = (LAS f32x2*)F.lds;
    LAS f32x2* bb = (LAS f32x2*)(F.lds + 33792);
    LAS f32x2* cc = (LAS f32x2*)(F.lds + 33792 + 16384);
    LAS float* ktab = (LAS float*)(F.lds + 33792 + 32768);
    const int tid = F.tid;
    if (tid < 128) {
        const int d = tid >> 6, p = tid & 63, base = (d * 64 + g) * 64 + p;
        const double lr = fmin((double)F.in[I_LAMRE][base], -1e-4), li = (double)F.in[I_LAMIM][base], dt = exp((double)F.in[I_LOGDT][d * 64 + g]);
        for (int k = 0; k <= 32; ++k) { const double mag = exp(k * lr * dt), ang = k * li * dt; pw[(d * 33 + k) * 64 + p] = (f32x2){(float)(mag * cos(ang)), (float)(mag * sin(ang))}; }
        { const double mag = exp(32 * lr * dt), ang = 32 * li * dt; float* laml = (float*)(F.ws + WS_LAML) + (size_t)base * 2; laml[0] = (float)(mag * cos(ang)); laml[1] = (float)(mag * sin(ang)); }
        const double m1 = exp(lr * dt), nr = m1 * cos(li * dt) - 1.0, ni = m1 * sin(li * dt), den = lr * lr + li * li;
        const double qr = (nr * lr + ni * li) / den, qi = (ni * lr - nr * li) / den;
        for (int c = 0; c < 16; ++c) { const double br = F.in[I_BRE][(size_t)base * 16 + c], bi = F.in[I_BIM][(size_t)base * 16 + c];
            bb[(d * 64 + p) * 16 + c] = (f32x2){(float)(qr * br - qi * bi), (float)(qr * bi + qi * br)}; }
    }
    for (int e = tid; e < 2048; e += NTHR) { const int d = e >> 10, c = (e >> 6) & 15, p = e & 63; const size_t gi = ((size_t)(d * 64 + g) * 16 + c) * 64 + p;
        cc[e] = (f32x2){F.in[I_CRE][gi], F.in[I_CIM][gi]}; }
    __syncthreads();
    for (int e = tid; e < 2 * 32 * 256; e += NTHR) {
        const int d = e >> 13, k = (e >> 8) & 31, c = (e >> 4) & 15, c2 = e & 15; float s = 0.f;
        for (int p = 0; p < 64; ++p) { const f32x2 C = cc[(d * 16 + c) * 64 + p], P = pw[(d * 33 + k) * 64 + p], B = bb[(d * 64 + p) * 16 + c2];
            const float tr = C.x * P.x - C.y * P.y, ti = C.x * P.y + C.y * P.x; s += tr * B.x - ti * B.y; }
        ktab[e] = s;
    }
    __syncthreads();
    const float* dsk = F.in[I_SD] + g * 16;
    unsigned char* tm = (unsigned char*)(F.ws + WS_TMAT) + (size_t)g * NS5 * KAUG;
    for (int ch = tid; ch < NS5 * (KAUG / 8); ch += NTHR) {
        const int rho = ch / (KAUG / 8), kc = ch % (KAUG / 8), rr_ = rho & 255;
        const int n = (rho & ~255) + 64 * ((rr_ >> 5) & 3) + 16 * ((rr_ >> 2) & 3) + 8 * (rr_ >> 7) + 4 * ((rr_ >> 4) & 1) + (rr_ & 3), t = n >> 4, c = n & 15;
        float v[8];
#pragma unroll
        for (int i = 0; i < 8; ++i) { const int kk = kc * 8 + i;
            if (kk < NS5) { const int s = kk >> 4, c2 = kk & 15;
                v[i] = t > s ? ktab[(t - s) * 256 + c * 16 + c2] : s > t ? ktab[8192 + (s - t) * 256 + c * 16 + c2] : ktab[c * 16 + c2] + ktab[8192 + c * 16 + c2] + (c == c2 ? dsk[c] : 0.f);
            } else { const int j = kk - NS5, d = j >> 7, p = (j & 127) >> 1, ri = j & 1, e = d == 0 ? t + 1 : LC5 - t;
                const f32x2 C = cc[(d * 16 + c) * 64 + p], P = pw[(d * 33 + e) * 64 + p];
                v[i] = (ri == 0 ? C.x * P.x - C.y * P.y : -(C.x * P.y + C.y * P.x)) * (1.0f / CARRY_SCALE); } }
        const float ts = (float)(1 << TMAT_SHIFT); u32x2 o; o.x = pk4_fp8(v[0] * ts, v[1] * ts, v[2] * ts, v[3] * ts); o.y = pk4_fp8(v[4] * ts, v[5] * ts, v[6] * ts, v[7] * ts);
        *(u32x2*)(tm + (size_t)rho * KAUG + kc * 8) = o;
    }
    unsigned char* wh = (unsigned char*)(F.ws + WS_WH) + (size_t)g * 256 * NS5;
    for (int ch = tid; ch < 256 * (NS5 / 8); ch += NTHR) {
        const int rho = ch / (NS5 / 8), kc = ch % (NS5 / 8), n = (rho & ~31) + pg8::perm32(rho & 31), d = n >> 7, p = (n & 127) >> 1, ri = n & 1;
        float v[8];
#pragma unroll
        for (int i = 0; i < 8; ++i) { const int kk = kc * 8 + i, s = kk >> 4, c2 = kk & 15, e = d == 0 ? LC5 - 1 - s : s;
            const f32x2 P = pw[(d * 33 + e) * 64 + p], B = bb[(d * 64 + p) * 16 + c2];
            v[i] = ri == 0 ? P.x * B.x - P.y * B.y : P.x * B.y + P.y * B.x; }
        const float hs = (float)(1 << WH_SHIFT); u32x2 o; o.x = pk4_fp8(v[0] * hs, v[1] * hs, v[2] * hs, v[3] * hs); o.y = pk4_fp8(v[4] * hs, v[5] * hs, v[6] * hs, v[7] * hs);
        *(u32x2*)(wh + (size_t)rho * NS5 + kc * 8) = o;
    }
    __syncthreads();
}
__device__ __forceinline__ void p0_rope(Frame& F) {
    float* rope = (float*)(F.ws + WS_ROPE);
    for (int idx = F.lane; idx < 64 * 16; idx += 64) { const int pos = idx >> 4, i = idx & 15;
        const double inv = exp(-9.210340371976184 * (double)i / 16.0), ang = (double)pos * inv; rope[idx * 2] = (float)cos(ang); rope[idx * 2 + 1] = (float)sin(ang); }
}

__device__ __forceinline__ void row_stats(const float (&v)[16], float eps, float& mean, float& rstd) {
    float s = 0.f;
#pragma unroll
    for (int i = 0; i < 16; ++i) s += v[i];
    mean = wave_sum(s) * (1.f / 1024.f); float q = 0.f;
#pragma unroll
    for (int i = 0; i < 16; ++i) { const float d = v[i] - mean; q += d * d; }
    rstd = 1.0f / sqrtf(wave_sum(q) * (1.f / 1024.f) + eps);
}
__device__ __forceinline__ void load16f(const float* row, int lane, float (&v)[16]) {
#pragma unroll
    for (int h = 0; h < 2; ++h) { const f32x4 a = *(const f32x4*)(row + h * 512 + lane * 8), b = *(const f32x4*)(row + h * 512 + lane * 8 + 4);
#pragma unroll
        for (int j = 0; j < 4; ++j) { v[h * 8 + j] = a[j]; v[h * 8 + 4 + j] = b[j]; } }
}
__device__ __forceinline__ void load16b(const bf16_t* row, int lane, float (&v)[16]) {
#pragma unroll
    for (int h = 0; h < 2; ++h) { const u32x4 w = *(const u32x4*)(row + h * 512 + lane * 8);
        v[h * 8 + 0] = bflo(w.x); v[h * 8 + 1] = bfhi(w.x); v[h * 8 + 2] = bflo(w.y); v[h * 8 + 3] = bfhi(w.y); v[h * 8 + 4] = bflo(w.z); v[h * 8 + 5] = bfhi(w.z); v[h * 8 + 6] = bflo(w.w); v[h * 8 + 7] = bfhi(w.w); }
}
__device__ __forceinline__ void store16b(bf16_t* row, int lane, const float (&v)[16]) {
#pragma unroll
    for (int h = 0; h < 2; ++h) { u32x4 w; w.x = cvt_pk_bf16(v[h * 8 + 0], v[h * 8 + 1]); w.y = cvt_pk_bf16(v[h * 8 + 2], v[h * 8 + 3]); w.z = cvt_pk_bf16(v[h * 8 + 4], v[h * 8 + 5]); w.w = cvt_pk_bf16(v[h * 8 + 6], v[h * 8 + 7]);
        *(u32x4*)(row + h * 512 + lane * 8) = w; }
}
__device__ __forceinline__ void load16f_nt(const float* row, int lane, float (&v)[16]) {
#pragma unroll
    for (int q = 0; q < 4; ++q) { const f32x4 a = __builtin_nontemporal_load((const f32x4*)(row + lane * 16 + q * 4));
#pragma unroll
        for (int j = 0; j < 4; ++j) v[q * 4 + j] = a[j]; }
}
__device__ __forceinline__ void load16f_c(const float* row, int lane, float (&v)[16]) {
#pragma unroll
    for (int q = 0; q < 4; ++q) { const f32x4 a = *(const f32x4*)(row + lane * 16 + q * 4);
#pragma unroll
        for (int j = 0; j < 4; ++j) v[q * 4 + j] = a[j]; }
}
__device__ __forceinline__ void store16_fp8(unsigned char* row, int lane, const float (&v)[16]) {
    u32x4 w;
#pragma unroll
    for (int q = 0; q < 4; ++q) w[q] = pk4_fp8(v[q * 4], v[q * 4 + 1], v[q * 4 + 2], v[q * 4 + 3]);
    *(u32x4*)(row + lane * 16) = w;
}
__device__ __forceinline__ void load16f_q(const float* row, int lane, float (&v)[16]) {
#pragma unroll
    for (int q = 0; q < 4; ++q) { const f32x4 a = *(const f32x4*)(row + q * 256 + lane * 4);
#pragma unroll
        for (int j = 0; j < 4; ++j) v[q * 4 + j] = a[j]; }
}
__device__ __forceinline__ void p1_rows(Frame& F, const float* src, unsigned char* dst, int r0, int r1, const float* modrow) {
    float sh[16], sc[16]; load16f_q(modrow, F.lane, sh); load16f_q(modrow + 1024, F.lane, sc);
    for (int r = r0; r < r1; r += 4) {
        float v[4][16];
#pragma unroll
        for (int i = 0; i < 4; ++i) if (r + i < r1) load16f_q(src + (size_t)(r + i) * 1024, F.lane, v[i]);
#pragma unroll
        for (int i = 0; i < 4; ++i) if (r + i < r1) {
            float mean, rstd; row_stats(v[i], 1e-6f, mean, rstd);
#pragma unroll
            for (int e = 0; e < 16; ++e) v[i][e] = (v[i][e] - mean) * rstd * (1.f + sc[e]) + sh[e];
#pragma unroll
            for (int q = 0; q < 4; ++q) *(unsigned*)(dst + (size_t)(r + i) * 1024 + q * 256 + F.lane * 4) = pk4_fp8(v[i][q * 4], v[i][q * 4 + 1], v[i][q * 4 + 2], v[i][q * 4 + 3]); }
    }
}
__device__ __forceinline__ void p1_modulate(Frame& F, int lo, int hi, bool with_ctx) {
    const float* mod = (const float*)(F.ws + WS_MOD);
    const int RPW = (hi - lo) / 2048; constexpr int CPW = TC / 2048;
    for (int w = F.gw; w < 2048; w += F.NGW) {
        const int r0 = lo + w * RPW; p1_rows(F, F.in[I_X], (unsigned char*)(F.ws + WS_A), r0, r0 + RPW, mod + (size_t)(r0 >> 11) * 6144);
        if (with_ctx) { const int c0 = w * CPW; p1_rows(F, F.in[I_CTX], (unsigned char*)(F.ws + WS_UC), c0, c0 + CPW, mod + (size_t)32 * 6144); }
    }
}
__device__ __forceinline__ void load16b_c(const bf16_t* row, int lane, float (&v)[16]) {
    const u32x4 a = *(const u32x4*)(row + lane * 16), b = *(const u32x4*)(row + lane * 16 + 8);
    v[0] = bflo(a.x); v[1] = bfhi(a.x); v[2] = bflo(a.y); v[3] = bfhi(a.y); v[4] = bflo(a.z); v[5] = bfhi(a.z); v[6] = bflo(a.w); v[7] = bfhi(a.w);
    v[8] = bflo(b.x); v[9] = bfhi(b.x); v[10] = bflo(b.y); v[11] = bfhi(b.y); v[12] = bflo(b.z); v[13] = bfhi(b.z); v[14] = bflo(b.w); v[15] = bfhi(b.w);
}
__device__ __forceinline__ void store16b_c(bf16_t* row, int lane, const float (&v)[16]) {
    u32x4 a, b; a.x = cvt_pk_bf16(v[0], v[1]); a.y = cvt_pk_bf16(v[2], v[3]); a.z = cvt_pk_bf16(v[4], v[5]); a.w = cvt_pk_bf16(v[6], v[7]);
    b.x = cvt_pk_bf16(v[8], v[9]); b.y = cvt_pk_bf16(v[10], v[11]); b.z = cvt_pk_bf16(v[12], v[13]); b.w = cvt_pk_bf16(v[14], v[15]);
    *(u32x4*)(row + lane * 16) = a; *(u32x4*)(row + lane * 16 + 8) = b;
}
__device__ __forceinline__ void store16_fp8_h(unsigned char* row, int lane, const float (&v)[16]) {
#pragma unroll
    for (int h = 0; h < 2; ++h) { u32x2 w; w.x = pk4_fp8(v[h * 8], v[h * 8 + 1], v[h * 8 + 2], v[h * 8 + 3]); w.y = pk4_fp8(v[h * 8 + 4], v[h * 8 + 5], v[h * 8 + 6], v[h * 8 + 7]); *(u32x2*)(row + h * 512 + lane * 8) = w; }
}
__device__ __forceinline__ void p9_router_weights(Frame& F) {
    const float* mod = (const float*)(F.ws + WS_MOD); const bf16_t* wr = (const bf16_t*)(F.ws + WS_WR); bf16_t* wrb = (bf16_t*)(F.ws + WS_WRB); float* rvb = (float*)(F.ws + WS_RVB);
    for (int row = F.gw; row < NB * 256; row += F.NGW) {
        const int b = row >> 8, p = row & 255;
        float w[16], sh[16], sc[16]; load16b(wr + (size_t)p * 1024, F.lane, w); load16f(mod + (size_t)b * 6144 + 3072, F.lane, sh); load16f(mod + (size_t)b * 6144 + 4096, F.lane, sc);
        float av = 0.f, aw = 0.f, o[16];
#pragma unroll
        for (int e = 0; e < 16; ++e) { const float x = w[e] * (1.f + sc[e]); const float xr = __uint_as_float(cvt_pk_bf16(x, x) << 16); o[e] = xr; av += xr; aw += w[e] * sh[e]; }
        store16b(wrb + (size_t)row * 1024, F.lane, o);
        av = wave_sum(av); aw = wave_sum(aw);
        if (F.lane == 0) { const int e = (p & ~31) + pg8::perm32(p & 31); rvb[b * 512 + e] = av; rvb[b * 512 + 256 + e] = aw; }
    }
}
__device__ __forceinline__ void p9_ln1(Frame& F) {
    const float* mod = (const float*)(F.ws + WS_MOD);
    float g[16], bta[16]; load16f(F.in[I_LN1G], F.lane, g); load16f(F.in[I_LN1B], F.lane, bta);
    constexpr int RPW = T / 2048;
    for (int w = F.gw; w < 2048; w += F.NGW) {
        const int r0 = w * RPW, b = r0 >> 11;
        float sh[16], sc[16]; load16f(mod + (size_t)b * 6144 + 3072, F.lane, sh); load16f(mod + (size_t)b * 6144 + 4096, F.lane, sc);
        for (int r = r0; r < r0 + RPW; r += 4) {
            float v[4][16];
#pragma unroll
            for (int i = 0; i < 4; ++i) load16b((const bf16_t*)(F.ws + WS_X1) + (size_t)(r + i) * 1024, F.lane, v[i]);
#pragma unroll
            for (int i = 0; i < 4; ++i) {
                float mean, rstd; row_stats(v[i], 1e-5f, mean, rstd);
#pragma unroll
                for (int e = 0; e < 16; ++e) v[i][e] = (v[i][e] - mean) * rstd * g[e] + bta[e];
                store16b((bf16_t*)(F.ws + WS_X1) + (size_t)(r + i) * 1024, F.lane, v[i]);
                row_stats(v[i], 1e-6f, mean, rstd);
#pragma unroll
                for (int e = 0; e < 16; ++e) v[i][e] = (v[i][e] - mean) * rstd * (1.f + sc[e]) + sh[e];
                if (F.lane == 0) *(f32x2*)((float*)(F.ws + WS_STAT) + (size_t)(r + i) * 2) = (f32x2){mean, rstd};
                store16_fp8_h((unsigned char*)(F.ws + WS_U2) + (size_t)(r + i) * 1024, F.lane, v[i]); }
        }
    }
}
__device__ __forceinline__ void p4_carry_scan(Frame& F) {
    const unsigned* hfin = (const unsigned*)(F.ws + WS_HFIN);        const float* laml = (const float*)(F.ws + WS_LAML); unsigned char* saug = (unsigned char*)(F.ws + WS_SAUG);
    for (int item = F.gw; item < NB * 64 * 2; item += F.NGW) {
        const int d = item & 1, g = (item >> 1) & 63, b = item >> 7, p = F.lane;
        const f32x2 lam = *(const f32x2*)(laml + ((size_t)(d * 64 + g) * 64 + p) * 2);
        float cr = 0.f, ci = 0.f;
        const size_t gbase = (size_t)g * ROWS_G;
        unsigned hv[8];
#pragma unroll
        for (int j = 0; j < 8; ++j) { const int jj = d == 0 ? j : 7 - j; hv[j] = hfin[((gbase + 2048 + b * 8 + jj) * 256 + d * 128) / 2 + p]; }
#pragma unroll
        for (int j = 0; j < 8; ++j) { const float nr = lam.x * cr - lam.y * ci + bflo(hv[j]), ni = lam.x * ci + lam.y * cr + bfhi(hv[j]); cr = nr; ci = ni; }
        for (int j0 = 0; j0 < 64; j0 += 8) {
#pragma unroll
            for (int j = 0; j < 8; ++j) { const int jj = d == 0 ? j0 + j : 63 - (j0 + j); hv[j] = hfin[((gbase + b * 64 + jj) * 256 + d * 128) / 2 + p]; }
#pragma unroll
            for (int j = 0; j < 8; ++j) { const int jj = d == 0 ? j0 + j : 63 - (j0 + j);
                *(unsigned short*)(saug + (gbase + b * 64 + jj) * KAUG + NS5 + d * 128 + p * 2) = (unsigned short)__builtin_amdgcn_cvt_pk_fp8_f32(cr * CARRY_SCALE, ci * CARRY_SCALE, 0, false);
                const float nr = lam.x * cr - lam.y * ci + bflo(hv[j]), ni = lam.x * ci + lam.y * cr + bfhi(hv[j]); cr = nr; ci = ni; }
        }
    }
}
__device__ __forceinline__ void p11_routing(Frame& F, int tile) {
    const float* logits = (const float*)(F.ws + WS_LOGIT); const float* rb = F.in[I_RB];
    int* eidx = (int*)(F.ws + WS_EIDX); float* gate = (float*)(F.ws + WS_GATE); int* slot = (int*)(F.ws + WS_SLOT); int* wgh = (int*)(F.ws + WS_WGH);
    LAS int* hist = (LAS int*)F.lds;
    for (int i = F.tid; i < 256; i += NTHR) hist[i] = 0;
    __syncthreads();
    const int g8 = F.lane & 7, sub = F.lane >> 3;
    float bias[32], vb[32], wb[32]; const float* rvb = (const float*)(F.ws + WS_RVB) + (tile >> 3) * 512; const float* stat = (const float*)(F.ws + WS_STAT);
#pragma unroll
    for (int j = 0; j < 8; ++j) { const f32x4 t = *(const f32x4*)(rb + g8 * 32 + j * 4); bias[j * 4] = t[0]; bias[j * 4 + 1] = t[1]; bias[j * 4 + 2] = t[2]; bias[j * 4 + 3] = t[3];
        const f32x4 a = *(const f32x4*)(rvb + g8 * 32 + j * 4), c = *(const f32x4*)(rvb + 256 + g8 * 32 + j * 4);
#pragma unroll
        for (int q = 0; q < 4; ++q) { vb[j * 4 + q] = a[q]; wb[j * 4 + q] = c[q]; } }
    for (int it = 0; it < 4; ++it) {
        const int token = tile * 256 + (it * 8 + F.wave) * 8 + sub; const float NEG = -INFINITY;
        float sc[32], bs[32]; const f32x2 ms = *(const f32x2*)(stat + (size_t)token * 2);
#pragma unroll
        for (int j = 0; j < 8; ++j) { const f32x4 t = *(const f32x4*)(logits + (size_t)token * 256 + g8 * 32 + j * 4);
#pragma unroll
            for (int q = 0; q < 4; ++q) { const float lg = ms[1] * (t[q] - ms[0] * vb[j * 4 + q]) + wb[j * 4 + q]; sc[j * 4 + q] = 1.0f / (1.0f + __expf(-lg)); bs[j * 4 + q] = sc[j * 4 + q] + bias[j * 4 + q]; } }
        float m1 = NEG, m2 = NEG;
#pragma unroll
        for (int j = 0; j < 32; ++j) { const float v = bs[j]; if (v > m1) { m2 = m1; m1 = v; } else if (v > m2) m2 = v; }
        const float gsc = m1 + m2; int rank = 0;
#pragma unroll
        for (int o = 1; o < 8; ++o) { const int og = (g8 + o) & 7; const float other = __shfl(gsc, (F.lane & ~7) | og); rank += (other > gsc || (other == gsc && og < g8)) ? 1 : 0; }
        if (rank >= 4) {
#pragma unroll
            for (int j = 0; j < 32; ++j) bs[j] = NEG; }
        int my_e = 0; float my_s = 0.f;
#pragma unroll 1
        for (int r = 0; r < 8; ++r) {
            float bv = NEG; int bi = 0;
#pragma unroll
            for (int j = 0; j < 32; ++j) if (bs[j] > bv) { bv = bs[j]; bi = j; }
            int gi = g8 * 32 + bi;
#pragma unroll
            for (int o = 1; o < 8; o <<= 1) { const float ov = __shfl_xor(bv, o); const int oi = __shfl_xor(gi, o); if (ov > bv || (ov == bv && oi < gi)) { bv = ov; gi = oi; } }
            float sw = 0.f; const bool mine = (gi >> 5) == g8;
#pragma unroll
            for (int j = 0; j < 32; ++j) if (mine && j == (gi & 31)) { sw = sc[j]; bs[j] = NEG; }
            sw = __shfl(sw, (F.lane & ~7) | (gi >> 5));
            if (g8 == r) { my_e = gi; my_s = sw; }
        }
        float ssum = my_s;
#pragma unroll
        for (int o = 1; o < 8; o <<= 1) ssum += __shfl_xor(ssum, o);
        const int pos = __hip_atomic_fetch_add(hist + my_e, 1, __ATOMIC_RELAXED, __HIP_MEMORY_SCOPE_WORKGROUP);
        eidx[(size_t)token * 8 + g8] = my_e; gate[(size_t)token * 8 + g8] = my_s / ssum * 2.5f; slot[(size_t)token * 8 + g8] = pos;
    }
    __syncthreads();
    for (int i = F.tid; i < 256; i += NTHR) wgh[tile * 256 + i] = hist[i];
    __syncthreads();
}
__device__ __forceinline__ void p12_dispatch(Frame& F) {
    constexpr int WPC = TCH / 256;
    LAS int* tot = (LAS int*)F.lds; LAS int* base = tot + 256; LAS int* off = tot + 512;
    const int w = (int)blockIdx.x, c = w / WPC; const int* wgh = (const int*)(F.ws + WS_WGH);
    if (F.tid < 256) { int t_ = 0, b_ = 0;
        for (int j = 0; j < WPC; ++j) { const int v = wgh[(c * WPC + j) * 256 + F.tid]; t_ += v; if (c * WPC + j < w) b_ += v; }
        tot[F.tid] = t_; base[F.tid] = b_; }
    __syncthreads();
    if (F.tid == 0) { int run = 0; for (int e = 0; e < 256; ++e) { off[e] = run; run += tot[e]; } }
    __syncthreads();
    const int* eidx = (const int*)(F.ws + WS_EIDX); int* slot = (int*)(F.ws + WS_SLOT); int* stok = (int*)(F.ws + WS_STOK) + (size_t)c * (SLOTS_CH + 256);
    for (int i = F.tid; i < 2048; i += NTHR) { const int a = w * 2048 + i, e = eidx[a], s = off[e] + base[e] + slot[a]; stok[s] = a >> 3; slot[a] = s; }
    for (int i = F.tid; i < 256; i += NTHR) { const int token = w * 256 + i; stok[TCH * 8 + (token - c * TCH)] = token; }
    if (w % WPC == 0 && F.tid == 0) {
        int* tiles = (int*)(F.ws + WS_TILES) + c * TILE_INTS; int nt_ = 0;
        for (int e = 0; e <= 256; ++e) { const int n = e < 256 ? tot[e] : TCH, o = e < 256 ? off[e] : TCH * 8;
            for (int r0 = 0; r0 < n; r0 += 256) { tiles[4 + nt_ * 4 + 0] = e; tiles[4 + nt_ * 4 + 1] = o + r0; tiles[4 + nt_ * 4 + 2] = (n - r0) < 256 ? (n - r0) : 256; tiles[4 + nt_ * 4 + 3] = 0; ++nt_; } }
        tiles[0] = nt_;
    }
    __syncthreads();
}
__device__ __forceinline__ void y16_fma(const u32x4& w, float s, float (&f)[16]) {
#pragma unroll
    for (int q = 0; q < 4; ++q) { const f32x2 a = __builtin_amdgcn_cvt_pk_f32_fp8((int)w[q], false), b = __builtin_amdgcn_cvt_pk_f32_fp8((int)w[q], true);
        f[q * 4 + 0] += s * a[0]; f[q * 4 + 1] += s * a[1]; f[q * 4 + 2] += s * b[0]; f[q * 4 + 3] += s * b[1]; }
}
template <int TIF> __device__ __forceinline__ void p15_combine(Frame& F, int c) {
    const float* mod = (const float*)(F.ws + WS_MOD); const unsigned char* Y = (const unsigned char*)(F.ws + WS_Y); const bf16_t* X1 = (const bf16_t*)(F.ws + WS_X1);
    const int* slot = (const int*)(F.ws + WS_SLOT); const float* gate = (const float*)(F.ws + WS_GATE);
    int lane_ = F.lane; asm volatile("" : "+v"(lane_));
    const float* gp_ = F.in[I_LN2G]; const float* bp_ = F.in[I_LN2B]; asm volatile("" : "+s"(gp_), "+s"(bp_));
    float g[16], bta[16]; load16f_c(gp_, lane_, g); load16f_c(bp_, lane_, bta);
    constexpr int TPW = TCH / 2048;
    for (int w = F.gw; w < 2048; w += F.NGW) {
        const int t0 = w * TPW, b = (c * TCH + t0) >> 11;
        float g2[16]; load16f_c(mod + (size_t)b * 6144 + 5120, lane_, g2);
        for (int tt = t0; tt < t0 + TPW; tt += TIF) {
            u32x4 yw[TIF][9], xa[TIF], xb[TIF]; float gt[TIF];
#pragma unroll
            for (int i = 0; i < TIF; ++i) { const int token = c * TCH + tt + i;
                int s = 0; gt[i] = 0.f; if (lane_ < 8) { s = slot[(size_t)token * 8 + lane_]; gt[i] = gate[(size_t)token * 8 + lane_]; }
                yw[i][8] = *(const u32x4*)(Y + (size_t)(TCH * 8 + tt + i) * 1024 + lane_ * 16);
#pragma unroll
                for (int k = 0; k < 8; ++k) { const int sk = __shfl(s, k); yw[i][k] = *(const u32x4*)(Y + (size_t)sk * 1024 + lane_ * 16); }
                xa[i] = *(const u32x4*)(X1 + (size_t)token * 1024 + lane_ * 16); xb[i] = *(const u32x4*)(X1 + (size_t)token * 1024 + lane_ * 16 + 8); }
#pragma unroll
            for (int i = 0; i < TIF; ++i) { const int token = c * TCH + tt + i;
                float f[16];
#pragma unroll
                for (int e = 0; e < 16; ++e) f[e] = 0.f;
                y16_fma(yw[i][8], 1.0f / YSCALE, f);
#pragma unroll
                for (int k = 0; k < 8; ++k) y16_fma(yw[i][k], __shfl(gt[i], k) * (1.0f / YSCALE), f);
                float x1[16];
                x1[0] = bflo(xa[i].x); x1[1] = bfhi(xa[i].x); x1[2] = bflo(xa[i].y); x1[3] = bfhi(xa[i].y); x1[4] = bflo(xa[i].z); x1[5] = bfhi(xa[i].z); x1[6] = bflo(xa[i].w); x1[7] = bfhi(xa[i].w);
                x1[8] = bflo(xb[i].x); x1[9] = bfhi(xb[i].x); x1[10] = bflo(xb[i].y); x1[11] = bfhi(xb[i].y); x1[12] = bflo(xb[i].z); x1[13] = bfhi(xb[i].z); x1[14] = bflo(xb[i].w); x1[15] = bfhi(xb[i].w);
#pragma unroll
                for (int e = 0; e < 16; ++e) f[e] = ALPHA * x1[e] + g2[e] * f[e];
                float mean, rstd; row_stats(f, 1e-5f, mean, rstd);
                LAS float* lrow = (LAS float*)(F.lds + F.wave * 4096);
#pragma unroll
                for (int q = 0; q < 4; ++q) { f32x4 o;
#pragma unroll
                    for (int j = 0; j < 4; ++j) o[j] = (f[q * 4 + j] - mean) * rstd * g[q * 4 + j] + bta[q * 4 + j];
                    *(LAS f32x4*)(lrow + lane_ * 16 + q * 4) = o; }
                LDS_WAIT(); asm volatile("" ::: "memory");
                float* orow = F.out + (size_t)token * 1024;
#pragma unroll
                for (int q = 0; q < 4; ++q) *(f32x4*)(orow + q * 256 + lane_ * 4) = *(const LAS f32x4*)(lrow + q * 256 + lane_ * 4);
                LDS_WAIT(); asm volatile("" ::: "memory");
            }
        }
    }
}
#if MK_DIAG
__device__ __forceinline__ unsigned dhash(unsigned i) { unsigned h = (i + 1u) * 2654435761u; h ^= h >> 15; h *= 2246822519u; h ^= h >> 13; return h; }
__device__ __forceinline__ void dreport(Frame& F, int k, float err) { atomicMax(F.ctl + CW_CHK + k, __float_as_uint(err)); }
__device__ __forceinline__ float relerr(float got, float exp_, float floor_) { return fabsf(got - exp_) / (fabsf(exp_) + floor_); }
__device__ __forceinline__ float ddot_b(const bf16_t* arow, int K, const float* W, int ldw, int col) { float s = 0.f; for (int k = 0; k < K; ++k) s += bf2f(arow[k]) * W[(size_t)k * ldw + col]; return s; }
__device__ __forceinline__ float dqk_ref(const bf16_t* urow, const float* win, int colbase, const float* gvec, bool rope, int l, int lane, int& spos) {
    const float d = ddot_b(urow, 1024, win, NIN, colbase + lane);
    const float ss = wave_sum(d * d), y = d * (1.0f / sqrtf(ss / 64.f + 1e-6f)) * gvec[lane];
    const float yp = __shfl(y, lane ^ 16);
    const int axis = lane >> 5, hd = lane & 31, i = hd & 15;
    float o = y;
    if (rope) { const float pos = axis == 0 ? (float)(l >> 6) : (float)(l & 63); const float ang = pos * powf(10000.f, -(float)i / 16.f); const float cs = cosf(ang), sn = sinf(ang);
        o = hd < 16 ? y * cs - yp * sn : yp * sn + y * cs; }
    const int bj = lane >> 5, n = (lane >> 4) & 1, fq = (lane >> 2) & 3, j = lane & 3; spos = 16 * fq + 8 * bj + 4 * n + j;
    return o;
}
#ifndef MK_DIAG_MASK
#define MK_DIAG_MASK 0xffffffffu
#endif
#define DCHK(k) (((MK_DIAG_MASK) >> (k)) & 1u)
template <int k> __device__ __forceinline__ void diag_checks(Frame& F) {
    unsigned char* ws = F.ws; const int lane = F.lane;
    if constexpr (k == 0) {
        const float* mod = (const float*)(ws + WS_MOD);
        for (int s = F.gw; s < 512; s += F.NGW) { const unsigned h = dhash(s); const int r = h % 33, n = (h >> 8) % 6144; float a = 0.f;
            for (int kk = lane; kk < 1024; kk += 64) { const float cv = r < 32 ? F.in[I_C][r * 1024 + kk] : F.in[I_CCTX][kk]; a += cv / (1.f + expf(-cv)) * F.in[I_WMOD][(size_t)kk * 6144 + n]; }
            a = wave_sum(a) + F.in[I_BMOD][n]; dreport(F, 0, relerr(mod[r * 6144 + n], a, 0.05f)); }
        const bf16_t* wt = (const bf16_t*)(ws + WS_WIN);
        for (int s = F.gw * 64 + lane; s < 65536; s += F.NGW * 64) { const unsigned h = dhash(s + 777); const int n = h % NIN, kk = (h >> 13) % 1024; bool gen; const int base = win_phys_base(n & ~31, gen);
            const int pr = base + (gen ? pg8::invperm32(n & 31) : (n & 31)); dreport(F, 1, relerr(bf2f(wt[(size_t)pr * 1024 + kk]), F.in[I_WIN][(size_t)kk * NIN + n], 0.02f)); }
    } else if constexpr (k == 1) {
        const float* mod = (const float*)(ws + WS_MOD);
        for (int s = F.gw; s < 512; s += F.NGW) { const unsigned h = dhash(s + 31); const bool isc = (s & 7) == 7; const int r = isc ? h % TC : h % T, b = isc ? 32 : r >> 11;
            const float* xr = (isc ? F.in[I_CTX] : F.in[I_X]) + (size_t)r * 1024; float a = 0.f, q = 0.f;
            for (int c = lane; c < 1024; c += 64) a += xr[c];
            const float mean = wave_sum(a) / 1024.f;
            for (int c = lane; c < 1024; c += 64) q += (xr[c] - mean) * (xr[c] - mean);
            const float rstd = 1.f / sqrtf(wave_sum(q) / 1024.f + 1e-6f);
            const bf16_t* ur = (const bf16_t*)(ws + (isc ? WS_UC : WS_A)) + (size_t)r * 1024;
            for (int c = lane; c < 1024; c += 64) { const float e = (xr[c] - mean) * rstd * (1.f + mod[b * 6144 + 1024 + c]) + mod[b * 6144 + c]; dreport(F, 2, relerr(bf2f(ur[c]), e, 0.05f)); } }
    } else if constexpr (k == 2) {
        const bf16_t* U = (const bf16_t*)(ws + WS_A); const bf16_t* UC = (const bf16_t*)(ws + WS_UC); const float* win = F.in[I_WIN];
        for (int s = F.gw; s < 1024; s += F.NGW) {
            const unsigned h = dhash(s + 99); const bool isc = (s & 3) == 3; const int r = isc ? h % TC : h % T, b = isc ? r >> 8 : r >> 11, l = isc ? r & 255 : r & 2047;
            const bf16_t* ur = (isc ? UC : U) + (size_t)r * 1024; const int kind = (h >> 20) % 6;
            const int cb = (h >> 24) & 15;
            if (kind == 0) { const int n = (cb * 64 + lane), g = n >> 4, c = n & 15; const float d = ddot_b(ur, 1024, win, NIN, n);
                const int grow = isc ? 2048 + b * 8 + (l >> 5) : b * 64 + (l >> 5); const float got = bf2f(((const bf16_t*)(ws + WS_SAUG))[((size_t)g * ROWS_G + grow) * KAUG + (l & 31) * 16 + c]); dreport(F, 3, relerr(got, d, 0.5f)); }
            else if (kind == 1 && !isc) { const int head = cb; int sp; const float e = dqk_ref(ur, win, 1024 + head * 64, F.in[I_QG], true, l, lane, sp) * C2Q;
                dreport(F, 4, relerr(bf2f(((const bf16_t*)(ws + WS_Q))[(size_t)r * 1024 + head * 64 + sp]), e, 0.1f)); }
            else if (kind == 2) { const int head = cb & 3; int sp; const float e = dqk_ref(ur, win, 2048 + head * 64, F.in[I_KG], !isc, l, lane, sp);
                dreport(F, 5, relerr(bf2f(((const bf16_t*)(ws + WS_K))[((size_t)b * SKV + (isc ? l : CTX + l)) * 256 + head * 64 + sp]), e, 0.5f)); }
            else if (kind == 3) { const int n = (cb & 3) * 64 + lane; const float d = ddot_b(ur, 1024, win, NIN, 2304 + n);
                dreport(F, 6, relerr(bf2f(((const bf16_t*)(ws + WS_V))[((size_t)b * SKV + (isc ? l : CTX + l)) * 256 + n]), d, 0.5f)); }
            else if (kind >= 4 && !isc) { const int n = cb * 64 + lane; const float d = ddot_b(ur, 1024, win, NIN, (kind == 4 ? 2560 : 3584) + n);
                dreport(F, 7, relerr(bf2f(((const bf16_t*)(ws + (kind == 4 ? WS_GS : WS_GA)))[(size_t)r * 1024 + n]), 1.f / (1.f + expf(-d)), 0.2f)); }
        }
    } else if constexpr (k == 4) {
        const bf16_t* U = (const bf16_t*)(ws + WS_A); const float* win = F.in[I_WIN]; const bf16_t* Kb = (const bf16_t*)(ws + WS_K); const bf16_t* Vb = (const bf16_t*)(ws + WS_V); const bf16_t* O = (const bf16_t*)(ws + WS_Q);
        LAS float* sp_ = (LAS float*)(F.lds) + F.wave * 4096;
        for (int s = F.gw; s < 512; s += F.NGW) {
            const unsigned h = dhash(s + 4242); const int r = h % T, b = r >> 11, l = r & 2047, head = (h >> 20) & 15, kvh = head >> 2;
            int spos; const float qv = dqk_ref(U + (size_t)r * 1024, win, 1024 + head * 64, F.in[I_QG], true, l, lane, spos) * C2Q;
            sp_[spos] = bf2f(f2bf(qv)); LDS_WAIT();
            float mx = -1e30f;
            for (int j = lane; j < SKV; j += 64) { const bf16_t* kr = Kb + ((size_t)b * SKV + j) * 256 + kvh * 64; float d = 0.f; for (int e = 0; e < 64; ++e) d += sp_[e] * bf2f(kr[e]); sp_[64 + j] = d; mx = fmaxf(mx, d); }
#pragma unroll
            for (int o = 1; o < 64; o <<= 1) mx = fmaxf(mx, __shfl_xor(mx, o));
            float sm = 0.f;
            for (int j = lane; j < SKV; j += 64) { const float p = exp2f(sp_[64 + j] - mx); sp_[64 + j] = p; sm += p; }
            sm = wave_sum(sm); LDS_WAIT();
            float o = 0.f;
            for (int j = 0; j < SKV; ++j) o += sp_[64 + j] * bf2f(Vb[((size_t)b * SKV + j) * 256 + kvh * 64 + lane]);
            o /= sm;
            dreport(F, 8, relerr(bf2f(O[(size_t)r * 1024 + head * 64 + lane]), o, 0.05f));
            LDS_WAIT();
        }
    } else if constexpr (k == 5) {
        const bf16_t* SA = (const bf16_t*)(ws + WS_SAUG); const bf16_t* Z = (const bf16_t*)(ws + WS_A);
        for (int s = F.gw; s < 256; s += F.NGW) {
            const unsigned h = dhash(s + 555); const int b = h & 31, l = (h >> 5) & 2047, g = (h >> 16) & 63, p = lane;
            float y[16];
#pragma unroll
            for (int c = 0; c < 16; ++c) y[c] = 0.f;
            for (int d = 0; d < 2; ++d) {
                const int base = (d * 64 + g) * 64 + p;
                const float lr = fminf(F.in[I_LAMRE][base], -1e-4f), li = F.in[I_LAMIM][base], dt = expf(F.in[I_LOGDT][d * 64 + g]);
                const float mg = expf(lr * dt), lbr = mg * cosf(li * dt), lbi = mg * sinf(li * dt), nr = lbr - 1.f, ni = lbi, den = lr * lr + li * li, qr = (nr * lr + ni * li) / den, qi = (ni * lr - nr * li) / den;
                float Br[16], Bi[16];
#pragma unroll
                for (int c = 0; c < 16; ++c) { const float br = F.in[I_BRE][(size_t)base * 16 + c], bi = F.in[I_BIM][(size_t)base * 16 + c]; Br[c] = qr * br - qi * bi; Bi[c] = qr * bi + qi * br; }
                float hr = 0.f, hi = 0.f;
                const int nlat = d == 0 ? l + 1 : SEQ - l;
                for (int st = 0; st < CTX + nlat; ++st) {
                    int grow, t;
                    if (st < CTX) { const int lc = d == 0 ? st : CTX - 1 - st; grow = 2048 + b * 8 + (lc >> 5); t = lc & 31; }
                    else { const int ll = d == 0 ? st - CTX : SEQ - 1 - (st - CTX); grow = b * 64 + (ll >> 5); t = ll & 31; }
                    const bf16_t* up = SA + ((size_t)g * ROWS_G + grow) * KAUG + t * 16;
                    float ur = 0.f, ui = 0.f;
#pragma unroll
                    for (int c = 0; c < 16; ++c) { const float u = bf2f(up[c]); ur += Br[c] * u; ui += Bi[c] * u; }
                    const float n1 = lbr * hr - lbi * hi + ur, n2 = lbr * hi + lbi * hr + ui; hr = n1; hi = n2;
                }
#pragma unroll
                for (int c = 0; c < 16; ++c) { const size_t ci = ((size_t)(d * 64 + g) * 16 + c) * 64 + p; y[c] += F.in[I_CRE][ci] * hr - F.in[I_CIM][ci] * hi; }
            }
            const bf16_t* ul = SA + ((size_t)g * ROWS_G + b * 64 + (l >> 5)) * KAUG + (l & 31) * 16;
#pragma unroll
            for (int c = 0; c < 16; ++c) { float v = wave_sum(y[c]) + F.in[I_SD][g * 16 + c] * bf2f(ul[c]); const float u0 = 0.7978845608f * (v + 0.044715f * v * v * v); v = 0.5f * v * (1.f + tanhf(u0));
                if (lane == c) dreport(F, 9, relerr(bf2f(Z[((size_t)g * T + b * 2048 + l) * 16 + c]), v, 0.3f)); }
        }

    } else if constexpr (k == 6) {
        const bf16_t* Z = (const bf16_t*)(ws + WS_A); const bf16_t* SSM = (const bf16_t*)(ws + WS_SAUG);
        for (int s = F.gw; s < 512; s += F.NGW) { const unsigned h = dhash(s + 66); const int r = h % T, col = ((h >> 20) & 15) * 64 + lane; float d = 0.f;
            for (int kk = 0; kk < 1024; ++kk) d += bf2f(Z[((size_t)(kk >> 4) * T + r) * 16 + (kk & 15)]) * F.in[I_WGLU][(size_t)kk * 1024 + col];
            const float z = bf2f(Z[((size_t)(col >> 4) * T + r) * 16 + (col & 15)]); dreport(F, 10, relerr(bf2f(SSM[(size_t)r * 1024 + col]), z / (1.f + expf(-d)), 0.2f)); }
    } else if constexpr (k == 7) {
        const bf16_t* SSM = (const bf16_t*)(ws + WS_SAUG); const bf16_t* O = (const bf16_t*)(ws + WS_Q); const bf16_t* MG = (const bf16_t*)(ws + WS_A);
        for (int s = F.gw; s < 512; s += F.NGW) { const unsigned h = dhash(s + 77); const int r = h % T, col = ((h >> 20) & 15) * 64 + lane;
            const float d1 = ddot_b(SSM + (size_t)r * 1024, 1024, F.in[I_WBS], 1024, col), d2 = ddot_b(O + (size_t)r * 1024, 1024, F.in[I_WBA], 1024, col);
            const float e = bf2f(((const bf16_t*)(ws + WS_GS))[(size_t)r * 1024 + col]) * d1 + bf2f(((const bf16_t*)(ws + WS_GA))[(size_t)r * 1024 + col]) * d2;
            dreport(F, 11, relerr(bf2f(MG[(size_t)r * 1024 + col]), e, 0.3f)); }
    } else if constexpr (k == 8) {
        const bf16_t* MG = (const bf16_t*)(ws + WS_A); const float* mod = (const float*)(ws + WS_MOD);
        for (int s = F.gw; s < 512; s += F.NGW) { const unsigned h = dhash(s + 88); const int r = h % T, col = ((h >> 20) & 15) * 64 + lane;
            const float d = ddot_b(MG + (size_t)r * 1024, 1024, F.in[I_WOUT], 1024, col), e = ALPHA * F.in[I_X][(size_t)r * 1024 + col] + mod[(size_t)(r >> 11) * 6144 + 2048 + col] * d;
            dreport(F, 12, relerr(bf2f(((const bf16_t*)(ws + WS_X1))[(size_t)r * 1024 + col]), e, 0.5f)); }
    } else if constexpr (k == 9) {
        const bf16_t* X1 = (const bf16_t*)(ws + WS_X1); const bf16_t* U2 = (const bf16_t*)(ws + WS_U2); const float* mod = (const float*)(ws + WS_MOD);
        for (int s = F.gw; s < 512; s += F.NGW) { const unsigned h = dhash(s + 909); const int r = h % T, b = r >> 11; const bf16_t* xr = X1 + (size_t)r * 1024; float a = 0.f, q = 0.f, a2 = 0.f, q2 = 0.f;
            for (int c = lane; c < 1024; c += 64) { const float v = bf2f(xr[c]), w = (v - F.in[I_LN1B][c]) / F.in[I_LN1G][c]; a += v; a2 += w; }
            const float mean = wave_sum(a) / 1024.f, mean2 = wave_sum(a2) / 1024.f;
            for (int c = lane; c < 1024; c += 64) { const float v = bf2f(xr[c]), w = (v - F.in[I_LN1B][c]) / F.in[I_LN1G][c]; q += (v - mean) * (v - mean); q2 += (w - mean2) * (w - mean2); }
            const float rstd = 1.f / sqrtf(wave_sum(q) / 1024.f + 1e-6f), var2 = wave_sum(q2) / 1024.f;
            if (lane == 0) dreport(F, 13, fabsf(mean2) * 3.f + fabsf(var2 - 1.f) * 3.f);
            for (int c = lane; c < 1024; c += 64) { const float e = (bf2f(xr[c]) - mean) * rstd * (1.f + mod[b * 6144 + 4096 + c]) + mod[b * 6144 + 3072 + c]; dreport(F, 14, relerr(bf2f(U2[(size_t)r * 1024 + c]), e, 0.5f)); } }
        const bf16_t* wgu = (const bf16_t*)(ws + WS_WGU); const bf16_t* wd = (const bf16_t*)(ws + WS_WD);
        for (int s = F.gw * 64 + lane; s < 65536; s += F.NGW * 64) { const unsigned h = dhash(s + 1234); const int e = h % NEXPS, kk = (h >> 9) & 1023, hid = (h >> 19) & 255, up = (h >> 27) & 1;
            const float* src = e < NEXP ? F.in[up ? I_WEU : I_WEG] + (size_t)e * 1024 * 256 : F.in[up ? I_WSU : I_WSG];
            const int pr = (hid >> 7) * 256 + up * 128 + (hid & 96) + pg8::invperm32(hid & 31);
            dreport(F, 15, relerr(bf2f(wgu[((size_t)e * 512 + pr) * 1024 + kk]), src[(size_t)kk * 256 + hid], 0.02f));
            const float* sd = e < NEXP ? F.in[I_WED] + (size_t)e * 256 * 1024 : F.in[I_WSD]; const int col = kk, k2 = hid;
            dreport(F, 16, relerr(bf2f(wd[((size_t)e * 1024 + (col & ~31) + pg8::invperm32(col & 31)) * 256 + k2]), sd[(size_t)k2 * 1024 + col], 0.02f)); }
    } else if constexpr (k == 10) {
        const bf16_t* U2 = (const bf16_t*)(ws + WS_U2); const float* lg = (const float*)(ws + WS_LOGIT);
        for (int s = F.gw; s < 512; s += F.NGW) { const unsigned h = dhash(s + 1010); const int r = h % T, col = ((h >> 20) & 3) * 64 + lane;
            dreport(F, 17, relerr(lg[(size_t)r * 256 + col], ddot_b(U2 + (size_t)r * 1024, 1024, F.in[I_WR], 256, col), 0.5f)); }
    } else if constexpr (k == 11) {
        const float* lg = (const float*)(ws + WS_LOGIT); const int* eidx = (const int*)(ws + WS_EIDX); const float* gate = (const float*)(ws + WS_GATE);
        LAS float* sc = (LAS float*)(F.lds) + F.wave * 1024; LAS float* bs = sc + 256; LAS float* gsc = sc + 512;
        for (int s = F.gw; s < 2048; s += F.NGW) { const unsigned h = dhash(s + 1111); const int tok = h % T;
            for (int e = lane; e < 256; e += 64) { const float v = 1.f / (1.f + expf(-lg[(size_t)tok * 256 + e])); sc[e] = v; bs[e] = v + F.in[I_RB][e]; }
            LDS_WAIT();
            if (lane == 0) {
                for (int g = 0; g < 8; ++g) { float m1 = -1e30f, m2 = -1e30f; for (int j = 0; j < 32; ++j) { const float v = bs[g * 32 + j]; if (v > m1) { m2 = m1; m1 = v; } else if (v > m2) m2 = v; } gsc[g] = m1 + m2; }
                for (int g = 0; g < 8; ++g) { int rank = 0; for (int o = 0; o < 8; ++o) if (gsc[o] > gsc[g] || (gsc[o] == gsc[g] && o < g)) ++rank; if (rank >= 4) for (int j = 0; j < 32; ++j) bs[g * 32 + j] = -1e30f; }
                float sel[8]; int se[8]; float ssum = 0.f; float err = 0.f;
#pragma unroll
                for (int r = 0; r < 8; ++r) { float bv = -1e31f; int bi = 0; for (int e = 0; e < 256; ++e) if (bs[e] > bv) { bv = bs[e]; bi = e; } bs[bi] = -1e31f; se[r] = bi; sel[r] = sc[bi]; ssum += sc[bi]; }
#pragma unroll
                for (int r = 0; r < 8; ++r) { if (eidx[(size_t)tok * 8 + r] != se[r]) err = 1.f; err = fmaxf(err, relerr(gate[(size_t)tok * 8 + r], sel[r] / ssum * 2.5f, 0.1f)); }
                dreport(F, 18, err);
            }
            LDS_WAIT();
        }
    } else if constexpr (k == 12) {
        const int* eidx = (const int*)(ws + WS_EIDX); const int* slot = (const int*)(ws + WS_SLOT); const int* stok = (const int*)(ws + WS_STOK);
        for (int s = F.gw * 64 + lane; s < 65536; s += F.NGW * 64) { const unsigned h = dhash(s + 1212); const int a = h % (T * 8), tok = a >> 3, c = tok / TCH; const int sl = slot[a];
            float err = 0.f; if (sl < 0 || sl >= TCH * 8) err = 1.f; else if (stok[(size_t)c * (SLOTS_CH + 256) + sl] != tok) err = 2.f;
            if (stok[(size_t)c * (SLOTS_CH + 256) + TCH * 8 + (tok - c * TCH)] != tok) err = 3.f;
            dreport(F, 19, err); }
        if (F.gw < NCHUNK && lane == 0) { int sum = 0; for (int e = 0; e < 256; ++e) sum += (int)__hip_atomic_load(F.ctl + CW_CNT + F.gw * 256 + e, RLX_AGENT); dreport(F, 20, sum == TCH * 8 ? 0.f : 1.f);
            const int* tiles = (const int*)(ws + WS_TILES) + F.gw * TILE_INTS; const int ntl = tiles[0]; int rows = 0; float err = (ntl < 64 || ntl > 1000) ? 1.f : 0.f;
            for (int i = 0; i < ntl && i < 1000; ++i) { if (tiles[4 + i * 4 + 1] != rows) err = 2.f; rows += tiles[4 + i * 4 + 2]; }
            if (rows != SLOTS_CH) err = 3.f; dreport(F, 21, err); }
    } else if constexpr (k == 20 || k == 21) {
        const int* eidx = (const int*)(ws + WS_EIDX); const int* slot = (const int*)(ws + WS_SLOT); const int* stok = (const int*)(ws + WS_STOK);
        const bf16_t* U2 = (const bf16_t*)(ws + WS_U2); const bf16_t* H = (const bf16_t*)(ws + WS_H); const bf16_t* Y = (const bf16_t*)(ws + WS_Y);
        for (int s = F.gw; s < 768; s += F.NGW) { const unsigned h = dhash(s + 2020 + k); const int sl = (s & 7) == 7 ? TCH * 8 + (h % TCH) : h % (TCH * 8); const int tok = stok[sl]; int e = 256;
            if (sl < TCH * 8) { e = -1; for (int kk = 0; kk < 8; ++kk) if (slot[(size_t)tok * 8 + kk] == sl) e = eidx[(size_t)tok * 8 + kk]; }
            if (e < 0 || tok < 0 || tok >= TCH) { dreport(F, 22, 5.f); continue; }
            if (k == 20) { const int hid = ((h >> 20) & 3) * 64 + lane;
                const float* wg = e < NEXP ? F.in[I_WEG] + (size_t)e * 1024 * 256 : F.in[I_WSG]; const float* wu = e < NEXP ? F.in[I_WEU] + (size_t)e * 1024 * 256 : F.in[I_WSU];
                const float g = ddot_b(U2 + (size_t)tok * 1024, 1024, wg, 256, hid), u = ddot_b(U2 + (size_t)tok * 1024, 1024, wu, 256, hid);
                dreport(F, 22, relerr(bf2f(H[(size_t)sl * 256 + hid]), g / (1.f + expf(-g)) * u, 0.3f));
            } else { const int col = ((h >> 20) & 15) * 64 + lane; const float* wdn = e < NEXP ? F.in[I_WED] + (size_t)e * 256 * 1024 : F.in[I_WSD];
                dreport(F, 23, relerr(bf2f(Y[(size_t)sl * 1024 + col]), ddot_b(H + (size_t)sl * 256, 256, wdn, 1024, col), 0.2f)); }
        }
    }
}
__device__ __forceinline__ void diag_finish(Frame& F, const XcdBarrier& bar, const Params& P) {
    xcd_barrier(bar);
    int code = 0;
    for (int j = 63; j >= 0; --j) { const float e = __uint_as_float(__hip_atomic_load(F.ctl + CW_CHK + j, RLX_AGENT)); if (!(e < 0.06f)) code = j + 1; }
#if MK_DIAG == 3
    code = 0; for (int j = 0; j < 6; ++j) { const float e = __uint_as_float(__hip_atomic_load(F.ctl + CW_CHK + MK_DIAG_BASE + j, RLX_AGENT)); if (!(e < 0.06f)) code |= 1 << j; }
#endif
#if MK_DIAG == 4
    code = (int)__hip_atomic_load(F.ctl + CW_CHK + 40, RLX_AGENT) / 4;
#endif
#if MK_DIAG == 5
    { const unsigned cyc = __hip_atomic_load(F.ctl + CW_CHK + 41, RLX_AGENT), rt_ = __hip_atomic_load(F.ctl + CW_CHK + 42, RLX_AGENT); const float ghz = rt_ ? (float)cyc / (float)rt_ : 0.f; code = ghz < 1.25f ? 1 : ghz < 1.75f ? 2 : ghz < 2.25f ? 3 : 4; }
#endif
#if MK_DIAG == 2
    code = (int)((P.ws_size - 1100000000ull) / 10000000ull); if (code < 0) code = 0; if (code > 80) code = 80;
#endif
    if (__hip_atomic_load(F.ctl + CW_BAR + XB_TMO, RLX_AGENT) != 0u) code = 90;
    const float v = sqrtf(10.f * (float)(code + 1));
    for (size_t i = (size_t)F.vcu * NTHR + F.tid; i < (size_t)T * DM / 4; i += (size_t)F.G * NTHR) ((f32x4*)F.out)[i] = (f32x4){v, v, v, v};
}
#endif
constexpr int N_PHASES = 16;
__global__ void __launch_bounds__(NTHR, 2) mk_fwd(Params P) {
    extern __shared__ __attribute__((aligned(16))) unsigned char lds_raw[];
    Frame F;
    F.lds = (LAS unsigned char*)lds_raw;
    F.MISC = (volatile LAS unsigned*)(F.lds + LDSCTL_OFF);
    F.tid = threadIdx.x; F.lane = F.tid & 63; F.wave = __builtin_amdgcn_readfirstlane(F.tid >> 6);
    F.G = gridDim.x; { const int bx = blockIdx.x; F.vcu = (F.G % 8 == 0) ? (bx % 8) * (F.G / 8) + bx / 8 : bx; }
    F.gw = F.vcu * NWAVES + F.wave; F.NGW = F.G * NWAVES;
    F.in = P.in; F.out = P.out; F.ws = P.ws; F.ctl = (unsigned*)(P.ws + WS_CTL);
    for (int u = F.tid; u < 128; u += NTHR) ((LAS unsigned*)(F.lds + LDSCTL_OFF))[u] = 0u;
    __syncthreads();
#if MK_DIAG == 4
    if (F.tid == 0 && (xb_xcc_id() != (blockIdx.x & 7u))) atomicAdd(F.ctl + CW_CHK + 40, 1u);
#endif
    XcdBarrier bar = xcd_barrier_post(F.ctl + CW_BAR + P.li * XCD_BAR_WORDS, F.MISC + 8);
    const int lo = P.ph_lo, hi = P.ph_hi;
    unsigned char* ws = P.ws;
    const int blk = (int)blockIdx.x;
#ifndef MK_DUP
#define MK_DUP 0u
#endif
#define REPS(k) ((((MK_DUP) >> (k)) & 1u) ? 2 : 1)
#define DUPBAR(k) do { if (REPS(k) == 2 && rep == 0) xcd_barrier(bar); } while (0)
#ifndef MK_PHMASK
#define MK_PHMASK 0xffffffffu
#endif
#define IN(k) (((MK_PHMASK >> (k)) & 1u) && lo <= (k) && (k) < hi)
#if MK_DIAG
#define SEAM(k) do { if (IN(k)) { xcd_barrier(bar); if constexpr (DCHK(k) != 0) { diag_checks<k>(F); xcd_barrier(bar); } } } while (0)
#else
#define SEAM(k) do { if (IN(k) && IN((k) + 1)) xcd_barrier(bar); } while (0)
#endif

    if (IN(0)) {
        if (blk < 96) p0_mod_item(F, blk);
    }
    SEAM(0);
#ifdef MK_XBAR
    for (int xb = 0; xb < MK_XBAR; ++xb) xcd_barrier(bar);
#endif
    if (IN(1)) {
        if (blk >= 192) p0_s5_tables(F, blk - 192);
        else { if (blk == 0 && F.wave == 0) p0_rope(F); p0_mixer_weights(F, 192); }
        p1_modulate(F, 0, T, true);
    }
    SEAM(1);
    if (IN(2)) {
        pg8::SchedInProj S{(unsigned)WS_A, (unsigned)WS_UC, (unsigned)WS_WIN, 8, F.G, blk, 0, 256, 32 * 6};
        pg8::EpiInProj E{(bf16_t*)(ws + WS_SAUG), (bf16_t*)(ws + WS_Q), (bf16_t*)(ws + WS_K), (bf16_t*)(ws + WS_V), (bf16_t*)(ws + WS_GS), (bf16_t*)(ws + WS_GA),
                         (const float*)(ws + WS_ROPE), F.in[I_QG], F.in[I_KG]};
#ifdef MK_DUPNULL
        if (REPS(2) == 2) { pg8::EpiNull E0{(float*)(ws + WS_ROPE + 32768)}; pg8::gemm_phase(F.lds, ws, S, E0); xcd_barrier(bar); }
#else
        if (REPS(2) == 2) { pg8::gemm_phase(F.lds, ws, S, E); xcd_barrier(bar); }
#endif
        pg8::gemm_phase(F.lds, ws, S, E);
    }
    SEAM(2);
    if (IN(3)) for (int rep = 0; rep < REPS(3); ++rep) {
        pg8::SchedGroupT<WH_SHIFT> S{(unsigned)WS_SAUG, (unsigned)WS_WH, KAUG, NS5, (unsigned)ROWS_G * KAUG, 256u * NS5, NS5 / 128, ROWS_G / 256, 1, F.G, blk};
        pg8::EpiBf16<0> E{(bf16_t*)(ws + WS_HFIN), 256, (size_t)ROWS_G * 256};
        pg8::gemm_phase(F.lds, ws, S, E);
        DUPBAR(3);
    }
    SEAM(3);
    if (IN(4)) {
        p4_carry_scan(F);
        VM_WAIT(); __syncthreads();
        for (int rep = 0; rep < REPS(4); ++rep) {
        const attn_body::AttnTensors AT{(const attn_body::bf16*)(ws + WS_Q), (const attn_body::bf16*)(ws + WS_K), (const attn_body::bf16*)(ws + WS_V), (attn_body::bf16*)(ws + WS_O8)};
        const attn_body::StaticOrder S((int)F.G, blk);
        { attn_body::AttnUnit u;
          for (int i = 0; S.next(i, u); ++i) {

#ifdef MK_ATTN_ABL
              if (REPS(4) == 2 && rep == 0) attn_body::attn_unit<MK_ATTN_ABL>(u.bh / attn_body::NHEAD, u.bh % attn_body::NHEAD, u.qb, AT.Q, AT.K, AT.V, AT.O, (char*)lds_raw); else
#endif
              attn_body::attn_unit<8>(u.bh / attn_body::NHEAD, u.bh % attn_body::NHEAD, u.qb, AT.Q, AT.K, AT.V, AT.O, (char*)lds_raw);

#ifdef MK_CONV2
              if (i == (F.vcu & 15))
#else
              if (rep == REPS(4) - 1 && i == (F.vcu & 15))
#endif
               { p9_expert_weights(F); asm volatile("s_waitcnt vmcnt(0) lgkmcnt(0)\n\ts_barrier" ::: "memory"); }
          } }
        DUPBAR(4);
        }
    }
    SEAM(4);
    if (IN(5)) for (int rep = 0; rep < REPS(5); ++rep) {
        pg8::SchedGroupT<TMAT_SHIFT> S{(unsigned)WS_SAUG, (unsigned)WS_TMAT, KAUG, KAUG, (unsigned)ROWS_G * KAUG, (unsigned)NS5 * KAUG, KAUG / 128, 2048 / 256, 2, F.G, blk};
        pg8::EpiZ8 E{(unsigned char*)(ws + WS_Z8), (size_t)T * 16};
        pg8::gemm_phase(F.lds, ws, S, E);
        DUPBAR(5);
    }
    SEAM(5);
    if (IN(6)) for (int rep = 0; rep < REPS(6); ++rep) {
        pg8::SchedDenseT<true, true> S{(unsigned)WS_Z8, (unsigned)WS_WGLU, 16u, (unsigned)T * 16u, 1024u, 8u * T * 16u, 256u * 16u, 256u * 1024u, 8, 256, 4, F.G, blk};
        pg8::EpiGate8<0> E{(const unsigned char*)(ws + WS_Z8), nullptr, (unsigned char*)(ws + WS_CAT), 2048};
        pg8::gemm_phase(F.lds, ws, S, E);
        DUPBAR(6);
    }
    SEAM(6);
    if (IN(7)) for (int rep = 0; rep < REPS(7); ++rep) {
        { pg8::SchedDenseT<true, false> S{(unsigned)WS_CAT, (unsigned)WS_WBS, 2048u, 0u, 2048u, 128u, 256u * 2048u, 256u * 2048u, 16, 256, 4, F.G, blk};
          pg8::EpiMerge8 E{(const unsigned char*)(ws + WS_GS), (const unsigned char*)(ws + WS_GA), (unsigned char*)(ws + WS_MG8)};
          pg8::gemm_phase(F.lds, ws, S, E); }
        DUPBAR(7);
    }
    SEAM(7);
#if MK_DIAG == 5
    unsigned long long c0_ = clock64(), r0_ = __builtin_amdgcn_s_memrealtime();
#endif
    if (IN(8)) for (int rep = 0; rep < REPS(8); ++rep) {
        pg8::SchedOutRow S{(unsigned)WS_MG8, (unsigned)WS_WOUT, 8, F.vcu};
#ifdef MK_DUPNULL
        if (REPS(8) == 2 && rep == 0) { pg8::EpiNull E0{(float*)(ws + WS_ROPE + 32768)}; pg8::gemm_phase(F.lds, ws, S, E0); } else
#endif
        { pg8::EpiOut16 E{F.in[I_X], (const float*)(ws + WS_MOD), (bf16_t*)(ws + WS_X1)};
        pg8::gemm_phase(F.lds, ws, S, E); }
        DUPBAR(8);
    }
#if MK_DIAG == 5
    if (blockIdx.x == 0 && F.tid == 0) { const unsigned long long c1_ = clock64(), r1_ = __builtin_amdgcn_s_memrealtime(); F.ctl[CW_CHK + 41] = (unsigned)((c1_ - c0_) / 10); F.ctl[CW_CHK + 42] = (unsigned)(r1_ - r0_); }
#endif
    if (IN(9)) { p9_router_weights(F); asm volatile("s_waitcnt vmcnt(0)" ::: "memory"); __syncthreads(); p9_ln1(F); }
    SEAM(9);
    if (IN(10)) {
        pg8::SchedRouter S{(unsigned)WS_X1, (unsigned)WS_WRB, 16, F.G, blk};
        pg8::EpiF32 E{(float*)(ws + WS_LOGIT), 256, 0};
        pg8::gemm_phase(F.lds, ws, S, E);
        pg8::Unit u0; u0.pm = 0; S.next(0, u0);
        asm volatile("s_waitcnt vmcnt(0)" ::: "memory"); __syncthreads();
        p11_routing(F, u0.pm);
    }
    SEAM(11);
    if (IN(12)) { p12_dispatch(F); }
    SEAM(12);
    if (IN(13)) {
        for (int c = 0; c < NCHUNK; ++c) {
            const int* tiles = (const int*)(ws + WS_TILES) + c * TILE_INTS;
            const int ntiles = __builtin_amdgcn_readfirstlane(__hip_atomic_load(tiles, RLX_AGENT));
            LAS unsigned* tt = (LAS unsigned*)(F.lds + RING_BYTES);
            __syncthreads();
            int tid_l = F.tid; asm volatile("" : "+v"(tid_l));
            for (int i = tid_l; i < ntiles && i < 1536; i += NTHR) { const int e_ = __hip_atomic_load(tiles + 4 + i * 4, RLX_AGENT), r0_ = __hip_atomic_load(tiles + 4 + i * 4 + 1, RLX_AGENT), nr_ = __hip_atomic_load(tiles + 4 + i * 4 + 2, RLX_AGENT);
                tt[i * 2] = (unsigned)r0_ | ((unsigned)(nr_ - 1) << 20); tt[i * 2 + 1] = (unsigned)e_; }
            __syncthreads();
#if !defined(MK_T13) || MK_T13 == 1
            for (int rep = 0; rep < REPS(13); ++rep)
            { pg8::SchedMoe<true> S{tt, ntiles, (unsigned)WS_U2, (unsigned)WS_WGU, (const int*)(ws + WS_STOK) + (size_t)c * (SLOTS_CH + 256), F.G, blk, 8};
              pg8::EpiMoe<true> E{(void*)(ws + WS_H)};
              pg8::gemm_phase(F.lds, ws, S, E); DUPBAR(13); }
#endif
            xcd_barrier(bar);
#if MK_DIAG
            if constexpr (DCHK(20) != 0) { if (c == 0) { diag_checks<20>(F); xcd_barrier(bar); } }
#endif
#if !defined(MK_T13) || MK_T13 == 2
            for (int rep = 0; rep < REPS(14); ++rep)
            { pg8::SchedMoe<false> S{tt, ntiles, (unsigned)WS_H, (unsigned)WS_WD, nullptr, F.G, blk, 2};
#ifdef MK_DUPNULL
              if (REPS(14) == 2 && rep == 0) { pg8::EpiNull E0{(float*)(ws + WS_ROPE + 32768)}; pg8::gemm_phase(F.lds, ws, S, E0); } else
#endif
              { pg8::EpiMoe<false> E{(void*)(ws + WS_Y)};
              pg8::gemm_phase(F.lds, ws, S, E); } DUPBAR(14); }
#endif
            xcd_barrier(bar);
#if MK_DIAG
            if constexpr (DCHK(21) != 0) { if (c == 0) { diag_checks<21>(F); xcd_barrier(bar); } }
#endif
#if !defined(MK_T13) || MK_T13 == 3
            for (int rep = 0; rep < REPS(15); ++rep) { p15_combine<2>(F, c); DUPBAR(15); }
#endif
        }
    }
#if MK_DIAG
    diag_finish(F, bar, P);
#endif
#undef IN
#undef SEAM
}

extern "C" void kernel_launch(void* const* d_in, const int* in_sizes, int n_in, void* d_out, int out_size, void* d_ws, size_t ws_size, hipStream_t stream) {
    static int grid = 0;
    if (grid == 0) {
        if (n_in != 33 || in_sizes[0] != T * DM || out_size != T * DM || ws_size < WS_END) {
            fprintf(stderr, "kernel_launch: unexpected shapes or workspace (n_in %d, in0 %d, out %d, ws %zu, need %zu); nothing launched\n", n_in, n_in > 0 ? in_sizes[0] : -1, out_size, ws_size, (size_t)WS_END); grid = -1; return; }
        int dev = 0, cus = 0, per_cu = 0;
        if (hipGetDevice(&dev) != hipSuccess || hipDeviceGetAttribute(&cus, hipDeviceAttributeMultiprocessorCount, dev) != hipSuccess) { grid = -1; return; }
        if (hipFuncSetAttribute((const void*)mk_fwd, hipFuncAttributeMaxDynamicSharedMemorySize, LDS_BYTES) != hipSuccess) { fprintf(stderr, "kernel_launch: hipFuncSetAttribute failed\n"); grid = -1; return; }
        if (hipOccupancyMaxActiveBlocksPerMultiprocessor(&per_cu, (const void*)mk_fwd, NTHR, LDS_BYTES) != hipSuccess || per_cu < 1) { fprintf(stderr, "kernel_launch: occupancy query reports %d workgroups per CU\n", per_cu); }
        (void)hipGetLastError();
        if (cus < 256) { fprintf(stderr, "kernel_launch: built for a 256-CU device (token ownership in the routing phases is per workgroup of a 256-workgroup grid); found %d CUs; nothing launched\n", cus); grid = -1; return; }
        grid = 256;
    }
    if (grid < 0) return;
    if (hipMemsetAsync((char*)d_ws + WS_CTL, 0, CTL_ZERO_BYTES, stream) != hipSuccess) { fprintf(stderr, "kernel_launch: memset failed\n"); return; }
    Params p{};
    for (int i = 0; i < 33; ++i) p.in[i] = (const float*)d_in[i];
    p.out = (float*)d_out; p.ws = (unsigned char*)d_ws; p.ws_size = (unsigned long long)ws_size;
#ifndef MK_CUTS
#ifndef MK_PH_HI
#define MK_PH_HI N_PHASES
#endif
    p.ph_lo = 0; p.ph_hi = MK_PH_HI;
    hipLaunchKernelGGL(mk_fwd, dim3(grid), dim3(NTHR), LDS_BYTES, stream, p);
#else
    { const int cuts[] = {MK_CUTS}; const int nc = (int)(sizeof(cuts) / sizeof(cuts[0]));
      for (int i = 0; i + 1 < nc; ++i) { p.ph_lo = cuts[i]; p.ph_hi = cuts[i + 1]; p.li = i; hipLaunchKernelGGL(mk_fwd, dim3(grid), dim3(NTHR), LDS_BYTES, stream, p); } }
#endif
    const hipError_t le = hipPeekAtLastError();
    if (le != hipSuccess) fprintf(stderr, "kernel_launch: launch failed: %s\n", hipGetErrorName(le));
}
```
